# Optimizing an MI355X kernel written in HIP

```python
import jax, jax.numpy as jnp
from jax import lax
import numpy as np

D_MODEL = 1024
BATCH = 8
SEQ = 4096
DEPTH = 1

GDN_HEAD_DIM = 128
GDN_WIDTH = D_MODEL // 2
GDN_HEADS = GDN_WIDTH // GDN_HEAD_DIM
GDN_CONV = 4
CHUNK = 64
SC_WIDTH = D_MODEL - GDN_WIDTH
SC_GROUPS = 8
SC_CONV = 3
MIX_WIDTH = GDN_WIDTH + SC_WIDTH
IN_COLS = 4 * GDN_WIDTH + 2 * GDN_HEADS + 3 * SC_WIDTH
N_MEM = 256
XATTN_HEADS = 4
XATTN_HEAD_DIM = D_MODEL // XATTN_HEADS
D_FF = ((8 * D_MODEL + 3 * 256 - 1) // (3 * 256)) * 256
EPS = 1e-6

kernel_name = "hybrid_gdn_shortconv_memxattn_block"


def rms_norm(x, g):
    xf = x.astype(jnp.float32)
    y = xf * lax.rsqrt(jnp.mean(xf * xf, axis=-1, keepdims=True) + EPS)
    return (y * g.astype(jnp.float32)).astype(x.dtype)


def l2norm(x):
    return x * lax.rsqrt(jnp.sum(x * x, axis=-1, keepdims=True) + EPS)


def causal_depthwise_conv(x, w):
    K, C = w.shape
    return lax.conv_general_dilated(
        x, w[:, None, :].astype(x.dtype), window_strides=(1,), padding=[(K - 1, 0)],
        dimension_numbers=('NWC', 'WIO', 'NWC'), feature_group_count=C)


def gated_delta_rule_chunked(q, k, v, g, beta):
    B, S, H, dk = q.shape
    dv = v.shape[-1]
    N = S // CHUNK

    def to_chunks(t):
        t = t.reshape((B, N, CHUNK, H) + t.shape[3:])
        return jnp.moveaxis(t, 3, 1)

    q, k, v, g, beta = (to_chunks(t) for t in (q, k, v, g, beta))
    q = q * (dk ** -0.5)
    gc = jnp.cumsum(g, axis=-1)
    idx = jnp.arange(CHUNK)
    causal = idx[:, None] >= idx[None, :]
    strict = idx[:, None] > idx[None, :]
    diff = gc[..., :, None] - gc[..., None, :]
    decay = jnp.exp(jnp.where(causal, diff, -jnp.inf))
    k_beta = k * beta[..., None]
    A = jnp.where(strict, jnp.einsum('bhnid,bhnjd->bhnij', k_beta, k) * decay, 0.0)
    eye = jnp.eye(CHUNK, dtype=q.dtype)
    T = lax.linalg.triangular_solve(eye + A, jnp.broadcast_to(eye, A.shape),
                                    left_side=True, lower=True)
    u = jnp.einsum('bhnij,bhnjd->bhnid', T, v * beta[..., None])
    w = jnp.einsum('bhnij,bhnjd->bhnid', T, k_beta * jnp.exp(gc)[..., None])
    attn_qk = jnp.einsum('bhnid,bhnjd->bhnij', q, k) * decay
    q_dec = q * jnp.exp(gc)[..., None]
    g_last = gc[..., -1]
    k_dec = k * jnp.exp(g_last[..., None] - gc)[..., None]

    def step(state, inp):
        u_n, w_n, a_n, qd_n, kd_n, gl_n = inp
        v_new = u_n - jnp.einsum('bhcd,bhde->bhce', w_n, state)
        o = (jnp.einsum('bhcd,bhde->bhce', qd_n, state)
             + jnp.einsum('bhij,bhje->bhie', a_n, v_new))
        state = state * jnp.exp(gl_n)[..., None, None] + jnp.einsum('bhcd,bhce->bhde', kd_n, v_new)
        return state, o

    xs = tuple(jnp.moveaxis(t, 2, 0) for t in (u, w, attn_qk, q_dec, k_dec, g_last))
    state0 = jnp.zeros((B, H, dk, dv), jnp.float32)
    _, o = lax.scan(step, state0, xs)
    return jnp.transpose(o, (1, 0, 3, 2, 4)).reshape(B, S, H, dv)


def hybrid_mixer(xn, w_in, conv_qkv_w, a_log, dt_bias, gdn_norm_g, conv_sc_w, sc_norm_g, w_out):
    B, S, _ = xn.shape
    f32 = jnp.float32
    proj = xn @ w_in
    cuts = [3 * GDN_WIDTH, 4 * GDN_WIDTH, 4 * GDN_WIDTH + GDN_HEADS,
            4 * GDN_WIDTH + 2 * GDN_HEADS, 4 * GDN_WIDTH + 2 * GDN_HEADS + SC_WIDTH,
            4 * GDN_WIDTH + 2 * GDN_HEADS + 2 * SC_WIDTH]
    qkv, z, a, b, sc_b, sc_c, sc_h = jnp.split(proj, cuts, axis=-1)

    qkv = jax.nn.silu(causal_depthwise_conv(qkv, conv_qkv_w))
    q, k, v = jnp.split(qkv, 3, axis=-1)
    heads = lambda t: t.reshape(B, S, GDN_HEADS, GDN_HEAD_DIM).astype(f32)
    q, k, v = l2norm(heads(q)), l2norm(heads(k)), heads(v)
    g = -jnp.exp(a_log.astype(f32)) * jax.nn.softplus(a.astype(f32) + dt_bias.astype(f32))
    beta = jax.nn.sigmoid(b.astype(f32))
    o = gated_delta_rule_chunked(q, k, v, g, beta)
    o = rms_norm(o, gdn_norm_g) * jax.nn.silu(heads(z))
    o_gdn = o.reshape(B, S, GDN_WIDTH).astype(xn.dtype)

    y = sc_b * causal_depthwise_conv(sc_c * sc_h, conv_sc_w)
    y = rms_norm(y.reshape(B, S, SC_GROUPS, SC_WIDTH // SC_GROUPS),
                 sc_norm_g.reshape(SC_GROUPS, SC_WIDTH // SC_GROUPS)).reshape(B, S, SC_WIDTH)

    return jnp.concatenate([o_gdn, y.astype(xn.dtype)], axis=-1) @ w_out


def memory_cross_attention(hn, memn, w_xq, w_xk, w_xv, w_xo):
    B, S, _ = hn.shape
    M = memn.shape[1]
    q = (hn @ w_xq).reshape(B, S, XATTN_HEADS, XATTN_HEAD_DIM)
    k = (memn @ w_xk).reshape(B, M, XATTN_HEADS, XATTN_HEAD_DIM)
    v = (memn @ w_xv).reshape(B, M, XATTN_HEADS, XATTN_HEAD_DIM)
    s = jnp.einsum('bshd,bmhd->bhsm', q, k).astype(jnp.float32) * (XATTN_HEAD_DIM ** -0.5)
    p = jax.nn.softmax(s, axis=-1).astype(v.dtype)
    o = jnp.einsum('bhsm,bmhd->bshd', p, v).reshape(B, S, XATTN_HEADS * XATTN_HEAD_DIM)
    return o @ w_xo


def swiglu(hn, w_gate, w_up, w_down):
    return (jax.nn.silu(hn @ w_gate) * (hn @ w_up)) @ w_down


def setup_inputs(seed: int = 0) -> dict:
    key = jax.random.key(seed)
    ks = jax.random.split(key, 24)
    f32 = jnp.float32
    L = DEPTH

    def dense(k, fan_in, shape):
        return jax.random.normal(k, shape, f32) * (fan_in ** -0.5)

    def gain(k, n):
        return 1.0 + 0.02 * jax.random.normal(k, (L, n), f32)

    dt = jnp.exp(jax.random.uniform(ks[5], (L, GDN_HEADS), f32, np.log(1e-3), np.log(1e-1)))
    return {
        "x": jax.random.normal(ks[0], (BATCH, SEQ, D_MODEL), f32),
        "mem": jax.random.normal(ks[1], (BATCH, N_MEM, D_MODEL), f32),
        "norm_mix_g": gain(ks[2], D_MODEL),
        "w_in": dense(ks[3], D_MODEL, (L, D_MODEL, IN_COLS)),
        "conv_qkv_w": dense(ks[4], GDN_CONV, (L, GDN_CONV, 3 * GDN_WIDTH)),
        "a_log": jnp.log(jax.random.uniform(ks[6], (L, GDN_HEADS), f32, 1.0, 16.0)),
        "dt_bias": dt + jnp.log(-jnp.expm1(-dt)),
        "gdn_norm_g": gain(ks[7], GDN_HEAD_DIM),
        "conv_sc_w": dense(ks[8], SC_CONV, (L, SC_CONV, SC_WIDTH)),
        "sc_norm_g": gain(ks[9], SC_WIDTH),
        "w_out": dense(ks[10], MIX_WIDTH, (L, MIX_WIDTH, D_MODEL)),
        "norm_x_g": gain(ks[11], D_MODEL),
        "norm_mem_g": gain(ks[12], D_MODEL),
        "w_xq": dense(ks[13], D_MODEL, (L, D_MODEL, D_MODEL)),
        "w_xk": dense(ks[14], D_MODEL, (L, D_MODEL, D_MODEL)),
        "w_xv": dense(ks[15], D_MODEL, (L, D_MODEL, D_MODEL)),
        "w_xo": dense(ks[16], D_MODEL, (L, D_MODEL, D_MODEL)),
        "norm_ffn_g": gain(ks[17], D_MODEL),
        "w_gate": dense(ks[18], D_MODEL, (L, D_MODEL, D_FF)),
        "w_up": dense(ks[19], D_MODEL, (L, D_MODEL, D_FF)),
        "w_down": dense(ks[20], D_FF, (L, D_FF, D_MODEL)),
        "norm_final_g": 1.0 + 0.02 * jax.random.normal(ks[21], (D_MODEL,), f32),
    }


def reference(x, mem, norm_mix_g, w_in, conv_qkv_w, a_log, dt_bias, gdn_norm_g, conv_sc_w,
              sc_norm_g, w_out, norm_x_g, norm_mem_g, w_xq, w_xk, w_xv, w_xo, norm_ffn_g,
              w_gate, w_up, w_down, norm_final_g):
    h = x
    for l in range(DEPTH):
        h = h + hybrid_mixer(rms_norm(h, norm_mix_g[l]), w_in[l], conv_qkv_w[l], a_log[l],
                             dt_bias[l], gdn_norm_g[l], conv_sc_w[l], sc_norm_g[l], w_out[l])
        h = h + memory_cross_attention(rms_norm(h, norm_x_g[l]), rms_norm(mem, norm_mem_g[l]),
                                       w_xq[l], w_xk[l], w_xv[l], w_xo[l])
        h = h + swiglu(rms_norm(h, norm_ffn_g[l]), w_gate[l], w_up[l], w_down[l])
    return rms_norm(h, norm_final_g)
```

```cpp
#include <hip/hip_runtime.h>
#include <cstdio>
namespace nv {
constexpr int D = 1024, SEQ = 4096, NB = 8, INC = 3592, DFF = 2816, NMEM = 256;

__global__ void rmsnorm(const float* __restrict__ in, const float* __restrict__ g, float* __restrict__ out, int cols) {
    const float* r = in + (size_t)blockIdx.x * cols; float* o = out + (size_t)blockIdx.x * cols;
    float s = 0.f;
    for (int c = threadIdx.x; c < cols; c += 256) { float v = r[c]; s += v * v; }
    __shared__ float red[256];
    red[threadIdx.x] = s; __syncthreads();
    for (int o2 = 128; o2 > 0; o2 >>= 1) { if (threadIdx.x < o2) red[threadIdx.x] += red[threadIdx.x + o2]; __syncthreads(); }
    float rs = rsqrtf(red[0] / cols + 1e-6f);
    for (int c = threadIdx.x; c < cols; c += 256) o[c] = r[c] * rs * g[c];
}

template <bool ADD>
__global__ void gemm(const float* __restrict__ A, long sAz, int lda, const float* __restrict__ B, long sBz, int ldbk, int ldbn,
                     float* __restrict__ C, long sCz, int ldc, const float* __restrict__ R, int M, int N, int K) {
    __shared__ float As[16][65], Bs[16][65];
    const int z = blockIdx.z; A += z * sAz; B += z * sBz; C += z * sCz; if (ADD) R += z * sCz;
    const int m0 = blockIdx.y * 64, n0 = blockIdx.x * 64, tx = threadIdx.x % 16, ty = threadIdx.x / 16;
    float acc[4][4] = {};
    for (int k0 = 0; k0 < K; k0 += 16) {
        for (int i = threadIdx.x; i < 1024; i += 256) {
            int mm = i / 16, kk = i % 16; As[kk][mm] = A[(size_t)(m0 + mm) * lda + k0 + kk];
            int kb = ldbn == 1 ? i / 64 : i % 16, nn = ldbn == 1 ? i % 64 : i / 16;
            Bs[kb][nn] = (n0 + nn < N) ? B[(size_t)(k0 + kb) * ldbk + (size_t)(n0 + nn) * ldbn] : 0.f;
        }
        __syncthreads();
#pragma unroll
        for (int kk = 0; kk < 16; ++kk) {
            float a[4], b[4];
#pragma unroll
            for (int i = 0; i < 4; ++i) { a[i] = As[kk][ty * 4 + i]; b[i] = Bs[kk][tx * 4 + i]; }
#pragma unroll
            for (int i = 0; i < 4; ++i)
#pragma unroll
                for (int j = 0; j < 4; ++j) acc[i][j] += a[i] * b[j];
        }
        __syncthreads();
    }
    for (int i = 0; i < 4; ++i) for (int j = 0; j < 4; ++j) {
        int m = m0 + ty * 4 + i, n = n0 + tx * 4 + j;
        if (n < N) { float v = acc[i][j]; if (ADD) v += R[(size_t)m * ldc + n]; C[(size_t)m * ldc + n] = v; }
    }
}

__device__ __forceinline__ float silu(float x) { return x / (1.f + expf(-x)); }

__global__ void convsilu_l2(const float* __restrict__ proj, const float* __restrict__ cw, const float* __restrict__ a_log, const float* __restrict__ dt_bias,
                            float* __restrict__ qn, float* __restrict__ kn, float* __restrict__ vv, float* __restrict__ gb) {
    const int t = blockIdx.x, h = blockIdx.y, d = threadIdx.x;
    float r[3];
    for (int p = 0; p < 3; ++p) {
        const int c = p * 512 + h * 128 + d; float s = 0.f;
        for (int k = 0; k < 4; ++k) { int tt = t - 3 + k; if (tt >= 0) s += cw[k * 1536 + c] * proj[(size_t)tt * INC + c]; }
        r[p] = silu(s);
    }
    __shared__ float red[2][128];
    red[0][d] = r[0] * r[0]; red[1][d] = r[1] * r[1]; __syncthreads();
    for (int o = 64; o > 0; o >>= 1) { if (d < o) { red[0][d] += red[0][d + o]; red[1][d] += red[1][d + o]; } __syncthreads(); }
    qn[(size_t)t * 512 + h * 128 + d] = r[0] * rsqrtf(red[0][0] + 1e-6f);
    kn[(size_t)t * 512 + h * 128 + d] = r[1] * rsqrtf(red[1][0] + 1e-6f);
    vv[(size_t)t * 512 + h * 128 + d] = r[2];
    if (d == 0) {
        float a = proj[(size_t)t * INC + 2048 + h], b = proj[(size_t)t * INC + 2052 + h];
        float xx = a + dt_bias[h]; float sp = xx > 20.f ? xx : log1pf(expf(xx));
        gb[t * 8 + h] = -expf(a_log[h]) * sp; gb[t * 8 + 4 + h] = 1.f / (1.f + expf(-b));
    }
}

__global__ void gdn_scan(const float* __restrict__ qn, const float* __restrict__ kn, const float* __restrict__ vv, const float* __restrict__ gb, float* __restrict__ o) {
    const int h = blockIdx.x / 8, sl = blockIdx.x % 8, lane = threadIdx.x, c = lane & 15, r4 = lane >> 4;
    float S[32];
#pragma unroll
    for (int i = 0; i < 32; ++i) S[i] = 0.f;
    for (int t = 0; t < SEQ; ++t) {
        const float* kp = kn + (size_t)t * 512 + h * 128 + r4 * 32; const float* qp = qn + (size_t)t * 512 + h * 128 + r4 * 32;
        const float a = expf(gb[t * 8 + h]), be = gb[t * 8 + 4 + h], v = vv[(size_t)t * 512 + h * 128 + sl * 16 + c];
        float kv[32]; float ks = 0.f;
#pragma unroll
        for (int i = 0; i < 32; ++i) { kv[i] = kp[i]; ks += kv[i] * S[i]; }
        ks += __shfl_xor(ks, 16); ks += __shfl_xor(ks, 32);
        const float vn = be * (v - a * ks);
        float os = 0.f;
#pragma unroll
        for (int i = 0; i < 32; ++i) { S[i] = a * S[i] + kv[i] * vn; os += qp[i] * S[i]; }
        os += __shfl_xor(os, 16); os += __shfl_xor(os, 32);
        if (r4 == 0) o[(size_t)t * 512 + h * 128 + sl * 16 + c] = os * 0.08838834764831845f;
    }
}

__global__ void gate_mix(const float* __restrict__ o, const float* __restrict__ proj, const float* __restrict__ gdn_g, const float* __restrict__ csw, const float* __restrict__ sc_g, float* __restrict__ mix) {
    const int t = blockIdx.x, c = threadIdx.x;
    __shared__ float red[1024];
    float val;
    if (c < 512) val = o[(size_t)t * 512 + c];
    else { const int ch = c - 512; float s = 0.f;
        for (int k = 0; k < 3; ++k) { int tt = t - 2 + k; if (tt >= 0) s += csw[k * 512 + ch] * proj[(size_t)tt * INC + 2568 + ch] * proj[(size_t)tt * INC + 3080 + ch]; }
        val = proj[(size_t)t * INC + 2056 + ch] * s; }
    red[c] = val * val; __syncthreads();
    const int gs = c < 512 ? 128 : 64;
    for (int oo = 64; oo > 0; oo >>= 1) { if (oo < gs && (c & (gs - 1)) < oo) red[c] += red[c + oo]; __syncthreads(); }
    const float ss = red[c & ~(gs - 1)];
    float r = val * rsqrtf(ss / gs + 1e-6f);
    if (c < 512) r = r * gdn_g[c & 127] * silu(proj[(size_t)t * INC + 1536 + c]);
    else r = r * sc_g[c - 512];
    mix[(size_t)t * 1024 + c] = r;
}

__global__ void softmax256(float* __restrict__ S, float scale) {
    float* r = S + (size_t)blockIdx.x * 256; float v = r[threadIdx.x] * scale;
    __shared__ float red[256];
    red[threadIdx.x] = v; __syncthreads();
    for (int o = 128; o > 0; o >>= 1) { if (threadIdx.x < o) red[threadIdx.x] = fmaxf(red[threadIdx.x], red[threadIdx.x + o]); __syncthreads(); }
    float mx = red[0]; __syncthreads();
    float e = expf(v - mx); red[threadIdx.x] = e; __syncthreads();
    for (int o = 128; o > 0; o >>= 1) { if (threadIdx.x < o) red[threadIdx.x] += red[threadIdx.x + o]; __syncthreads(); }
    r[threadIdx.x] = e / red[0];
}
__global__ void silu_mul(float* __restrict__ g, const float* __restrict__ u, size_t n) {
    size_t i = (size_t)blockIdx.x * 256 + threadIdx.x; if (i < n) g[i] = silu(g[i]) * u[i];
}

struct Bufs { float *xn, *proj, *qn, *kn, *vv, *gb, *o, *mix, *h1, *q, *memn, *k, *v, *S, *ao, *h2, *up, *h3; };
static size_t carve(Bufs& b, char* base) {
    size_t off = 0; auto take = [&](size_t bytes) { float* p = (float*)(base + off); off += (bytes + 255) & ~(size_t)255; return p; };
    b.xn = take((size_t)SEQ * D * 4); b.proj = take((size_t)SEQ * INC * 4); b.qn = take((size_t)SEQ * 512 * 4); b.kn = take((size_t)SEQ * 512 * 4); b.vv = take((size_t)SEQ * 512 * 4);
    b.gb = take((size_t)SEQ * 8 * 4); b.o = take((size_t)SEQ * 512 * 4); b.mix = take((size_t)SEQ * D * 4); b.h1 = take((size_t)SEQ * D * 4); b.q = take((size_t)SEQ * D * 4);
    b.memn = take((size_t)NMEM * D * 4); b.k = take((size_t)NMEM * D * 4); b.v = take((size_t)NMEM * D * 4); b.S = take((size_t)4 * SEQ * 256 * 4); b.ao = take((size_t)SEQ * D * 4);
    b.h2 = take((size_t)SEQ * D * 4); b.up = take((size_t)SEQ * DFF * 4); b.h3 = take((size_t)SEQ * D * 4);
    return off;
}
template <bool ADD> static void G(hipStream_t st, const float* A, long sAz, int lda, const float* B, long sBz, int ldbk, int ldbn, float* C, long sCz, int ldc, const float* R, int M, int N, int K, int Z = 1) {
    gemm<ADD><<<dim3((N + 63) / 64, M / 64, Z), 256, 0, st>>>(A, sAz, lda, B, sBz, ldbk, ldbn, C, sCz, ldc, R, M, N, K);
}
static void forward_batch(hipStream_t st, void* const* d_in, float* out, const Bufs& b, int bi, int from, int to) {
    const float* x = (const float*)d_in[0] + (size_t)bi * SEQ * D; const float* mem = (const float*)d_in[1] + (size_t)bi * NMEM * D;
    auto I = [&](int i) { return (const float*)d_in[i]; };
    float* gate = b.proj;
    for (int s = from; s <= to; ++s) switch (s) {
    case 0: rmsnorm<<<SEQ, 256, 0, st>>>(x, I(2), b.xn, D); G<false>(st, b.xn, 0, D, I(3), 0, INC, 1, b.proj, 0, INC, nullptr, SEQ, INC, D); break;
    case 1: convsilu_l2<<<dim3(SEQ, 4), 128, 0, st>>>(b.proj, I(4), I(5), I(6), b.qn, b.kn, b.vv, b.gb); break;
    case 2: gdn_scan<<<32, 64, 0, st>>>(b.qn, b.kn, b.vv, b.gb, b.o); break;
    case 3: gate_mix<<<SEQ, 1024, 0, st>>>(b.o, b.proj, I(7), I(8), I(9), b.mix); break;
    case 4: G<true>(st, b.mix, 0, D, I(10), 0, D, 1, b.h1, 0, D, x, SEQ, D, D); break;
    case 5:
        rmsnorm<<<SEQ, 256, 0, st>>>(b.h1, I(11), b.xn, D); G<false>(st, b.xn, 0, D, I(13), 0, D, 1, b.q, 0, D, nullptr, SEQ, D, D);
        rmsnorm<<<NMEM, 256, 0, st>>>(mem, I(12), b.memn, D);
        G<false>(st, b.memn, 0, D, I(14), 0, D, 1, b.k, 0, D, nullptr, NMEM, D, D); G<false>(st, b.memn, 0, D, I(15), 0, D, 1, b.v, 0, D, nullptr, NMEM, D, D);
        G<false>(st, b.q, 256, D, b.k, 256, 1, D, b.S, (long)SEQ * 256, 256, nullptr, SEQ, 256, 256, 4);
        softmax256<<<4 * SEQ, 256, 0, st>>>(b.S, 0.0625f);
        G<false>(st, b.S, (long)SEQ * 256, 256, b.v, 256, D, 1, b.ao, 256, D, nullptr, SEQ, 256, 256, 4);
        G<true>(st, b.ao, 0, D, I(16), 0, D, 1, b.h2, 0, D, b.h1, SEQ, D, D); break;
    case 6:
        rmsnorm<<<SEQ, 256, 0, st>>>(b.h2, I(17), b.xn, D);
        G<false>(st, b.xn, 0, D, I(18), 0, DFF, 1, gate, 0, DFF, nullptr, SEQ, DFF, D); G<false>(st, b.xn, 0, D, I(19), 0, DFF, 1, b.up, 0, DFF, nullptr, SEQ, DFF, D);
        silu_mul<<<(unsigned)(((size_t)SEQ * DFF + 255) / 256), 256, 0, st>>>(gate, b.up, (size_t)SEQ * DFF);
        G<true>(st, gate, 0, DFF, I(20), 0, D, 1, b.h3, 0, D, b.h2, SEQ, D, DFF); break;
    case 7: rmsnorm<<<SEQ, 256, 0, st>>>(b.h3, I(21), out + (size_t)bi * SEQ * D, D); break;
    }
}
}
extern "C" void kernel_launch(void* const* d_in, const int* in_sizes, int n_in, void* d_out, int out_size, void* d_ws, size_t ws_size, hipStream_t stream) {
    nv::Bufs b; size_t need = nv::carve(b, (char*)d_ws);
    if (need > ws_size) { fprintf(stderr, "ws too small: need %zu have %zu\n", need, ws_size); return; }
    for (int bi = 0; bi < nv::NB; ++bi) nv::forward_batch(stream, d_in, (float*)d_out, b, bi, 0, 7);
}
```

```cpp
#include <hip/hip_runtime.h>
#include <hip/hip_cooperative_groups.h>
#include <cstdio>
namespace fk {
#define FK_LAS __attribute__((address_space(3)))
#define FK_DI __device__ __forceinline__
typedef unsigned short bf16_t;
typedef short bf16x8 __attribute__((ext_vector_type(8)));
typedef float f32x2 __attribute__((ext_vector_type(2)));
typedef float f32x4 __attribute__((ext_vector_type(4)));
typedef float f32x16 __attribute__((ext_vector_type(16)));
typedef unsigned u32x2 __attribute__((ext_vector_type(2)));
typedef unsigned u32x4 __attribute__((ext_vector_type(4)));
typedef __bf16 bf16v2 __attribute__((ext_vector_type(2)));

constexpr int M = 32768, D = 1024, SEQ = 4096, NB = 8, DFF = 2816, N1 = 3584, INC = 3592, NCH = 64  , NITEM = NB * 4 * NCH;
constexpr float EPS = 1e-6f;

FK_DI unsigned pk2(float lo, float hi) { f32x2 v = {lo, hi}; bf16v2 r = __builtin_convertvector(v, bf16v2); return __builtin_bit_cast(unsigned, r); }
FK_DI float bf_lo(unsigned u) { return __uint_as_float(u << 16); }
FK_DI float bf_hi(unsigned u) { return __uint_as_float(u & 0xffff0000u); }
FK_DI float silu(float x) { return x / (1.f + __expf(-x)); }
FK_DI float wave_sum(float v) {
#pragma unroll
    for (int o = 1; o < 64; o <<= 1) v += __shfl_xor(v, o);
    return v;
}

constexpr size_t MiB = 1u << 20;
constexpr size_t WS_WIN_T = 0;
constexpr size_t WS_WOUT_T = 7 * MiB;
constexpr size_t WS_WXQ_G = 9 * MiB;
constexpr size_t WS_WXK_T = 11 * MiB;
constexpr size_t WS_WXV_T = 13 * MiB;
constexpr size_t WS_WXO_T = 15 * MiB;
constexpr size_t WS_WGU_T = 17 * MiB;
constexpr size_t WS_WDN_T = 28 * MiB;
constexpr size_t WS_WQP = 34 * MiB;
constexpr size_t WS_VWP = 50 * MiB;
constexpr size_t WS_MEMN = 66 * MiB;
constexpr size_t WS_KV = 70 * MiB;
constexpr size_t WS_GB = 78 * MiB;
constexpr size_t WS_SS1 = 79 * MiB, WS_SS2 = 81 * MiB, WS_SS3 = 83 * MiB;
constexpr size_t WS_GL = 85 * MiB;
constexpr size_t WS_QKV = 86 * MiB;
constexpr size_t WS_SC = 182 * MiB;
constexpr size_t WS_CHUNK = 278 * MiB;
constexpr size_t WS_MIX = 422 * MiB;
constexpr size_t WS_END = 486 * MiB;
constexpr size_t WS_HB = WS_QKV;
constexpr size_t WS_P = WS_SC;
constexpr size_t WS_ACT = 246 * MiB;
constexpr size_t DO_XN = 0, DO_Z = 64 * MiB;
constexpr int CH_WF = 0, CH_KDF = 16384, CH_QDF = 32768, CH_ATF = 49152, CH_UC = 57344, CH_BYTES = 73728;

struct Params {
    const float* in[22];
    float* out; unsigned char* ws;
    int dbg_lo, dbg_hi;
};
}
namespace fk {
constexpr int BM = 256, BK = 64, HALF = 128, HTB = HALF * BK * 2, STAGE_BYTES = 8 * HTB, NXCD = 8, WGM = 8;
constexpr int LDS_EXCH = STAGE_BYTES;
constexpr int LDS_TOTAL = STAGE_BYTES + 16384;

FK_DI int lds_byte(int r, int c) { const int st = (r >> 4) * 2 + (c >> 5), rr = r & 15, cc = c & 31, ob = rr * 64 + cc * 2; return st * 1024 + (ob ^ (((ob >> 9) & 1) << 5)); }
FK_DI void stage_rc(int b, int& R, int& C) { const int st = b / 1024, sb = b % 1024, swz = sb ^ (((sb >> 9) & 1) << 5); R = (st >> 1) * 16 + swz / 64; C = (st & 1) * 32 + (swz % 64) / 2; }
FK_DI int perm32(int rho) { const int n = rho >> 4, i = rho & 15; return 8 * (i >> 2) + 4 * n + (i & 3); }

struct Unit { int pm, pn; };

struct TileOrder {
    int nM, nN, nwg, G, c;
    FK_DI void init(int nM_, int nN_, int G_, int c_) { nM = nM_; nN = nN_; nwg = nM * nN; G = G_; c = c_; }
    FK_DI bool next(int i, Unit& u) const {
        const long L = (long)i * G + c; if (L >= nwg) return false;
        int wgid = (int)L; { const int q = nwg / NXCD, r = nwg % NXCD, xcd = wgid % NXCD, off = wgid / NXCD; wgid = (xcd < r ? xcd * (q + 1) : r * (q + 1) + (xcd - r) * q) + off; }
        const int nig = WGM * nN, gid = wgid / nig, fm = gid * WGM, gsz = (nM - fm) < WGM ? (nM - fm) : WGM;
        u.pm = fm + ((wgid % nig) % gsz); u.pn = (wgid % nig) / gsz; return true;
    }
};
struct ProbStd {
    const char* A; const char* Bt; int lda, ldb, K; size_t b_bstride; TileOrder T;
    FK_DI bool next(int i, Unit& u) const { return T.next(i, u); }
    FK_DI const char* aptr(const Unit& u) const { return A + (size_t)u.pm * 256 * lda * 2; }
    FK_DI const char* bptr(const Unit& u) const { return Bt + (size_t)u.pn * 256 * ldb * 2 + (size_t)(u.pm >> 4) * b_bstride; }
};

typedef f32x4 Acc[2][2][4][2];

template <class Epi, class Prob, bool ALIGN_EPI, bool SP2>
FK_DI void gemm_phase(FK_LAS unsigned char* lds, const Prob& S, const Epi& E) {
    const int tid = threadIdx.x, wid = __builtin_amdgcn_readfirstlane(tid >> 6), lane = tid & 63, wr = wid >> 2, wc = wid & 3, fr = lane & 15, fq = lane >> 4;
    const int K = S.K, nt = K / BK, lda = S.lda, ldb = S.ldb;
    unsigned voffA[2], voffB[2];
#pragma unroll
    for (int i = 0; i < 2; ++i) { int R, C; stage_rc(tid * 16 + i * 8192, R, C); const int Rb = Epi::PERM ? ((R & ~31) + perm32(R & 31)) : R;
        voffA[i] = (unsigned)(R * lda + C) * 2u; voffB[i] = (unsigned)(Rb * ldb + C) * 2u; }
    const size_t kstep = (size_t)(BK * 2);
    const size_t hstepA = (size_t)HALF * lda * 2, hstepB = (size_t)HALF * ldb * 2;
    const unsigned ldsw = (unsigned)wid * 1024u;
    const int aoff = lds_byte(wr * 64 + fr, fq * 8), boff = lds_byte(wc * 32 + fr, fq * 8);
#define PG8_SA(b, h) (((b) * 2 + (h)) * HTB)
#define PG8_SB(b, h) ((4 + (b) * 2 + (h)) * HTB)
#define PG8_STAGE(bufoff, gbase, voff) do { _Pragma("unroll") for (int _i = 0; _i < 2; ++_i) \
        __builtin_amdgcn_global_load_lds((const unsigned*)((const char*)(gbase) + (voff)[_i]), (FK_LAS unsigned*)(lds + (bufoff) + ldsw + _i * 8192), 16, 0, 0); } while (0)
#define PG8_LDA(dst, b, h) do { _Pragma("unroll") for (int m = 0; m < 4; ++m) _Pragma("unroll") for (int k = 0; k < 2; ++k) dst[m][k] = *(const FK_LAS bf16x8*)(lds + PG8_SA(b, h) + aoff + m * 2048 + k * 1024); } while (0)
#define PG8_LDB(dst, b, h) do { _Pragma("unroll") for (int n = 0; n < 2; ++n) _Pragma("unroll") for (int k = 0; k < 2; ++k) dst[n][k] = *(const FK_LAS bf16x8*)(lds + PG8_SB(b, h) + boff + n * 2048 + k * 1024); } while (0)
#define PG8_MMA(ai, bj, At, Bt) do { __builtin_amdgcn_s_setprio(1); _Pragma("unroll") for (int m = 0; m < 4; ++m) _Pragma("unroll") for (int n = 0; n < 2; ++n) _Pragma("unroll") for (int k = 0; k < 2; ++k) \
        acc[ai][bj][m][n] = __builtin_amdgcn_mfma_f32_16x16x32_bf16(Bt[n][k], At[m][k], acc[ai][bj][m][n], 0, 0, 0); __builtin_amdgcn_s_setprio(0); } while (0)
#define PG8_WAIT_V(n) asm volatile("s_waitcnt vmcnt(" #n ")" ::: "memory")
#define PG8_WAIT_L(n) asm volatile("s_waitcnt lgkmcnt(" #n ")" ::: "memory")
#define PG8_BAR __builtin_amdgcn_s_barrier()
#define PG8_SCHED __builtin_amdgcn_sched_barrier(0)
    Unit cur, nxt; int ui = 0;
    if (!S.next(0, cur)) return;
    Acc acc;
#pragma unroll
    for (int a = 0; a < 2; ++a)
#pragma unroll
        for (int b = 0; b < 2; ++b)
#pragma unroll
            for (int m = 0; m < 4; ++m)
#pragma unroll
                for (int n = 0; n < 2; ++n) acc[a][b][m][n] = (f32x4){0.f, 0.f, 0.f, 0.f};
    bf16x8 At[4][2], B0[2][2], B1[2][2];
    const char* cA = S.aptr(cur); const char* cB = S.bptr(cur);
    if constexpr (SP2) {
        PG8_STAGE(PG8_SB(0, 0), cB, voffB); PG8_STAGE(PG8_SB(0, 1), cB + hstepB, voffB); PG8_STAGE(PG8_SA(0, 0), cA, voffA); PG8_STAGE(PG8_SA(0, 1), cA + hstepA, voffA);
        if (wr == 1) PG8_BAR;
        PG8_WAIT_V(2); PG8_BAR;
        PG8_STAGE(PG8_SB(1, 0), cB + kstep, voffB); PG8_STAGE(PG8_SA(1, 0), cA + kstep, voffA); PG8_STAGE(PG8_SB(1, 1), cB + hstepB + kstep, voffB);
        PG8_WAIT_V(6); PG8_BAR;
    } else {
        PG8_STAGE(PG8_SB(0, 0), cB, voffB); PG8_STAGE(PG8_SA(0, 0), cA, voffA); PG8_STAGE(PG8_SB(0, 1), cB + hstepB, voffB); PG8_STAGE(PG8_SA(0, 1), cA + hstepA, voffA);
        if (wr == 1) PG8_BAR;
        PG8_WAIT_V(4); PG8_BAR;
        PG8_STAGE(PG8_SB(1, 0), cB + kstep, voffB); PG8_STAGE(PG8_SA(1, 0), cA + kstep, voffA); PG8_STAGE(PG8_SB(1, 1), cB + hstepB + kstep, voffB);
        PG8_WAIT_V(6); PG8_BAR;
    }
    for (;;) {
        const bool has_next = S.next(ui + 1, nxt);
        const char* nA = has_next ? S.aptr(nxt) : cA; const char* nB = has_next ? S.bptr(nxt) : cB;
        for (int t = 0; t < nt; t += 2) {
            const bool last = (t == nt - 2);
            const char* a1 = cA + (size_t)(t + 1) * kstep;
            const char* a2 = last ? nA : cA + (size_t)(t + 2) * kstep; const char* b2 = last ? nB : cB + (size_t)(t + 2) * kstep;
            const char* a3 = a2 + kstep; const char* b3 = b2 + kstep;
            if constexpr (SP2) {
            PG8_LDB(B0, 0, 0); PG8_LDB(B1, 0, 1); PG8_SCHED; PG8_LDA(At, 0, 0); PG8_STAGE(PG8_SA(1, 1), a1 + hstepA, voffA);
            PG8_WAIT_V(8); PG8_WAIT_L(0); PG8_BAR; PG8_MMA(0, 0, At, B0); PG8_MMA(0, 1, At, B1); PG8_BAR; PG8_SCHED;
            PG8_LDA(At, 0, 1); PG8_STAGE(PG8_SB(0, 0), b2, voffB); PG8_STAGE(PG8_SB(0, 1), b2 + hstepB, voffB); PG8_STAGE(PG8_SA(0, 0), a2, voffA);
            PG8_WAIT_V(8); PG8_WAIT_L(0); PG8_BAR; PG8_MMA(1, 0, At, B0); PG8_MMA(1, 1, At, B1); PG8_BAR; PG8_SCHED;
            PG8_LDB(B0, 1, 0); PG8_LDB(B1, 1, 1); PG8_SCHED; PG8_LDA(At, 1, 0); PG8_STAGE(PG8_SA(0, 1), a2 + hstepA, voffA);
            PG8_WAIT_V(8); PG8_WAIT_L(0); PG8_BAR; PG8_MMA(0, 0, At, B0); PG8_MMA(0, 1, At, B1); PG8_BAR; PG8_SCHED;
            PG8_LDA(At, 1, 1); PG8_STAGE(PG8_SB(1, 0), b3, voffB); PG8_STAGE(PG8_SB(1, 1), b3 + hstepB, voffB); PG8_STAGE(PG8_SA(1, 0), a3, voffA);
            PG8_WAIT_V(8); PG8_WAIT_L(0); PG8_BAR; PG8_MMA(1, 0, At, B0); PG8_MMA(1, 1, At, B1); PG8_BAR; PG8_SCHED;
            } else {
            PG8_LDB(B0, 0, 0); PG8_SCHED; PG8_LDA(At, 0, 0); PG8_STAGE(PG8_SA(1, 1), a1 + hstepA, voffA);
            PG8_WAIT_L(8); PG8_BAR; PG8_WAIT_L(0); PG8_MMA(0, 0, At, B0); PG8_BAR; PG8_SCHED;
            PG8_LDB(B1, 0, 1); PG8_STAGE(PG8_SB(0, 0), b2, voffB);
            PG8_BAR; PG8_WAIT_L(0); PG8_MMA(0, 1, At, B1); PG8_BAR;
            PG8_LDA(At, 0, 1); PG8_STAGE(PG8_SA(0, 0), a2, voffA);
            PG8_BAR; PG8_WAIT_L(0); PG8_MMA(1, 0, At, B0); PG8_BAR; PG8_SCHED;
            PG8_STAGE(PG8_SB(0, 1), b2 + hstepB, voffB);
            PG8_WAIT_V(6); PG8_BAR; PG8_MMA(1, 1, At, B1); PG8_BAR;
            PG8_LDB(B0, 1, 0); PG8_SCHED; PG8_LDA(At, 1, 0); PG8_STAGE(PG8_SA(0, 1), a2 + hstepA, voffA);
            PG8_WAIT_L(8); PG8_BAR; PG8_WAIT_L(0); PG8_MMA(0, 0, At, B0); PG8_BAR; PG8_SCHED;
            PG8_LDB(B1, 1, 1); PG8_STAGE(PG8_SB(1, 0), b3, voffB);
            PG8_BAR; PG8_WAIT_L(0); PG8_MMA(0, 1, At, B1); PG8_BAR;
            PG8_LDA(At, 1, 1); PG8_STAGE(PG8_SA(1, 0), a3, voffA);
            PG8_BAR; PG8_WAIT_L(0); PG8_MMA(1, 0, At, B0); PG8_BAR; PG8_SCHED;
            PG8_STAGE(PG8_SB(1, 1), b3 + hstepB, voffB);
            PG8_WAIT_V(6); PG8_BAR; PG8_MMA(1, 1, At, B1); PG8_BAR;
            }
        }
        if constexpr (ALIGN_EPI) { if (wr == 0) PG8_BAR; }
        E(acc, cur, wr, wc, fr, fq, lds);
        if (!has_next) break;
#pragma unroll
        for (int a = 0; a < 2; ++a)
#pragma unroll
            for (int b = 0; b < 2; ++b)
#pragma unroll
                for (int m = 0; m < 4; ++m)
#pragma unroll
                    for (int n = 0; n < 2; ++n) acc[a][b][m][n] = (f32x4){0.f, 0.f, 0.f, 0.f};
        cur = nxt; cA = nA; cB = nB; ++ui;
        if constexpr (ALIGN_EPI) { if (wr == 1) PG8_BAR; }
    }
    PG8_WAIT_V(0);
    if constexpr (!ALIGN_EPI) { if (wr == 0) PG8_BAR; }
    PG8_BAR;
#undef PG8_SA
#undef PG8_SB
#undef PG8_STAGE
#undef PG8_LDA
#undef PG8_LDB
#undef PG8_MMA
#undef PG8_WAIT_V
#undef PG8_WAIT_L
#undef PG8_BAR
#undef PG8_SCHED
}

struct EpiBf16Split {
    static constexpr bool PERM = true;
    bf16_t* o0; bf16_t* o1; bf16_t* o2; int t1, t2;
    int ld0, ld1, ld2;
    FK_DI void operator()(Acc& acc, const Unit& u, int wr, int wc, int fr, int fq, FK_LAS unsigned char*) const {
        bf16_t* base; int ld, ct;
        if (u.pn < t1) { base = o0; ld = ld0; ct = u.pn; } else if (u.pn < t2) { base = o1; ld = ld1; ct = u.pn - t1; } else { base = o2; ld = ld2; ct = u.pn - t2; }
        const int row0 = u.pm * BM + wr * 64 + fr, col0 = ct * BM + wc * 32 + 8 * fq;
#pragma unroll
        for (int ai = 0; ai < 2; ++ai)
#pragma unroll
            for (int m = 0; m < 4; ++m) { bf16_t* rowp = base + (size_t)(row0 + ai * HALF + m * 16) * ld + col0;
#pragma unroll
                for (int bj = 0; bj < 2; ++bj) { const f32x4 v0 = acc[ai][bj][m][0], v1 = acc[ai][bj][m][1];
                    u32x4 w; w.x = pk2(v0[0], v0[1]); w.y = pk2(v0[2], v0[3]); w.z = pk2(v1[0], v1[1]); w.w = pk2(v1[2], v1[3]);
                    *(u32x4*)(rowp + bj * HALF) = w; } }
    }
};
struct EpiBf16At {
    static constexpr bool PERM = true;
    bf16_t* o; int ld; size_t pm_stride, pn_stride;
    FK_DI void operator()(Acc& acc, const Unit& u, int wr, int wc, int fr, int fq, FK_LAS unsigned char*) const {
        bf16_t* base = o + (size_t)u.pm * pm_stride + (size_t)u.pn * pn_stride;
        const int row0 = wr * 64 + fr, col0 = wc * 32 + 8 * fq;
#pragma unroll
        for (int ai = 0; ai < 2; ++ai)
#pragma unroll
            for (int m = 0; m < 4; ++m) { bf16_t* rowp = base + (size_t)(row0 + ai * HALF + m * 16) * ld + col0;
#pragma unroll
                for (int bj = 0; bj < 2; ++bj) { const f32x4 v0 = acc[ai][bj][m][0], v1 = acc[ai][bj][m][1];
                    u32x4 w; w.x = pk2(v0[0], v0[1]); w.y = pk2(v0[2], v0[3]); w.z = pk2(v1[0], v1[1]); w.w = pk2(v1[2], v1[3]);
                    *(u32x4*)(rowp + bj * HALF) = w; } }
    }
};
struct EpiResid {
    static constexpr bool PERM = false;
    const float* base; float* hout; bf16_t* hb; float* ss;
    FK_DI void operator()(Acc& acc, const Unit& u, int wr, int wc, int fr, int fq, FK_LAS unsigned char*) const {
        const int row0 = u.pm * BM + wr * 64 + fr, col0 = u.pn * BM + wc * 32 + 4 * fq;
#pragma unroll
        for (int ai = 0; ai < 2; ++ai)
#pragma unroll
            for (int m = 0; m < 4; ++m) { const int row = row0 + ai * HALF + m * 16; const size_t off = (size_t)row * D + col0; float s = 0.f;
#pragma unroll
                for (int bj = 0; bj < 2; ++bj)
#pragma unroll
                    for (int n = 0; n < 2; ++n) { const f32x4 bs = *(const f32x4*)(base + off + bj * HALF + n * 16); const f32x4 o = bs + acc[ai][bj][m][n];
                        *(f32x4*)(hout + off + bj * HALF + n * 16) = o; s += (o[0] * o[0] + o[1] * o[1]) + (o[2] * o[2] + o[3] * o[3]);
                        if (hb) { u32x2 w; w.x = pk2(o[0], o[1]); w.y = pk2(o[2], o[3]); *(u32x2*)(hb + off + bj * HALF + n * 16) = w; } }
                s += __shfl_xor(s, 16); s += __shfl_xor(s, 32);
                if (fq == 0) ss[(size_t)row * 16 + u.pn * 4 + wc] = s;
                asm volatile("" ::: "memory"); }
    }
};
FK_DI float row_rstd(const float* ss, int row) {
    const f32x4* p = (const f32x4*)(ss + (size_t)row * 16); const f32x4 a = p[0], b = p[1], c = p[2], d = p[3];
    const float s = ((a[0] + a[1]) + (a[2] + a[3])) + ((b[0] + b[1]) + (b[2] + b[3])) + ((c[0] + c[1]) + (c[2] + c[3])) + ((d[0] + d[1]) + (d[2] + d[3]));
    return rsqrtf(s * (1.f / 1024.f) + EPS);
}
struct EpiSoftmax {
    static constexpr bool PERM = true;
    const float* ss; bf16_t* P;
    FK_DI void operator()(Acc& acc, const Unit& u, int wr, int wc, int fr, int fq, FK_LAS unsigned char* lds) const {
        FK_LAS f32x2* X = (FK_LAS f32x2*)(lds + LDS_EXCH);
        const int row0 = u.pm * BM + wr * 64 + fr;
#pragma unroll
        for (int ai = 0; ai < 2; ++ai)
#pragma unroll
            for (int m = 0; m < 4; ++m) { const int rl = ai * HALF + wr * 64 + m * 16 + fr; const float rs = row_rstd(ss, u.pm * BM + rl);
                float mx = -3.0e38f;
#pragma unroll
                for (int bj = 0; bj < 2; ++bj)
#pragma unroll
                    for (int n = 0; n < 2; ++n) { f32x4 v = acc[ai][bj][m][n] * rs; acc[ai][bj][m][n] = v; mx = fmaxf(fmaxf(mx, fmaxf(v[0], v[1])), fmaxf(v[2], v[3])); }
                mx = fmaxf(mx, __shfl_xor(mx, 16)); mx = fmaxf(mx, __shfl_xor(mx, 32));
                float sm = 0.f;
#pragma unroll
                for (int bj = 0; bj < 2; ++bj)
#pragma unroll
                    for (int n = 0; n < 2; ++n) { f32x4 v = acc[ai][bj][m][n];
#pragma unroll
                        for (int j = 0; j < 4; ++j) { v[j] = __expf(v[j] - mx); sm += v[j]; }
                        acc[ai][bj][m][n] = v; }
                sm += __shfl_xor(sm, 16); sm += __shfl_xor(sm, 32);
                if (fq == 0) X[rl * 4 + wc] = (f32x2){mx, sm};
            }
        asm volatile("s_waitcnt lgkmcnt(0)" ::: "memory"); __builtin_amdgcn_s_barrier(); asm volatile("" ::: "memory");
#pragma unroll
        for (int ai = 0; ai < 2; ++ai)
#pragma unroll
            for (int m = 0; m < 4; ++m) { const int rl = ai * HALF + wr * 64 + m * 16 + fr;
                const f32x2 x0 = X[rl * 4 + 0], x1 = X[rl * 4 + 1], x2 = X[rl * 4 + 2], x3 = X[rl * 4 + 3];
                const float Mx = fmaxf(fmaxf(x0.x, x1.x), fmaxf(x2.x, x3.x));
                const float tot = x0.y * __expf(x0.x - Mx) + x1.y * __expf(x1.x - Mx) + x2.y * __expf(x2.x - Mx) + x3.y * __expf(x3.x - Mx);
                const float mine = wc == 0 ? x0.x : (wc == 1 ? x1.x : (wc == 2 ? x2.x : x3.x));
                const float sc = __expf(mine - Mx) / tot;
                bf16_t* rowp = P + (size_t)(row0 + ai * HALF + m * 16) * D + u.pn * BM + wc * 32 + 8 * fq;
#pragma unroll
                for (int bj = 0; bj < 2; ++bj) { const f32x4 v0 = acc[ai][bj][m][0] * sc, v1 = acc[ai][bj][m][1] * sc;
                    u32x4 w; w.x = pk2(v0[0], v0[1]); w.y = pk2(v0[2], v0[3]); w.z = pk2(v1[0], v1[1]); w.w = pk2(v1[2], v1[3]);
                    *(u32x4*)(rowp + bj * HALF) = w; } }
        asm volatile("s_waitcnt lgkmcnt(0)" ::: "memory"); __builtin_amdgcn_s_barrier(); asm volatile("" ::: "memory");
    }
};
struct EpiGateUp {
    static constexpr bool PERM = true;
    const float* ss; bf16_t* act;
    FK_DI void operator()(Acc& acc, const Unit& u, int wr, int wc, int fr, int fq, FK_LAS unsigned char*) const {
        const int row0 = u.pm * BM + wr * 64 + fr, col0 = u.pn * HALF + wc * 32 + 8 * fq;
#pragma unroll
        for (int ai = 0; ai < 2; ++ai)
#pragma unroll
            for (int m = 0; m < 4; ++m) { const int row = row0 + ai * HALF + m * 16; const float rs = row_rstd(ss, row);
                u32x4 w;
#pragma unroll
                for (int n = 0; n < 2; ++n) { const f32x4 g = acc[ai][0][m][n] * rs, up = acc[ai][1][m][n] * rs;
                    w[2 * n] = pk2(silu(g[0]) * up[0], silu(g[1]) * up[1]); w[2 * n + 1] = pk2(silu(g[2]) * up[2], silu(g[3]) * up[3]); }
                *(u32x4*)(act + (size_t)row * DFF + col0) = w; }
    }
};
}
namespace fk {
template <class Src>
FK_DI void transpose_item(const Src& src, int ldw, int K, bf16_t* WT, const float* gk, FK_LAS float* scr, int kb, int nb, int lane) {
    const int k0 = 64 * kb, n0 = 32 * nb;
    const float* colp = src(n0 + (lane & 31));
#pragma unroll 8
    for (int i = 0; i < 32; ++i) { const int kk = 2 * i + (lane >> 5); float v = colp[(size_t)(k0 + kk) * ldw]; if (gk) v *= gk[k0 + kk]; scr[kk * 33 + (lane & 31)] = v; }
    asm volatile("s_waitcnt lgkmcnt(0)" ::: "memory");
    const int c = lane & 7;
#pragma unroll
    for (int j = 0; j < 4; ++j) { const int n = (lane >> 3) + 8 * j; const FK_LAS float* s = scr + (8 * c) * 33 + n;
        u32x4 o; o.x = pk2(s[0 * 33], s[1 * 33]); o.y = pk2(s[2 * 33], s[3 * 33]); o.z = pk2(s[4 * 33], s[5 * 33]); o.w = pk2(s[6 * 33], s[7 * 33]);
        *(u32x4*)(WT + (size_t)(n0 + n) * K + k0 + 8 * c) = o; }
    asm volatile("s_waitcnt lgkmcnt(0)" ::: "memory");
}

FK_DI void p0_prologue(const Params& p, FK_LAS unsigned char* lds, int gw, int NGW, int wave, int lane) {
    unsigned char* ws = p.ws;
    FK_LAS float* scr = (FK_LAS float*)(lds + wave * 16384);
    const float* w_in = p.in[3]; const float* w_out = p.in[10]; const float* w_xq = p.in[13]; const float* w_xk = p.in[14]; const float* w_xv = p.in[15];
    const float* w_xo = p.in[16]; const float* w_gate = p.in[18]; const float* w_up = p.in[19]; const float* w_down = p.in[20];
    const float* g_mix = p.in[2]; const float* g_x = p.in[11]; const float* g_mem = p.in[12]; const float* g_ffn = p.in[17];
    constexpr int I_IN = (D / 64) * (N1 / 32), I_SQ = (D / 64) * (D / 32), I_GU = (D / 64) * (2 * DFF / 32), I_DN = (DFF / 64) * (D / 32);
    constexpr int NITEMS = I_IN + 4 * I_SQ + I_GU + I_DN;
    for (int it = gw; it < NITEMS; it += NGW) {
        int r = it;
        if (r < I_IN) { auto src = [&](int n) { return w_in + (n < 2048 ? n : n + 8); }; transpose_item(src, INC, D, (bf16_t*)(ws + WS_WIN_T), (const float*)nullptr, scr, r / (N1 / 32), r % (N1 / 32), lane); continue; } r -= I_IN;
        if (r < I_SQ) { auto src = [&](int n) { return w_out + n; }; transpose_item(src, D, D, (bf16_t*)(ws + WS_WOUT_T), (const float*)nullptr, scr, r / 32, r % 32, lane); continue; } r -= I_SQ;
        if (r < I_SQ) { auto src = [&](int n) { return w_xk + n; }; transpose_item(src, D, D, (bf16_t*)(ws + WS_WXK_T), (const float*)nullptr, scr, r / 32, r % 32, lane); continue; } r -= I_SQ;
        if (r < I_SQ) { auto src = [&](int n) { return w_xv + n; }; transpose_item(src, D, D, (bf16_t*)(ws + WS_WXV_T), (const float*)nullptr, scr, r / 32, r % 32, lane); continue; } r -= I_SQ;
        if (r < I_SQ) { auto src = [&](int n) { return w_xo + n; }; transpose_item(src, D, D, (bf16_t*)(ws + WS_WXO_T), (const float*)nullptr, scr, r / 32, r % 32, lane); continue; } r -= I_SQ;
        if (r < I_GU) { auto src = [&](int n) { const int blk = n >> 8, w = n & 255; return (w < 128 ? w_gate + blk * 128 + w : w_up + blk * 128 + (w - 128)); };
            transpose_item(src, DFF, D, (bf16_t*)(ws + WS_WGU_T), g_ffn, scr, r / (2 * DFF / 32), r % (2 * DFF / 32), lane); continue; } r -= I_GU;
        { auto src = [&](int n) { return w_down + n; }; transpose_item(src, D, DFF, (bf16_t*)(ws + WS_WDN_T), (const float*)nullptr, scr, r / 32, r % 32, lane); }
    }
    for (int k = gw; k < D; k += NGW) { const float sc = g_x[k] * 0.0625f; const f32x4* s = (const f32x4*)(w_xq + (size_t)k * D) + lane; u32x2* o = (u32x2*)((bf16_t*)(ws + WS_WXQ_G) + (size_t)k * D) + lane;
#pragma unroll
        for (int j = 0; j < 4; ++j) { const f32x4 v = s[64 * j] * sc; u32x2 w; w.x = pk2(v[0], v[1]); w.y = pk2(v[2], v[3]); o[64 * j] = w; } }
    for (int m = gw; m < NB * 256; m += NGW) { const f32x4* xr = (const f32x4*)(p.in[1] + (size_t)m * D) + lane; f32x4 v[4]; float s = 0.f;
#pragma unroll
        for (int j = 0; j < 4; ++j) { v[j] = xr[64 * j]; s += (v[j][0] * v[j][0] + v[j][1] * v[j][1]) + (v[j][2] * v[j][2] + v[j][3] * v[j][3]); }
        const float rs = rsqrtf(wave_sum(s) * (1.f / D) + EPS); u32x2* o = (u32x2*)((bf16_t*)(ws + WS_MEMN) + (size_t)m * D) + lane;
#pragma unroll
        for (int j = 0; j < 4; ++j) { const f32x4 g = ((const f32x4*)g_mem)[lane + 64 * j]; const f32x4 y = v[j] * rs * g; u32x2 w; w.x = pk2(y[0], y[1]); w.y = pk2(y[2], y[3]); o[64 * j] = w; } }
    {
        f32x4 gm[4]; f32x4 wab[4][4][2];
#pragma unroll
        for (int j = 0; j < 4; ++j) { gm[j] = ((const f32x4*)g_mix)[lane + 64 * j];
#pragma unroll
            for (int e = 0; e < 4; ++e) { const int k = 4 * lane + 256 * j + e; const f32x4* wp = (const f32x4*)(w_in + (size_t)k * INC + 2048); wab[j][e][0] = wp[0] * gm[j][e]; wab[j][e][1] = wp[1] * gm[j][e]; } }
        const float* a_log = p.in[5]; const float* dt_bias = p.in[6];
        bf16_t* XN = (bf16_t*)((unsigned char*)p.out + DO_XN); float* GB = (float*)(ws + WS_GB);
        for (int m = gw; m < M; m += NGW) { const f32x4* xr = (const f32x4*)(p.in[0] + (size_t)m * D) + lane; f32x4 v[4]; float s = 0.f;
#pragma unroll
            for (int j = 0; j < 4; ++j) { v[j] = xr[64 * j]; s += (v[j][0] * v[j][0] + v[j][1] * v[j][1]) + (v[j][2] * v[j][2] + v[j][3] * v[j][3]); }
            const float rs = rsqrtf(wave_sum(s) * (1.f / D) + EPS);
            f32x4 d0 = {0.f, 0.f, 0.f, 0.f}, d1 = {0.f, 0.f, 0.f, 0.f};
            u32x2* o = (u32x2*)(XN + (size_t)m * D) + lane;
#pragma unroll
            for (int j = 0; j < 4; ++j) { const f32x4 xs = v[j] * rs; const f32x4 y = xs * gm[j]; u32x2 w; w.x = pk2(y[0], y[1]); w.y = pk2(y[2], y[3]); o[64 * j] = w;
#pragma unroll
                for (int e = 0; e < 4; ++e) { d0 += wab[j][e][0] * xs[e]; d1 += wab[j][e][1] * xs[e]; } }
            float r8[8] = {d0[0], d0[1], d0[2], d0[3], d1[0], d1[1], d1[2], d1[3]};
#pragma unroll
            for (int q = 0; q < 8; ++q) r8[q] = wave_sum(r8[q]);
            float mine = r8[0];
#pragma unroll
            for (int q = 1; q < 8; ++q) mine = (lane == q) ? r8[q] : mine;
            if (lane < 4) { const float xx = mine + dt_bias[lane]; const float sp = xx > 20.f ? xx : log1pf(__expf(xx)); GB[(size_t)m * 8 + lane] = -__expf(a_log[lane]) * sp; }
            else if (lane < 8) { GB[(size_t)m * 8 + lane] = 1.f / (1.f + __expf(-mine)); }
        }
    }
}

FK_DI void p9_final(const Params& p, int gw, int NGW, int lane) {
    const float* ss = (const float*)(p.ws + WS_SS3); const f32x4* g = (const f32x4*)p.in[21];
    f32x4 gm[4];
#pragma unroll
    for (int j = 0; j < 4; ++j) gm[j] = g[lane + 64 * j];
    for (int m = gw; m < M; m += NGW) { const float rs = row_rstd(ss, m); f32x4* xr = (f32x4*)(p.out + (size_t)m * D) + lane;
#pragma unroll
        for (int j = 0; j < 4; ++j) xr[64 * j] = xr[64 * j] * rs * gm[j]; }
}
}
namespace fk {
#define FK_MFMA32(a, b, c) __builtin_amdgcn_mfma_f32_32x32x16_bf16((a), (b), (c), 0, 0, 0)
FK_DI int crow(int reg, int h) { return (reg & 3) + 8 * (reg >> 2) + 4 * h; }
FK_DI bf16x8 pack8(const f32x16& x, int s) {
    u32x4 p; p.x = pk2(x[8 * s], x[8 * s + 1]); p.y = pk2(x[8 * s + 2], x[8 * s + 3]); p.z = pk2(x[8 * s + 4], x[8 * s + 5]); p.w = pk2(x[8 * s + 6], x[8 * s + 7]);
    return __builtin_bit_cast(bf16x8, p);
}
FK_DI f32x16 zero16() { f32x16 z; for (int i = 0; i < 16; ++i) z[i] = 0.f; return z; }

constexpr int PL_QS = 0, PL_KS = 17408, PL_KT = 34816, PL_VT = 53248, PL_AF = 71680, PL_TP = 88064, PL_TPP = 97280, PL_TAB = 106496;
constexpr int QS_LD = 136, KT_LD = 72, TP_LD = 72;

FK_DI void p2_short_conv(const Params& p, int gw, int lane) {
    const bf16_t* SC = (const bf16_t*)(p.ws + WS_SC); bf16_t* MIX = (bf16_t*)(p.ws + WS_MIX);
    const float* csw = p.in[8]; const float* scg = p.in[9];
    float w0[8], w1[8], w2[8], g[8];
#pragma unroll
    for (int e = 0; e < 8; ++e) { w0[e] = csw[8 * lane + e]; w1[e] = csw[512 + 8 * lane + e]; w2[e] = csw[1024 + 8 * lane + e]; g[e] = scg[8 * lane + e]; }
    const int r0 = gw * 16;
    float p1[8], p2[8];
    auto prod = [&](int row, float* o) {
        const u32x4 c = *(const u32x4*)(SC + (size_t)row * 1536 + 512 + 8 * lane), hh = *(const u32x4*)(SC + (size_t)row * 1536 + 1024 + 8 * lane);
        #pragma unroll
        for (int q = 0; q < 4; ++q) { o[2 * q] = bf_lo(c[q]) * bf_lo(hh[q]); o[2 * q + 1] = bf_hi(c[q]) * bf_hi(hh[q]); }
    };
    const int t0 = r0 & (SEQ - 1);
    if (t0 >= 1) prod(r0 - 1, p1); else { for (int e = 0; e < 8; ++e) p1[e] = 0.f; }
    if (t0 >= 2) prod(r0 - 2, p2); else { for (int e = 0; e < 8; ++e) p2[e] = 0.f; }
    for (int i = 0; i < 16; ++i) { const int row = r0 + i; float p0[8]; prod(row, p0);
        const u32x4 b = *(const u32x4*)(SC + (size_t)row * 1536 + 8 * lane); float y[8]; float s = 0.f;
#pragma unroll
        for (int e = 0; e < 8; ++e) { const float bb = (e & 1) ? bf_hi(b[e >> 1]) : bf_lo(b[e >> 1]); y[e] = bb * (w0[e] * p2[e] + w1[e] * p1[e] + w2[e] * p0[e]); s += y[e] * y[e]; }
        s += __shfl_xor(s, 1); s += __shfl_xor(s, 2); s += __shfl_xor(s, 4);
        const float rs = rsqrtf(s * (1.f / 64.f) + EPS);
        u32x4 o; o.x = pk2(y[0] * rs * g[0], y[1] * rs * g[1]); o.y = pk2(y[2] * rs * g[2], y[3] * rs * g[3]); o.z = pk2(y[4] * rs * g[4], y[5] * rs * g[5]); o.w = pk2(y[6] * rs * g[6], y[7] * rs * g[7]);
        *(u32x4*)(MIX + (size_t)row * D + 512 + 8 * lane) = o;
#pragma unroll
        for (int e = 0; e < 8; ++e) { p2[e] = p1[e]; p1[e] = p0[e]; }
    }
}

FK_DI void p2_item(const Params& p, FK_LAS unsigned char* lds, int it, int tid_in, int wave, int lane_in) {
    int tid = tid_in, lane = lane_in; asm volatile("" : "+v"(tid), "+v"(lane));
    const int n = it & 63, h = (it >> 6) & 3, b = it >> 8;
    const bf16_t* QKV = (const bf16_t*)(p.ws + WS_QKV); const float* GB = (const float*)(p.ws + WS_GB); const float* cw = p.in[4];
    unsigned char* item = p.ws + WS_CHUNK + (size_t)it * CH_BYTES;
    FK_LAS float* TAB = (FK_LAS float*)(lds + PL_TAB);
    const int grow0 = b * SEQ + n * 64;
    if (wave == 0) {
        float g = GB[(size_t)(grow0 + lane) * 8 + h]; const float be = GB[(size_t)(grow0 + lane) * 8 + 4 + h];
#pragma unroll
        for (int o = 1; o < 64; o <<= 1) { const float t = __shfl_up(g, o); if (lane >= o) g += t; }
        const float gl = __shfl(g, 63);
        TAB[lane] = g; TAB[64 + lane] = __expf(g); TAB[128 + lane] = be; TAB[192 + lane] = __expf(gl - g);
        if (lane == 0) ((float*)(p.ws + WS_GL))[it] = __expf(gl);
    }
    {
        const int cg = tid & 15, rsub = tid >> 4;
#pragma unroll
        for (int pt = 0; pt < 3; ++pt) {
            const int cb = pt * 512 + h * 128 + cg * 8;
            float w[4][8];
#pragma unroll
            for (int k = 0; k < 4; ++k) { const f32x4 a = *(const f32x4*)(cw + k * 1536 + cb), c = *(const f32x4*)(cw + k * 1536 + cb + 4);
                w[k][0] = a[0]; w[k][1] = a[1]; w[k][2] = a[2]; w[k][3] = a[3]; w[k][4] = c[0]; w[k][5] = c[1]; w[k][6] = c[2]; w[k][7] = c[3]; }
#pragma unroll
            for (int ps = 0; ps < 2; ++ps) {
                const int tl = ps * 32 + rsub; float y[8];
#pragma unroll
                for (int e = 0; e < 8; ++e) y[e] = 0.f;
#pragma unroll
                for (int k = 0; k < 4; ++k) { const int tt = n * 64 + tl - 3 + k;
                    if (tt >= 0) { const u32x4 x = *(const u32x4*)(QKV + (size_t)(b * SEQ + tt) * 1536 + cb);
#pragma unroll
                        for (int q = 0; q < 4; ++q) { y[2 * q] += w[k][2 * q] * bf_lo(x[q]); y[2 * q + 1] += w[k][2 * q + 1] * bf_hi(x[q]); } } }
                float s = 0.f;
#pragma unroll
                for (int e = 0; e < 8; ++e) { y[e] = silu(y[e]); s += y[e] * y[e]; }
                if (pt < 2) { s += __shfl_xor(s, 1); s += __shfl_xor(s, 2); s += __shfl_xor(s, 4); s += __shfl_xor(s, 8);
                    const float rs = rsqrtf(s + EPS) * (pt == 0 ? 0.08838834764831845f : 1.f);
#pragma unroll
                    for (int e = 0; e < 8; ++e) y[e] *= rs; }
                u32x4 o; o.x = pk2(y[0], y[1]); o.y = pk2(y[2], y[3]); o.z = pk2(y[4], y[5]); o.w = pk2(y[6], y[7]);
                if (pt == 0) *(FK_LAS u32x4*)(lds + PL_QS + (tl * QS_LD + cg * 8) * 2) = o;
                if (pt == 1) *(FK_LAS u32x4*)(lds + PL_KS + (tl * QS_LD + cg * 8) * 2) = o;
                if (pt >= 1) { FK_LAS bf16_t* T = (FK_LAS bf16_t*)(lds + (pt == 1 ? PL_KT : PL_VT));
#pragma unroll
                    for (int e = 0; e < 8; ++e) T[(cg * 8 + e) * KT_LD + tl] = (bf16_t)((e & 1) ? (o[e >> 1] >> 16) : (o[e >> 1] & 0xffffu)); }
            }
        }
    }
    __syncthreads();
    {
        const int r = lane & 31, hh = lane >> 5;
        if (wave < 4) {
            const int tj = wave >> 1, ti = wave & 1;
            f32x16 c = zero16();
            if (tj <= ti) {
#pragma unroll
                for (int s = 0; s < 8; ++s) { const bf16x8 a = *(const FK_LAS bf16x8*)(lds + PL_KS + ((32 * tj + r) * QS_LD + 16 * s + 8 * hh) * 2);
                    const bf16x8 bq = *(const FK_LAS bf16x8*)(lds + PL_QS + ((32 * ti + r) * QS_LD + 16 * s + 8 * hh) * 2); c = FK_MFMA32(a, bq, c); }
                const int i = 32 * ti + r; const float gci = TAB[i];
#pragma unroll
                for (int reg = 0; reg < 16; ++reg) { const int j = 32 * tj + crow(reg, hh); c[reg] = (i >= j) ? c[reg] * __expf(gci - TAB[j]) : 0.f; }
            }
#pragma unroll
            for (int s = 0; s < 2; ++s) *(bf16x8*)(item + CH_ATF + (((ti * 4) + 2 * tj + s) * 64 + lane) * 16) = pack8(c, s);
        } else {
            const int ta = (wave - 4) >> 1, tb = (wave - 4) & 1;
            if (ta >= tb) {
                f32x16 c = zero16();
#pragma unroll
                for (int s = 0; s < 8; ++s) { const bf16x8 a = *(const FK_LAS bf16x8*)(lds + PL_KS + ((32 * ta + r) * QS_LD + 16 * s + 8 * hh) * 2);
                    const bf16x8 bk = *(const FK_LAS bf16x8*)(lds + PL_KS + ((32 * tb + r) * QS_LD + 16 * s + 8 * hh) * 2); c = FK_MFMA32(a, bk, c); }
                const int j = 32 * tb + r; const float gcj = TAB[j]; FK_LAS float* AF = (FK_LAS float*)(lds + PL_AF);
#pragma unroll
                for (int reg = 0; reg < 16; ++reg) { const int i = 32 * ta + crow(reg, hh); AF[i * 64 + j] = (i > j) ? TAB[128 + i] * c[reg] * __expf(TAB[i] - gcj) : 0.f; }
            }
        }
#pragma unroll
        for (int rep = 0; rep < 2; ++rep) { const int f = wave * 2 + rep;
            { const int mt = f >> 3, kk = f & 7; const int tok = 32 * mt + r; const float sc = TAB[64 + tok];
              const u32x2 lo = *(const FK_LAS u32x2*)(lds + PL_QS + (tok * QS_LD + 16 * kk + 4 * hh) * 2), hi = *(const FK_LAS u32x2*)(lds + PL_QS + (tok * QS_LD + 16 * kk + 8 + 4 * hh) * 2);
              u32x4 o; o.x = pk2(bf_lo(lo.x) * sc, bf_hi(lo.x) * sc); o.y = pk2(bf_lo(lo.y) * sc, bf_hi(lo.y) * sc); o.z = pk2(bf_lo(hi.x) * sc, bf_hi(hi.x) * sc); o.w = pk2(bf_lo(hi.y) * sc, bf_hi(hi.y) * sc);
              *(u32x4*)(item + CH_QDF + (f * 64 + lane) * 16) = o; }
            { const int mt = f >> 2, ks = f & 3; const int dk = 32 * mt + r; const int tk = 16 * ks + 4 * hh;
              const u32x2 lo = *(const FK_LAS u32x2*)(lds + PL_KT + (dk * KT_LD + tk) * 2), hi = *(const FK_LAS u32x2*)(lds + PL_KT + (dk * KT_LD + tk + 8) * 2);
              const f32x4 f0 = *(const FK_LAS f32x4*)(TAB + 192 + tk), f1 = *(const FK_LAS f32x4*)(TAB + 192 + tk + 8);
              u32x4 o; o.x = pk2(bf_lo(lo.x) * f0[0], bf_hi(lo.x) * f0[1]); o.y = pk2(bf_lo(lo.y) * f0[2], bf_hi(lo.y) * f0[3]); o.z = pk2(bf_lo(hi.x) * f1[0], bf_hi(hi.x) * f1[1]); o.w = pk2(bf_lo(hi.y) * f1[2], bf_hi(hi.y) * f1[3]);
              *(u32x4*)(item + CH_KDF + (f * 64 + lane) * 16) = o; }
        }
    }
    __syncthreads();
#ifndef NO_STEPD
    if (wave == 0) {
        const FK_LAS float* AF = (const FK_LAS float*)(lds + PL_AF);
        FK_LAS bf16_t* TP = (FK_LAS bf16_t*)(lds + PL_TP) + lane; FK_LAS bf16_t* TPP = (FK_LAS bf16_t*)(lds + PL_TPP) + lane;
        asm volatile("" : "+v"(TP), "+v"(TPP));
        const float bc = TAB[128 + lane], bec = bc * TAB[64 + lane];
        float t[64];
#pragma unroll
        for (int i = 0; i < 64; ++i) {
            float acc = (lane == i) ? 1.f : 0.f;
#pragma unroll
            for (int j4 = 0; j4 < (i + 3) / 4; ++j4) { const f32x4 a = *(const FK_LAS f32x4*)(AF + i * 64 + 4 * j4);
#pragma unroll
                for (int e = 0; e < 4; ++e) if (4 * j4 + e < i) acc -= a[e] * t[4 * j4 + e]; }
            t[i] = acc;
            const unsigned pv = pk2(acc * bec, acc * bc);
            TP[i * TP_LD] = (bf16_t)(pv & 0xffffu); TPP[i * TP_LD] = (bf16_t)(pv >> 16);
            asm volatile("" ::: "memory");
        }
    }
#endif
    __syncthreads();
    {
        const int r = lane & 31, hh = lane >> 5;
        { const int mt = wave & 1, s4 = wave >> 1; f32x16 c = zero16();
#pragma unroll
          for (int s = 0; s < 4; ++s) { const bf16x8 a = *(const FK_LAS bf16x8*)(lds + PL_TPP + ((32 * mt + r) * TP_LD + 16 * s + 8 * hh) * 2);
              const bf16x8 bv = *(const FK_LAS bf16x8*)(lds + PL_VT + ((32 * s4 + r) * KT_LD + 16 * s + 8 * hh) * 2); c = FK_MFMA32(a, bv, c); }
          unsigned char* dst = item + CH_UC + ((s4 * 64 + lane) * 2 + mt) * 32;
          *(bf16x8*)(dst) = pack8(c, 0); *(bf16x8*)(dst + 16) = pack8(c, 1); }
        { const int t = wave >> 1, mt = wave & 1; f32x16 c = zero16();
#pragma unroll
          for (int s = 0; s < 4; ++s) { const bf16x8 a = *(const FK_LAS bf16x8*)(lds + PL_KT + ((32 * t + r) * KT_LD + 16 * s + 8 * hh) * 2);
              const bf16x8 bt = *(const FK_LAS bf16x8*)(lds + PL_TP + ((32 * mt + r) * TP_LD + 16 * s + 8 * hh) * 2); c = FK_MFMA32(a, bt, c); }
#pragma unroll
          for (int s = 0; s < 2; ++s) *(bf16x8*)(item + CH_WF + ((mt * 8 + 2 * t + s) * 64 + lane) * 16) = pack8(c, s); }
    }
    __syncthreads();
}

constexpr int SC_STAGE = 57344, SC_OBUF = 2 * SC_STAGE, SC_OB_BYTES = 16384;

FK_DI void p3_scan(const Params& p, FK_LAS unsigned char* lds, int bh, int tid, int wave, int lane) {
    const int b = bh >> 2, h = bh & 3;
    const unsigned char* items = p.ws + WS_CHUNK + (size_t)(bh * 64) * CH_BYTES;
    const float* GL = (const float*)(p.ws + WS_GL) + bh * 64;
    const int r = lane & 31, hh = lane >> 5;
#define SC_LOAD(nn) do { const unsigned char* src = items + (size_t)(nn) * CH_BYTES; FK_LAS unsigned char* dst = lds + ((nn) & 1) * SC_STAGE; \
        _Pragma("unroll") for (int i = 0; i < 14; ++i) { const int pc = (wave - 4) * 14 + i; \
            __builtin_amdgcn_global_load_lds((const unsigned*)(src + pc * 1024 + lane * 16), (FK_LAS unsigned*)(dst + pc * 1024), 16, 0, 0); } } while (0)
    if (wave >= 4) { SC_LOAD(0); asm volatile("s_waitcnt vmcnt(0)" ::: "memory"); }
    __syncthreads();
    if (wave < 4) {
        f32x16 S[4]; bf16x8 Sf[8];
#pragma unroll
        for (int t = 0; t < 4; ++t) S[t] = zero16();
#pragma unroll
        for (int k = 0; k < 8; ++k) Sf[k] = (bf16x8){0, 0, 0, 0, 0, 0, 0, 0};
        u32x4 ub[4]; float egl;
        { const u32x4* up = (const u32x4*)(items + CH_UC + (wave * 64 + lane) * 64); ub[0] = up[0]; ub[1] = up[1]; ub[2] = up[2]; ub[3] = up[3]; egl = GL[0]; }
        for (int n = 0; n < NCH; ++n) {
            const FK_LAS unsigned char* st = lds + (n & 1) * SC_STAGE;
            u32x4 un[4]; float egn = 0.f;
            if (n + 1 < NCH) { const u32x4* up = (const u32x4*)(items + (size_t)(n + 1) * CH_BYTES + CH_UC + (wave * 64 + lane) * 64); un[0] = up[0]; un[1] = up[1]; un[2] = up[2]; un[3] = up[3]; egn = GL[n + 1]; }
            else { un[0] = ub[0]; un[1] = ub[1]; un[2] = ub[2]; un[3] = ub[3]; }
            f32x16 av[2], ao[2];
#pragma unroll
            for (int mt = 0; mt < 2; ++mt) { av[mt] = zero16(); ao[mt] = zero16();
#pragma unroll
                for (int kk = 0; kk < 8; ++kk) { const bf16x8 wa = *(const FK_LAS bf16x8*)(st + CH_WF + ((mt * 8 + kk) * 64 + lane) * 16), qa = *(const FK_LAS bf16x8*)(st + CH_QDF + ((mt * 8 + kk) * 64 + lane) * 16);
                    av[mt] = FK_MFMA32(wa, Sf[kk], av[mt]); ao[mt] = FK_MFMA32(qa, Sf[kk], ao[mt]); } }
            bf16x8 Vf[4];
#pragma unroll
            for (int mt = 0; mt < 2; ++mt) {
#pragma unroll
                for (int q = 0; q < 8; ++q) { const unsigned uw = ub[2 * mt + (q >> 2)][q & 3]; av[mt][2 * q] = bf_lo(uw) - av[mt][2 * q]; av[mt][2 * q + 1] = bf_hi(uw) - av[mt][2 * q + 1]; }
                Vf[2 * mt] = pack8(av[mt], 0); Vf[2 * mt + 1] = pack8(av[mt], 1); }
#pragma unroll
            for (int mt = 0; mt < 2; ++mt)
#pragma unroll
                for (int ks = 0; ks < 4; ++ks) { const bf16x8 aa = *(const FK_LAS bf16x8*)(st + CH_ATF + ((mt * 4 + ks) * 64 + lane) * 16); ao[mt] = FK_MFMA32(aa, Vf[ks], ao[mt]); }
#pragma unroll
            for (int t = 0; t < 4; ++t) { S[t] = S[t] * egl;
#pragma unroll
                for (int ks = 0; ks < 4; ++ks) { const bf16x8 ka = *(const FK_LAS bf16x8*)(st + CH_KDF + ((t * 4 + ks) * 64 + lane) * 16); S[t] = FK_MFMA32(ka, Vf[ks], S[t]); }
                Sf[2 * t] = pack8(S[t], 0); Sf[2 * t + 1] = pack8(S[t], 1); }
            FK_LAS bf16_t* ob = (FK_LAS bf16_t*)(lds + SC_OBUF + (n & 1) * SC_OB_BYTES);
#pragma unroll
            for (int mt = 0; mt < 2; ++mt)
#pragma unroll
                for (int q = 0; q < 8; ++q) { const unsigned pv = pk2(ao[mt][2 * q], ao[mt][2 * q + 1]);
                    ob[(32 * mt + crow(2 * q, hh)) * 128 + 32 * wave + r] = (bf16_t)(pv & 0xffffu); ob[(32 * mt + crow(2 * q + 1, hh)) * 128 + 32 * wave + r] = (bf16_t)(pv >> 16); }
            ub[0] = un[0]; ub[1] = un[1]; ub[2] = un[2]; ub[3] = un[3]; egl = egn;
            __syncthreads();
        }
        __syncthreads();
    } else {
        const int e = wave - 4;
        const bf16_t* Z = (const bf16_t*)((const unsigned char*)p.out + DO_Z); bf16_t* MIX = (bf16_t*)(p.ws + WS_MIX);
        const float g0 = p.in[7][2 * lane], g1 = p.in[7][2 * lane + 1];
        for (int n = 0; n <= NCH; ++n) {
            if (n + 1 < NCH) SC_LOAD(n + 1);
            if (n >= 1) { const int c = n - 1; const FK_LAS unsigned* ob = (const FK_LAS unsigned*)(lds + SC_OBUF + (c & 1) * SC_OB_BYTES);
                const size_t row0 = (size_t)b * SEQ + c * 64 + 16 * e;
                unsigned zz[16];
#pragma unroll
                for (int i = 0; i < 16; ++i) zz[i] = *(const unsigned*)(Z + (row0 + i) * 512 + h * 128 + 2 * lane);
#pragma unroll
                for (int i = 0; i < 16; ++i) { const unsigned ov = ob[(16 * e + i) * 64 + lane]; const float o0 = bf_lo(ov), o1 = bf_hi(ov);
                    const float ss = wave_sum(o0 * o0 + o1 * o1); const float rs = rsqrtf(ss * (1.f / 128.f) + EPS);
                    *(unsigned*)(MIX + (row0 + i) * D + h * 128 + 2 * lane) = pk2(o0 * rs * g0 * silu(bf_lo(zz[i])), o1 * rs * g1 * silu(bf_hi(zz[i]))); } }
            asm volatile("s_waitcnt vmcnt(0)" ::: "memory");
            __syncthreads();
        }
    }
#undef SC_LOAD
}
}
namespace fk {
namespace cg = cooperative_groups;

struct ProbXW {
    const char* KB; const char* VB; const char* WXQ; const char* WXO; int lda, ldb, K; int G, c;
    FK_DI bool next(int i, Unit& u) const { const int L = i * G + c; if (L >= 256) return false; u.pm = L; u.pn = 0; return true; }
    FK_DI const char* aptr(const Unit& u) const { const int L = u.pm & 127, b = L >> 4, h = (L >> 2) & 3, q4 = L & 3;
        return (u.pm < 128) ? KB + ((size_t)(b * 256) * 1024 + h * 256) * 2 : WXO + ((size_t)(q4 * 256) * 1024 + h * 256) * 2; }
    FK_DI const char* bptr(const Unit& u) const { const int L = u.pm & 127, b = L >> 4, h = (L >> 2) & 3, q4 = L & 3;
        return (u.pm < 128) ? WXQ + ((size_t)(q4 * 256) * 1024 + h * 256) * 2 : VB + ((size_t)(b * 256) * 1024 + h * 256) * 2; }
};
struct EpiXW {
    static constexpr bool PERM = true;
    bf16_t* WQP; bf16_t* VWP;
    FK_DI void operator()(Acc& acc, const Unit& u, int wr, int wc, int fr, int fq, FK_LAS unsigned char*) const {
        const int L = u.pm & 127, b = L >> 4, h = (L >> 2) & 3, q4 = L & 3;
        bf16_t* base = (u.pm < 128) ? WQP + (size_t)b * 1048576 + (size_t)(h * 256) * 1024 + q4 * 256 : VWP + (size_t)b * 1048576 + (size_t)(q4 * 256) * 1024 + h * 256;
        const int row0 = wr * 64 + fr, col0 = wc * 32 + 8 * fq;
#pragma unroll
        for (int ai = 0; ai < 2; ++ai)
#pragma unroll
            for (int m = 0; m < 4; ++m) { bf16_t* rowp = base + (size_t)(row0 + ai * HALF + m * 16) * 1024 + col0;
#pragma unroll
                for (int bj = 0; bj < 2; ++bj) { const f32x4 v0 = acc[ai][bj][m][0], v1 = acc[ai][bj][m][1];
                    u32x4 w; w.x = pk2(v0[0], v0[1]); w.y = pk2(v0[2], v0[3]); w.z = pk2(v1[0], v1[1]); w.w = pk2(v1[2], v1[3]);
                    *(u32x4*)(rowp + bj * HALF) = w; } }
    }
};

__global__ void __launch_bounds__(512, 2) mega(Params p) {
    extern __shared__ __attribute__((aligned(16))) unsigned char lds_raw[];
    FK_LAS unsigned char* lds = (FK_LAS unsigned char*)lds_raw;
    cg::grid_group grid = cg::this_grid();
    const int tid = threadIdx.x, wave = __builtin_amdgcn_readfirstlane(tid >> 6), lane = tid & 63;
    const int G = gridDim.x, bid = blockIdx.x, gw = bid * 8 + wave, NGW = G * 8;
    unsigned char* ws = p.ws;
#ifndef PHMASK
#define PHMASK 0x3ff
#endif
#define PH(k) (((PHMASK >> (k)) & 1) && p.dbg_lo <= (k) && (k) <= p.dbg_hi)
    constexpr bool AL = true, SP = true;
    if (PH(0)) { p0_prologue(p, lds, gw, NGW, wave, lane); }
    grid.sync();
    if (PH(1)) {
        { ProbStd S{(const char*)p.out + DO_XN, (const char*)(ws + WS_WIN_T), D, D, D, 0}; S.T.init(M / 256, N1 / 256, G, bid);
          EpiBf16Split E{(bf16_t*)(ws + WS_QKV), (bf16_t*)((unsigned char*)p.out + DO_Z), (bf16_t*)(ws + WS_SC), 6, 8, 1536, 512, 1536};
          gemm_phase<EpiBf16Split, ProbStd, AL, SP>(lds, S, E); }
        { ProbStd S{(const char*)(ws + WS_MEMN), (const char*)(ws + WS_WXK_T), D, D, D, 0}; S.T.init(8, 8, G, bid);
          EpiBf16Split E{(bf16_t*)(ws + WS_KV), (bf16_t*)(ws + WS_KV) + (size_t)2048 * 1024, nullptr, 4, 8, 1024, 1024, 1024};
          gemm_phase<EpiBf16Split, ProbStd, AL, SP>(lds, S, E); }
    }
    grid.sync();
    if (PH(2)) {
#ifndef NO_ITEM
        for (int i8 = 0; i8 < NITEM / 256; ++i8) { int it = bid * (NITEM / 256) + i8; asm volatile("" : "+s"(it)); if (bid * (NITEM / 256) + i8 < NITEM && G == 256) p2_item(p, lds, it, tid, wave, lane); }
#endif
#ifndef NO_SCONV
        if (gw < 2048) p2_short_conv(p, gw, lane);
#endif
        __syncthreads();
        { ProbXW S{(const char*)(ws + WS_KV), (const char*)(ws + WS_KV) + (size_t)2048 * 1024 * 2, (const char*)(ws + WS_WXQ_G), (const char*)(ws + WS_WXO_T), D, D, 256, G, bid};
          EpiXW E{(bf16_t*)(ws + WS_WQP), (bf16_t*)(ws + WS_VWP)};
          gemm_phase<EpiXW, ProbXW, AL, SP>(lds, S, E); }
    }
    grid.sync();
    if (PH(3)) { if (bid < 32) p3_scan(p, lds, bid, tid, wave, lane); }
    grid.sync();
    if (PH(4)) { ProbStd S{(const char*)(ws + WS_MIX), (const char*)(ws + WS_WOUT_T), D, D, D, 0}; S.T.init(M / 256, 4, G, bid);
        EpiResid E{p.in[0], p.out, (bf16_t*)(ws + WS_HB), (float*)(ws + WS_SS1)};
        gemm_phase<EpiResid, ProbStd, AL, SP>(lds, S, E); }
    grid.sync();
    if (PH(5)) { ProbStd S{(const char*)(ws + WS_HB), (const char*)(ws + WS_WQP), D, D, D, (size_t)2 * 1048576}; S.T.init(M / 256, 4, G, bid);
        EpiSoftmax E{(const float*)(ws + WS_SS1), (bf16_t*)(ws + WS_P)};
        gemm_phase<EpiSoftmax, ProbStd, AL, SP>(lds, S, E); }
    grid.sync();
    if (PH(6)) { ProbStd S{(const char*)(ws + WS_P), (const char*)(ws + WS_VWP), D, D, D, (size_t)2 * 1048576}; S.T.init(M / 256, 4, G, bid);
        EpiResid E{p.out, p.out, (bf16_t*)(ws + WS_HB), (float*)(ws + WS_SS2)};
        gemm_phase<EpiResid, ProbStd, AL, SP>(lds, S, E); }
    grid.sync();
    if (PH(7)) { ProbStd S{(const char*)(ws + WS_HB), (const char*)(ws + WS_WGU_T), D, D, D, 0}; S.T.init(M / 256, 2 * DFF / 256, G, bid);
        EpiGateUp E{(const float*)(ws + WS_SS2), (bf16_t*)(ws + WS_ACT)};
        gemm_phase<EpiGateUp, ProbStd, AL, SP>(lds, S, E); }
    grid.sync();
    if (PH(8)) { ProbStd S{(const char*)(ws + WS_ACT), (const char*)(ws + WS_WDN_T), DFF, DFF, DFF, 0}; S.T.init(M / 256, 4, G, bid);
        EpiResid E{p.out, p.out, nullptr, (float*)(ws + WS_SS3)};
        gemm_phase<EpiResid, ProbStd, AL, SP>(lds, S, E); }
    grid.sync();
    if (PH(9)) p9_final(p, gw, NGW, lane);
#undef PH
}

static int launch_mega(void* const* d_in, void* d_out, void* d_ws, size_t ws_size, hipStream_t stream, int lo, int hi) {
    static int grid_blocks = 0;
    if (!grid_blocks) {
        int dev = 0, cus = 0, per_cu = 0;
        hipGetDevice(&dev); hipDeviceGetAttribute(&cus, hipDeviceAttributeMultiprocessorCount, dev);
        if (hipFuncSetAttribute((const void*)mega, hipFuncAttributeMaxDynamicSharedMemorySize, LDS_TOTAL) != hipSuccess) { fprintf(stderr, "hipFuncSetAttribute failed\n"); grid_blocks = -1; return -1; }
        hipOccupancyMaxActiveBlocksPerMultiprocessor(&per_cu, (const void*)mega, 512, LDS_TOTAL);
        if (per_cu < 1) { fprintf(stderr, "occupancy query says %d blocks/CU\n", per_cu); per_cu = 1; }
        grid_blocks = cus * 1;
        if (ws_size < WS_END) { fprintf(stderr, "ws too small: %zu < %zu\n", ws_size, (size_t)WS_END); grid_blocks = -1; return -1; }
    }
    if (grid_blocks < 0) return -1;
    Params p{}; for (int i = 0; i < 22; ++i) p.in[i] = (const float*)d_in[i];
    p.out = (float*)d_out; p.ws = (unsigned char*)d_ws; p.dbg_lo = lo; p.dbg_hi = hi;
    void* args[] = {&p};
    hipError_t e = hipLaunchCooperativeKernel((const void*)mega, dim3(grid_blocks), dim3(512), args, LDS_TOTAL, stream);
    if (e != hipSuccess) { fprintf(stderr, "cooperative launch failed: %s (grid %d)\n", hipGetErrorString(e), grid_blocks); return -1; }
    return 0;
}
}
extern "C" void kernel_launch(void* const* d_in, const int* in_sizes, int n_in, void* d_out, int out_size, void* d_ws, size_t ws_size, hipStream_t stream) {
    fk::launch_mega(d_in, d_out, d_ws, ws_size, stream, 0, 99);
}
```

```cpp
#include <hip/hip_runtime.h>
#include <hip/hip_cooperative_groups.h>
#include <cstdio>
namespace fk {
#define FK_LAS __attribute__((address_space(3)))
#define FK_DI __device__ __forceinline__
typedef unsigned short bf16_t;
typedef short bf16x8 __attribute__((ext_vector_type(8)));
typedef float f32x2 __attribute__((ext_vector_type(2)));
typedef float f32x4 __attribute__((ext_vector_type(4)));
typedef float f32x16 __attribute__((ext_vector_type(16)));
typedef unsigned u32x2 __attribute__((ext_vector_type(2)));
typedef unsigned u32x4 __attribute__((ext_vector_type(4)));
typedef __bf16 bf16v2 __attribute__((ext_vector_type(2)));

constexpr int M = 32768, D = 1024, SEQ = 4096, NB = 8, DFF = 2816, N1 = 3584, INC = 3592, NCH = 64  , NITEM = NB * 4 * NCH;
constexpr float EPS = 1e-6f;

FK_DI unsigned pk2(float lo, float hi) { f32x2 v = {lo, hi}; bf16v2 r = __builtin_convertvector(v, bf16v2); return __builtin_bit_cast(unsigned, r); }
FK_DI float bf_lo(unsigned u) { return __uint_as_float(u << 16); }
FK_DI float bf_hi(unsigned u) { return __uint_as_float(u & 0xffff0000u); }
FK_DI float silu(float x) { return x * __builtin_amdgcn_rcpf(1.f + __expf(-x)); }
template <int CTRL> FK_DI float dpp_mov(float v) { return __builtin_bit_cast(float, __builtin_amdgcn_update_dpp(0, __builtin_bit_cast(int, v), CTRL, 0xF, 0xF, true)); }
FK_DI float sum8(float v) { v += dpp_mov<0xB1>(v); v += dpp_mov<0x4E>(v); v += dpp_mov<0x141>(v); return v; }
FK_DI float sum16(float v) { v = sum8(v); v += dpp_mov<0x140>(v); return v; }
FK_DI float wave_sum(float v) {
    v = sum16(v);
    const float r0 = __builtin_bit_cast(float, __builtin_amdgcn_readlane(__builtin_bit_cast(int, v), 0)), r1 = __builtin_bit_cast(float, __builtin_amdgcn_readlane(__builtin_bit_cast(int, v), 16));
    const float r2 = __builtin_bit_cast(float, __builtin_amdgcn_readlane(__builtin_bit_cast(int, v), 32)), r3 = __builtin_bit_cast(float, __builtin_amdgcn_readlane(__builtin_bit_cast(int, v), 48));
    return (r0 + r1) + (r2 + r3);
}

constexpr size_t MiB = 1u << 20;
constexpr size_t WS_WIN_T = 0;
constexpr size_t WS_WOUT_T = 7 * MiB;
constexpr size_t WS_WXQ_G = 9 * MiB;
constexpr size_t WS_WXK_T = 11 * MiB;
constexpr size_t WS_WXV_T = 13 * MiB;
constexpr size_t WS_WXO_T = 15 * MiB;
constexpr size_t WS_WGU_T = 17 * MiB;
constexpr size_t WS_WDN_T = 28 * MiB;
constexpr size_t WS_WQP = 34 * MiB;
constexpr size_t WS_VWP = 50 * MiB;
constexpr size_t WS_MEMN = 66 * MiB;
constexpr size_t WS_KV = 70 * MiB;
constexpr size_t WS_GB = 78 * MiB;
constexpr size_t WS_SS1 = 79 * MiB, WS_SS2 = 81 * MiB, WS_SS3 = 83 * MiB;
constexpr size_t WS_GL = 85 * MiB;
constexpr size_t WS_BAR = 85 * MiB + 65536;
constexpr size_t WS_FLAGS = 85 * MiB + 131072;
constexpr size_t WS_PCNT = WS_FLAGS + 8192;
constexpr size_t WS_PROG = WS_PCNT + 512;
constexpr size_t WS_QKV = 86 * MiB;
constexpr size_t WS_SC = 182 * MiB;
constexpr size_t WS_CHUNK = 278 * MiB;
constexpr size_t WS_MIX = 422 * MiB;
constexpr size_t WS_END = 486 * MiB;
constexpr size_t WS_ORAW = WS_QKV;
constexpr size_t WS_HB = WS_QKV;
constexpr size_t WS_P = WS_SC;
constexpr size_t WS_ACT = 246 * MiB;
constexpr size_t DO_XN = 0, DO_Z = 64 * MiB;
constexpr int CH_WF = 0, CH_KDF = 16384, CH_QDF = 32768, CH_ATF = 49152, CH_UC = 57344, CH_BYTES = 73728;

struct Params {
    const float* in[22];
    float* out; unsigned char* ws;
    int dbg_lo, dbg_hi;
};
typedef const __attribute__((address_space(4))) Params* PP;
}
namespace fk {
#define XB_TMO      128
#define XB_XCNT(j)  (256  + 64 * (j))
#define XB_XSUB(j)  (1280 + 64 * (j))
#define XB_XGEN(j)  (2304 + 64 * (j))
#define XB_TOP      3328
#define XB_TOPGEN   3392
#define XCD_BAR_WORDS 3456
#define XB_SPIN_CAP (1u << 18)

__device__ __forceinline__ unsigned xb_ld(unsigned* p)              { return __hip_atomic_load(p, __ATOMIC_RELAXED, __HIP_MEMORY_SCOPE_AGENT); }
__device__ __forceinline__ unsigned xb_add(unsigned* p, unsigned v) { return __hip_atomic_fetch_add(p, v, __ATOMIC_RELAXED, __HIP_MEMORY_SCOPE_AGENT); }
__device__ __forceinline__ unsigned xb_xcc_id() { return (unsigned)__builtin_amdgcn_s_getreg((3 << 11) | 20) & 0xFu; }
#define XB_SPIN(cond, bar) do { unsigned _sp = 0; while (cond) { __builtin_amdgcn_s_sleep(1); \
    if ((++_sp & 255u) == 0u) { if (xb_ld(&(bar)[XB_TMO])) break; if (_sp > XB_SPIN_CAP) { atomicAdd(&(bar)[XB_TMO], 1u); break; } } } } while (0)

struct XcdBarrier {
    unsigned* bar; unsigned x;
    volatile FK_LAS unsigned* st;
};

__device__ __forceinline__ XcdBarrier xcd_barrier_post(unsigned* bar, volatile FK_LAS unsigned* st) {
    XcdBarrier b; b.bar = bar; b.x = xb_xcc_id(); b.st = st;
    if (threadIdx.x == 0) (void)xb_add(&bar[XB_XCNT(b.x)], 1u);
    return b;
}
__device__ __forceinline__ void xcd_barrier_complete(unsigned* bar, unsigned x, unsigned& nloc, unsigned& nx) {
    const unsigned G = gridDim.x * gridDim.y * gridDim.z;
    unsigned sum, cnt, mine, sp = 0u;
    for (;;) {
        sum = 0u; cnt = 0u; mine = 0u;
#pragma unroll
        for (unsigned j = 0; j < 16; ++j) { const unsigned c = xb_ld(&bar[XB_XCNT(j)]); sum += c; cnt += (c > 0u) ? 1u : 0u; mine = (j == x) ? c : mine; }
        if (sum == G) break;
        __builtin_amdgcn_s_sleep(1);
        if ((++sp & 255u) == 0u) { if (xb_ld(&bar[XB_TMO])) break; if (sp > XB_SPIN_CAP) { atomicAdd(&bar[XB_TMO], 1u); break; } }
    }
    nloc = mine > 0u ? mine : 1u; nx = cnt > 0u ? cnt : 1u;
}

__device__ __forceinline__ void xcd_barrier(const XcdBarrier& b) {
    asm volatile("s_waitcnt vmcnt(0)" ::: "memory");
    __syncthreads();
    if (threadIdx.x == 0) {
        unsigned* bar = b.bar;
        __builtin_amdgcn_s_waitcnt(0);
        unsigned nloc = b.st[0], nx = b.st[1];
        if (nloc == 0u) { xcd_barrier_complete(bar, b.x, nloc, nx); b.st[0] = nloc; b.st[1] = nx; }
        const unsigned old = xb_add(&bar[XB_XSUB(b.x)], 1u);
        const unsigned gen = old / nloc;
        if (old + 1u == (gen + 1u) * nloc) {
            __builtin_amdgcn_fence(__ATOMIC_RELEASE, "agent");
            asm volatile("s_waitcnt vmcnt(0)" ::: "memory");
            const unsigned og = xb_add(&bar[XB_TOP], 1u);
            const unsigned tg = og / nx;
            if (og + 1u == (tg + 1u) * nx) xb_add(&bar[XB_TOPGEN], 1u);
            else XB_SPIN(xb_ld(&bar[XB_TOPGEN]) == tg, bar);
            __builtin_amdgcn_fence(__ATOMIC_ACQUIRE, "agent");
            xb_add(&bar[XB_XGEN(b.x)], 1u);
            asm volatile("s_waitcnt vmcnt(0)" ::: "memory");
        } else {
            XB_SPIN(xb_ld(&bar[XB_XGEN(b.x)]) == gen, bar);
            __builtin_amdgcn_fence(__ATOMIC_ACQUIRE, "agent");
            asm volatile("s_waitcnt vmcnt(0)" ::: "memory");
        }
    }
    __syncthreads();
}

}
namespace fk {
#ifndef GEMM_WGM
#define GEMM_WGM 4
#endif
constexpr int BM = 256, BK = 64, HALF = 128, HTB = HALF * BK * 2, STAGE_BYTES = 8 * HTB, NXCD = 8, WGM = GEMM_WGM;
constexpr int LDS_EXCH = STAGE_BYTES;
constexpr int LDS_TOTAL = STAGE_BYTES + 16384;

FK_DI int lds_byte(int r, int c) { const int st = (r >> 4) * 2 + (c >> 5), rr = r & 15, cc = c & 31, ob = rr * 64 + cc * 2; return st * 1024 + (ob ^ (((ob >> 9) & 1) << 5)); }
FK_DI void stage_rc(int b, int& R, int& C) { const int st = b / 1024, sb = b % 1024, swz = sb ^ (((sb >> 9) & 1) << 5); R = (st >> 1) * 16 + swz / 64; C = (st & 1) * 32 + (swz % 64) / 2; }
FK_DI int perm32(int rho) { const int n = rho >> 4, i = rho & 15; return 8 * (i >> 2) + 4 * n + (i & 3); }

struct Unit { int pm, pn; };

struct TileOrder {
    int nM, nN, nwg, G, c, wgm;
    FK_DI void init(int nM_, int nN_, int G_, int c_, int wgm_ = WGM) { nM = nM_; nN = nN_; nwg = nM * nN; G = G_; c = c_; wgm = wgm_; }
    FK_DI bool next(int i, Unit& u) const {
        const long L = (long)i * G + c; if (L >= nwg) return false;
        int wgid = (int)L; { const int q = nwg / NXCD, r = nwg % NXCD, xcd = wgid % NXCD, off = wgid / NXCD; wgid = (xcd < r ? xcd * (q + 1) : r * (q + 1) + (xcd - r) * q) + off; }
        const int nig = wgm * nN, gid = wgid / nig, fm = gid * wgm, gsz = (nM - fm) < wgm ? (nM - fm) : wgm;
        u.pm = fm + ((wgid % nig) % gsz); u.pn = (wgid % nig) / gsz; return true;
    }
};
struct ProbStd {
    const char* A; const char* Bt; int lda, ldb, K; size_t b_bstride; TileOrder T;
    FK_DI bool next(int i, Unit& u) const { return T.next(i, u); }
    FK_DI const char* aptr(const Unit& u) const { return A + (size_t)u.pm * 256 * lda * 2; }
    FK_DI const char* bptr(const Unit& u) const { return Bt + (size_t)u.pn * 256 * ldb * 2 + (size_t)(u.pm >> 4) * b_bstride; }
};

typedef f32x4 Acc[2][2][4][2];

template <class Epi, class Prob, bool ALIGN_EPI, bool SP2>
FK_DI void gemm_phase(FK_LAS unsigned char* lds, const Prob& S, const Epi& E) {
    int tid = threadIdx.x; asm volatile("" : "+v"(tid));
    const int wid = __builtin_amdgcn_readfirstlane(tid >> 6), lane = tid & 63, wr = wid >> 2, wc = wid & 3, fr = lane & 15, fq = lane >> 4;
    const int K = S.K, nt = K / BK, lda = S.lda, ldb = S.ldb;
    unsigned voffA[2], voffB[2];
#pragma unroll
    for (int i = 0; i < 2; ++i) { int R, C; stage_rc(tid * 16 + i * 8192, R, C); const int Rb = Epi::PERM ? ((R & ~31) + perm32(R & 31)) : R;
        voffA[i] = (unsigned)(R * lda + C) * 2u; voffB[i] = (unsigned)(Rb * ldb + C) * 2u; }
    const size_t kstep = (size_t)(BK * 2);
    const size_t hstepA = (size_t)HALF * lda * 2, hstepB = (size_t)HALF * ldb * 2;
    const unsigned ldsw = (unsigned)wid * 1024u;
    const int aoff = lds_byte(wr * 64 + fr, fq * 8), boff = lds_byte(wc * 32 + fr, fq * 8);
#define PG8_SA(b, h) (((b) * 2 + (h)) * HTB)
#define PG8_SB(b, h) ((4 + (b) * 2 + (h)) * HTB)
#define PG8_STAGE(bufoff, gbase, voff) do { _Pragma("unroll") for (int _i = 0; _i < 2; ++_i) \
        __builtin_amdgcn_global_load_lds((const unsigned*)((const char*)(gbase) + (voff)[_i]), (FK_LAS unsigned*)(lds + (bufoff) + ldsw + _i * 8192), 16, 0, 0); } while (0)
#define PG8_LDA(dst, b, h) do { _Pragma("unroll") for (int m = 0; m < 4; ++m) _Pragma("unroll") for (int k = 0; k < 2; ++k) dst[m][k] = *(const FK_LAS bf16x8*)(lds + PG8_SA(b, h) + aoff + m * 2048 + k * 1024); } while (0)
#define PG8_LDB(dst, b, h) do { _Pragma("unroll") for (int n = 0; n < 2; ++n) _Pragma("unroll") for (int k = 0; k < 2; ++k) dst[n][k] = *(const FK_LAS bf16x8*)(lds + PG8_SB(b, h) + boff + n * 2048 + k * 1024); } while (0)
#define PG8_MMA(ai, bj, At, Bt) do { __builtin_amdgcn_s_setprio(1); _Pragma("unroll") for (int m = 0; m < 4; ++m) _Pragma("unroll") for (int n = 0; n < 2; ++n) _Pragma("unroll") for (int k = 0; k < 2; ++k) \
        acc[ai][bj][m][n] = __builtin_amdgcn_mfma_f32_16x16x32_bf16(Bt[n][k], At[m][k], acc[ai][bj][m][n], 0, 0, 0); __builtin_amdgcn_s_setprio(0); } while (0)
#define PG8_WAIT_V(n) asm volatile("s_waitcnt vmcnt(" #n ")" ::: "memory")
#define PG8_WAIT_L(n) asm volatile("s_waitcnt lgkmcnt(" #n ")" ::: "memory")
#define PG8_BAR __builtin_amdgcn_s_barrier()
#define PG8_SCHED __builtin_amdgcn_sched_barrier(0)
    Unit cur, nxt; int ui = 0;
    if (!S.next(0, cur)) return;
    Acc acc;
#pragma unroll
    for (int a = 0; a < 2; ++a)
#pragma unroll
        for (int b = 0; b < 2; ++b)
#pragma unroll
            for (int m = 0; m < 4; ++m)
#pragma unroll
                for (int n = 0; n < 2; ++n) acc[a][b][m][n] = (f32x4){0.f, 0.f, 0.f, 0.f};
    bf16x8 At[4][2], B0[2][2], B1[2][2];
    const char* cA = S.aptr(cur); const char* cB = S.bptr(cur);
    if constexpr (SP2) {
        PG8_STAGE(PG8_SB(0, 0), cB, voffB); PG8_STAGE(PG8_SB(0, 1), cB + hstepB, voffB); PG8_STAGE(PG8_SA(0, 0), cA, voffA); PG8_STAGE(PG8_SA(0, 1), cA + hstepA, voffA);
        if (wr == 1) PG8_BAR;
        PG8_WAIT_V(2); PG8_BAR;
        PG8_STAGE(PG8_SB(1, 0), cB + kstep, voffB); PG8_STAGE(PG8_SA(1, 0), cA + kstep, voffA); PG8_STAGE(PG8_SB(1, 1), cB + hstepB + kstep, voffB);
        PG8_WAIT_V(6); PG8_BAR;
    } else {
        PG8_STAGE(PG8_SB(0, 0), cB, voffB); PG8_STAGE(PG8_SA(0, 0), cA, voffA); PG8_STAGE(PG8_SB(0, 1), cB + hstepB, voffB); PG8_STAGE(PG8_SA(0, 1), cA + hstepA, voffA);
        if (wr == 1) PG8_BAR;
        PG8_WAIT_V(4); PG8_BAR;
        PG8_STAGE(PG8_SB(1, 0), cB + kstep, voffB); PG8_STAGE(PG8_SA(1, 0), cA + kstep, voffA); PG8_STAGE(PG8_SB(1, 1), cB + hstepB + kstep, voffB);
        PG8_WAIT_V(6); PG8_BAR;
    }
    for (;;) {
        const bool has_next = S.next(ui + 1, nxt);
        const char* nA = has_next ? S.aptr(nxt) : cA; const char* nB = has_next ? S.bptr(nxt) : cB;
        for (int t = 0; t < nt; t += 2) {
            const bool last = (t == nt - 2);
            const char* a1 = cA + (size_t)(t + 1) * kstep;
            const char* a2 = last ? nA : cA + (size_t)(t + 2) * kstep; const char* b2 = last ? nB : cB + (size_t)(t + 2) * kstep;
            const char* a3 = a2 + kstep; const char* b3 = b2 + kstep;
            if constexpr (SP2) {
            PG8_LDB(B0, 0, 0); PG8_LDB(B1, 0, 1); PG8_SCHED; PG8_LDA(At, 0, 0); PG8_STAGE(PG8_SA(1, 1), a1 + hstepA, voffA);
            PG8_WAIT_V(8); PG8_WAIT_L(0); PG8_BAR; PG8_MMA(0, 0, At, B0); PG8_MMA(0, 1, At, B1); PG8_BAR; PG8_SCHED;
            PG8_LDA(At, 0, 1); PG8_STAGE(PG8_SB(0, 0), b2, voffB); PG8_STAGE(PG8_SB(0, 1), b2 + hstepB, voffB); PG8_STAGE(PG8_SA(0, 0), a2, voffA);
            PG8_WAIT_V(8); PG8_WAIT_L(0); PG8_BAR; PG8_MMA(1, 0, At, B0); PG8_MMA(1, 1, At, B1); PG8_BAR; PG8_SCHED;
            PG8_LDB(B0, 1, 0); PG8_LDB(B1, 1, 1); PG8_SCHED; PG8_LDA(At, 1, 0); PG8_STAGE(PG8_SA(0, 1), a2 + hstepA, voffA);
            PG8_WAIT_V(8); PG8_WAIT_L(0); PG8_BAR; PG8_MMA(0, 0, At, B0); PG8_MMA(0, 1, At, B1); PG8_BAR; PG8_SCHED;
            PG8_LDA(At, 1, 1); PG8_STAGE(PG8_SB(1, 0), b3, voffB); PG8_STAGE(PG8_SB(1, 1), b3 + hstepB, voffB); PG8_STAGE(PG8_SA(1, 0), a3, voffA);
            PG8_WAIT_V(8); PG8_WAIT_L(0); PG8_BAR; PG8_MMA(1, 0, At, B0); PG8_MMA(1, 1, At, B1); PG8_BAR; PG8_SCHED;
            } else {
            PG8_LDB(B0, 0, 0); PG8_SCHED; PG8_LDA(At, 0, 0); PG8_STAGE(PG8_SA(1, 1), a1 + hstepA, voffA);
            PG8_WAIT_L(8); PG8_BAR; PG8_WAIT_L(0); PG8_MMA(0, 0, At, B0); PG8_BAR; PG8_SCHED;
            PG8_LDB(B1, 0, 1); PG8_STAGE(PG8_SB(0, 0), b2, voffB);
            PG8_BAR; PG8_WAIT_L(0); PG8_MMA(0, 1, At, B1); PG8_BAR;
            PG8_LDA(At, 0, 1); PG8_STAGE(PG8_SA(0, 0), a2, voffA);
            PG8_BAR; PG8_WAIT_L(0); PG8_MMA(1, 0, At, B0); PG8_BAR; PG8_SCHED;
            PG8_STAGE(PG8_SB(0, 1), b2 + hstepB, voffB);
            PG8_WAIT_V(6); PG8_BAR; PG8_MMA(1, 1, At, B1); PG8_BAR;
            PG8_LDB(B0, 1, 0); PG8_SCHED; PG8_LDA(At, 1, 0); PG8_STAGE(PG8_SA(0, 1), a2 + hstepA, voffA);
            PG8_WAIT_L(8); PG8_BAR; PG8_WAIT_L(0); PG8_MMA(0, 0, At, B0); PG8_BAR; PG8_SCHED;
            PG8_LDB(B1, 1, 1); PG8_STAGE(PG8_SB(1, 0), b3, voffB);
            PG8_BAR; PG8_WAIT_L(0); PG8_MMA(0, 1, At, B1); PG8_BAR;
            PG8_LDA(At, 1, 1); PG8_STAGE(PG8_SA(1, 0), a3, voffA);
            PG8_BAR; PG8_WAIT_L(0); PG8_MMA(1, 0, At, B0); PG8_BAR; PG8_SCHED;
            PG8_STAGE(PG8_SB(1, 1), b3 + hstepB, voffB);
            PG8_WAIT_V(6); PG8_BAR; PG8_MMA(1, 1, At, B1); PG8_BAR;
            }
        }
        if constexpr (ALIGN_EPI) { if (wr == 0) PG8_BAR; }
        E(acc, cur, wr, wc, fr, fq, lds);
        if (!has_next) break;
#pragma unroll
        for (int a = 0; a < 2; ++a)
#pragma unroll
            for (int b = 0; b < 2; ++b)
#pragma unroll
                for (int m = 0; m < 4; ++m)
#pragma unroll
                    for (int n = 0; n < 2; ++n) acc[a][b][m][n] = (f32x4){0.f, 0.f, 0.f, 0.f};
        cur = nxt; cA = nA; cB = nB; ++ui;
        if constexpr (ALIGN_EPI) { if (wr == 1) PG8_BAR; }
    }
    PG8_WAIT_V(0);
    if constexpr (!ALIGN_EPI) { if (wr == 0) PG8_BAR; }
    PG8_BAR;
#undef PG8_SA
#undef PG8_SB
#undef PG8_STAGE
#undef PG8_LDA
#undef PG8_LDB
#undef PG8_MMA
#undef PG8_WAIT_V
#undef PG8_WAIT_L
#undef PG8_BAR
#undef PG8_SCHED
}

struct EpiBf16Split {
    static constexpr bool PERM = true;
    bf16_t* o0; bf16_t* o1; bf16_t* o2; int t1, t2;
    int ld0, ld1, ld2;
    int t3;
    const float* gz;
    FK_DI void operator()(Acc& acc, const Unit& u, int wr, int wc, int fr, int fq, FK_LAS unsigned char*) const {
        bf16_t* base; int ld, ct; bool gate = false;
        if (u.pn < t1) { base = o0; ld = ld0; ct = u.pn; } else if (u.pn < t2) { base = o1; ld = ld1; ct = u.pn - t1; gate = (gz != nullptr); } else { base = o2; ld = ld2; ct = u.pn - t2; }
        const int row0 = u.pm * BM + wr * 64 + fr, col0 = ct * BM + wc * 32 + 8 * fq;
        if (u.pn >= t3) {
#pragma unroll
            for (int ai = 0; ai < 2; ++ai)
#pragma unroll
                for (int m = 0; m < 4; ++m) { const f32x4 v0 = acc[ai][0][m][0] * acc[ai][1][m][0], v1 = acc[ai][0][m][1] * acc[ai][1][m][1];
                    u32x4 w; w.x = pk2(v0[0], v0[1]); w.y = pk2(v0[2], v0[3]); w.z = pk2(v1[0], v1[1]); w.w = pk2(v1[2], v1[3]);
                    *(u32x4*)(o2 + (size_t)(row0 + ai * HALF + m * 16) * ld2 + 512 + (u.pn - t3) * HALF + wc * 32 + 8 * fq) = w; }
            return;
        }
        if (gate) {
            const f32x4 g0 = *(const f32x4*)(gz + (col0 & 127)), g1 = *(const f32x4*)(gz + (col0 & 127) + 4);
#pragma unroll
            for (int ai = 0; ai < 2; ++ai)
#pragma unroll
                for (int m = 0; m < 4; ++m)
#pragma unroll
                    for (int bj = 0; bj < 2; ++bj) { f32x4 v0 = acc[ai][bj][m][0], v1 = acc[ai][bj][m][1];
#pragma unroll
                        for (int j = 0; j < 4; ++j) { v0[j] = silu(v0[j]) * g0[j]; v1[j] = silu(v1[j]) * g1[j]; }
                        acc[ai][bj][m][0] = v0; acc[ai][bj][m][1] = v1; }
        }
#pragma unroll
        for (int ai = 0; ai < 2; ++ai)
#pragma unroll
            for (int m = 0; m < 4; ++m) { bf16_t* rowp = base + (size_t)(row0 + ai * HALF + m * 16) * ld + col0;
#pragma unroll
                for (int bj = 0; bj < 2; ++bj) { const f32x4 v0 = acc[ai][bj][m][0], v1 = acc[ai][bj][m][1];
                    u32x4 w; w.x = pk2(v0[0], v0[1]); w.y = pk2(v0[2], v0[3]); w.z = pk2(v1[0], v1[1]); w.w = pk2(v1[2], v1[3]);
                    *(u32x4*)(rowp + bj * HALF) = w; } }
    }
};
struct EpiBf16At {
    static constexpr bool PERM = true;
    bf16_t* o; int ld; size_t pm_stride, pn_stride;
    FK_DI void operator()(Acc& acc, const Unit& u, int wr, int wc, int fr, int fq, FK_LAS unsigned char*) const {
        bf16_t* base = o + (size_t)u.pm * pm_stride + (size_t)u.pn * pn_stride;
        const int row0 = wr * 64 + fr, col0 = wc * 32 + 8 * fq;
#pragma unroll
        for (int ai = 0; ai < 2; ++ai)
#pragma unroll
            for (int m = 0; m < 4; ++m) { bf16_t* rowp = base + (size_t)(row0 + ai * HALF + m * 16) * ld + col0;
#pragma unroll
                for (int bj = 0; bj < 2; ++bj) { const f32x4 v0 = acc[ai][bj][m][0], v1 = acc[ai][bj][m][1];
                    u32x4 w; w.x = pk2(v0[0], v0[1]); w.y = pk2(v0[2], v0[3]); w.z = pk2(v1[0], v1[1]); w.w = pk2(v1[2], v1[3]);
                    *(u32x4*)(rowp + bj * HALF) = w; } }
    }
};
struct EpiResid {
    static constexpr bool PERM = false;
    const float* base; float* hout; bf16_t* hb; float* ss;
    FK_DI void operator()(Acc& acc, const Unit& u, int wr, int wc, int fr, int fq, FK_LAS unsigned char*) const {
        const int row0 = u.pm * BM + wr * 64 + fr, col0 = u.pn * BM + wc * 32 + 4 * fq;
#pragma unroll
        for (int ai = 0; ai < 2; ++ai)
#pragma unroll
            for (int m = 0; m < 4; ++m) { const int row = row0 + ai * HALF + m * 16; const size_t off = (size_t)row * D + col0; float s = 0.f;
#pragma unroll
                for (int bj = 0; bj < 2; ++bj)
#pragma unroll
                    for (int n = 0; n < 2; ++n) { const f32x4 bs = *(const f32x4*)(base + off + bj * HALF + n * 16); const f32x4 o = bs + acc[ai][bj][m][n];
                        *(f32x4*)(hout + off + bj * HALF + n * 16) = o; s += (o[0] * o[0] + o[1] * o[1]) + (o[2] * o[2] + o[3] * o[3]);
                        if (hb) { u32x2 w; w.x = pk2(o[0], o[1]); w.y = pk2(o[2], o[3]); *(u32x2*)(hb + off + bj * HALF + n * 16) = w; } }
                s += __shfl_xor(s, 16); s += __shfl_xor(s, 32);
                if (fq == 0) __hip_atomic_fetch_add(ss + row, s, __ATOMIC_RELAXED, __HIP_MEMORY_SCOPE_AGENT);
                asm volatile("" ::: "memory"); }
    }
};

struct EpiResidB {
    static constexpr bool PERM = true;
    const float* xf; const bf16_t* hb_in; bf16_t* hb_out; float* ss;
    FK_DI void operator()(Acc& acc, const Unit& u, int wr, int wc, int fr, int fq, FK_LAS unsigned char*) const {
        const int row0 = u.pm * BM + wr * 64 + fr, col0 = u.pn * BM + wc * 32 + 8 * fq;
#pragma unroll
        for (int ai = 0; ai < 2; ++ai)
#pragma unroll
            for (int m = 0; m < 4; ++m) { const int row = row0 + ai * HALF + m * 16; const size_t off = (size_t)row * D + col0; float s = 0.f;
#pragma unroll
                for (int bj = 0; bj < 2; ++bj) { f32x4 b0, b1;
                    if (xf) { b0 = *(const f32x4*)(xf + off + bj * HALF); b1 = *(const f32x4*)(xf + off + bj * HALF + 4); }
                    else { const u32x4 hv = *(const u32x4*)(hb_in + off + bj * HALF); b0 = (f32x4){bf_lo(hv.x), bf_hi(hv.x), bf_lo(hv.y), bf_hi(hv.y)}; b1 = (f32x4){bf_lo(hv.z), bf_hi(hv.z), bf_lo(hv.w), bf_hi(hv.w)}; }
                    const f32x4 o0 = b0 + acc[ai][bj][m][0], o1 = b1 + acc[ai][bj][m][1];
                    s += ((o0[0] * o0[0] + o0[1] * o0[1]) + (o0[2] * o0[2] + o0[3] * o0[3])) + ((o1[0] * o1[0] + o1[1] * o1[1]) + (o1[2] * o1[2] + o1[3] * o1[3]));
                    u32x4 w; w.x = pk2(o0[0], o0[1]); w.y = pk2(o0[2], o0[3]); w.z = pk2(o1[0], o1[1]); w.w = pk2(o1[2], o1[3]);
                    *(u32x4*)(hb_out + off + bj * HALF) = w; }
                s += __shfl_xor(s, 16); s += __shfl_xor(s, 32);
                if (fq == 0) __hip_atomic_fetch_add(ss + row, s, __ATOMIC_RELAXED, __HIP_MEMORY_SCOPE_AGENT);
                asm volatile("" ::: "memory"); }
    }
};

struct EpiFinal {
    static constexpr bool PERM = true;
    const bf16_t* hb_in; float* out; float* ss; unsigned* cnt; const float* gfin;
    FK_DI void operator()(Acc& acc, const Unit& u, int wr, int wc, int fr, int fq, FK_LAS unsigned char*) const {
        const int row0 = u.pm * BM + wr * 64 + fr, col0 = u.pn * BM + wc * 32 + 8 * fq;
#pragma unroll
        for (int ai = 0; ai < 2; ++ai)
#pragma unroll
            for (int m = 0; m < 4; ++m) { const int row = row0 + ai * HALF + m * 16; const size_t off = (size_t)row * D + col0; float s = 0.f;
#pragma unroll
                for (int bj = 0; bj < 2; ++bj) { const u32x4 hv = *(const u32x4*)(hb_in + off + bj * HALF);
                    const f32x4 o0 = (f32x4){bf_lo(hv.x), bf_hi(hv.x), bf_lo(hv.y), bf_hi(hv.y)} + acc[ai][bj][m][0], o1 = (f32x4){bf_lo(hv.z), bf_hi(hv.z), bf_lo(hv.w), bf_hi(hv.w)} + acc[ai][bj][m][1];
                    acc[ai][bj][m][0] = o0; acc[ai][bj][m][1] = o1;
                    s += ((o0[0] * o0[0] + o0[1] * o0[1]) + (o0[2] * o0[2] + o0[3] * o0[3])) + ((o1[0] * o1[0] + o1[1] * o1[1]) + (o1[2] * o1[2] + o1[3] * o1[3])); }
                s += __shfl_xor(s, 16); s += __shfl_xor(s, 32);
                if (fq == 0) __hip_atomic_fetch_add(ss + row, s, __ATOMIC_RELAXED, __HIP_MEMORY_SCOPE_AGENT);
                asm volatile("" ::: "memory"); }
        asm volatile("s_waitcnt vmcnt(0)" ::: "memory"); __builtin_amdgcn_s_barrier(); asm volatile("" ::: "memory");
        if (threadIdx.x == 0) __hip_atomic_fetch_add(cnt + u.pm, 1u, __ATOMIC_RELAXED, __HIP_MEMORY_SCOPE_AGENT);
        { unsigned sp_ = 0; while ((unsigned)__builtin_amdgcn_readfirstlane(__hip_atomic_load(cnt + u.pm, __ATOMIC_RELAXED, __HIP_MEMORY_SCOPE_AGENT)) < 4u) { __builtin_amdgcn_s_sleep(2); if (++sp_ > (1u << 22)) break; } }
        float rsv[8];
#pragma unroll
        for (int q = 0; q < 8; ++q) rsv[q] = __uint_as_float(__hip_atomic_load((const unsigned*)ss + row0 + (q >> 2) * HALF + (q & 3) * 16, __ATOMIC_RELAXED, __HIP_MEMORY_SCOPE_AGENT));
        f32x4 gv[2][2];
#pragma unroll
        for (int bj = 0; bj < 2; ++bj) { gv[bj][0] = *(const f32x4*)(gfin + col0 + bj * HALF); gv[bj][1] = *(const f32x4*)(gfin + col0 + bj * HALF + 4); }
#pragma unroll
        for (int ai = 0; ai < 2; ++ai)
#pragma unroll
            for (int m = 0; m < 4; ++m) { const int row = row0 + ai * HALF + m * 16; const float rs = rsqrtf(rsv[ai * 4 + m] * (1.f / 1024.f) + EPS); float* op = out + (size_t)row * D + col0;
#pragma unroll
                for (int bj = 0; bj < 2; ++bj) { *(f32x4*)(op + bj * HALF) = acc[ai][bj][m][0] * rs * gv[bj][0]; *(f32x4*)(op + bj * HALF + 4) = acc[ai][bj][m][1] * rs * gv[bj][1]; } }
    }
};
FK_DI float row_rstd(const float* ss, int row) { return rsqrtf(ss[row] * (1.f / 1024.f) + EPS); }
struct EpiSoftmax {
    static constexpr bool PERM = true;
    const float* ss; bf16_t* P;
    FK_DI void operator()(Acc& acc, const Unit& u, int wr, int wc, int fr, int fq, FK_LAS unsigned char* lds) const {
        FK_LAS f32x2* X = (FK_LAS f32x2*)(lds + LDS_EXCH);
        const int row0 = u.pm * BM + wr * 64 + fr;
        float rsv[8];
#pragma unroll
        for (int q = 0; q < 8; ++q) rsv[q] = ss[row0 + (q >> 2) * HALF + (q & 3) * 16];
#pragma unroll
        for (int ai = 0; ai < 2; ++ai)
#pragma unroll
            for (int m = 0; m < 4; ++m) { const int rl = ai * HALF + wr * 64 + m * 16 + fr; const float rs = rsqrtf(rsv[ai * 4 + m] * (1.f / 1024.f) + EPS);
                float mx = -3.0e38f;
#pragma unroll
                for (int bj = 0; bj < 2; ++bj)
#pragma unroll
                    for (int n = 0; n < 2; ++n) { f32x4 v = acc[ai][bj][m][n] * rs; acc[ai][bj][m][n] = v; mx = fmaxf(fmaxf(mx, fmaxf(v[0], v[1])), fmaxf(v[2], v[3])); }
                mx = fmaxf(mx, __shfl_xor(mx, 16)); mx = fmaxf(mx, __shfl_xor(mx, 32));
                float sm = 0.f;
#pragma unroll
                for (int bj = 0; bj < 2; ++bj)
#pragma unroll
                    for (int n = 0; n < 2; ++n) { f32x4 v = acc[ai][bj][m][n];
#pragma unroll
                        for (int j = 0; j < 4; ++j) { v[j] = __expf(v[j] - mx); sm += v[j]; }
                        acc[ai][bj][m][n] = v; }
                sm += __shfl_xor(sm, 16); sm += __shfl_xor(sm, 32);
                if (fq == 0) X[rl * 4 + wc] = (f32x2){mx, sm};
            }
        asm volatile("s_waitcnt lgkmcnt(0)" ::: "memory"); __builtin_amdgcn_s_barrier(); asm volatile("" ::: "memory");
#pragma unroll
        for (int ai = 0; ai < 2; ++ai)
#pragma unroll
            for (int m = 0; m < 4; ++m) { const int rl = ai * HALF + wr * 64 + m * 16 + fr;
                const f32x2 x0 = X[rl * 4 + 0], x1 = X[rl * 4 + 1], x2 = X[rl * 4 + 2], x3 = X[rl * 4 + 3];
                const float Mx = fmaxf(fmaxf(x0.x, x1.x), fmaxf(x2.x, x3.x));
                const float tot = x0.y * __expf(x0.x - Mx) + x1.y * __expf(x1.x - Mx) + x2.y * __expf(x2.x - Mx) + x3.y * __expf(x3.x - Mx);
                const float mine = wc == 0 ? x0.x : (wc == 1 ? x1.x : (wc == 2 ? x2.x : x3.x));
                const float sc = __expf(mine - Mx) * __builtin_amdgcn_rcpf(tot);
                bf16_t* rowp = P + (size_t)(row0 + ai * HALF + m * 16) * D + u.pn * BM + wc * 32 + 8 * fq;
#pragma unroll
                for (int bj = 0; bj < 2; ++bj) { const f32x4 v0 = acc[ai][bj][m][0] * sc, v1 = acc[ai][bj][m][1] * sc;
                    u32x4 w; w.x = pk2(v0[0], v0[1]); w.y = pk2(v0[2], v0[3]); w.z = pk2(v1[0], v1[1]); w.w = pk2(v1[2], v1[3]);
                    *(u32x4*)(rowp + bj * HALF) = w; } }
        asm volatile("s_waitcnt lgkmcnt(0)" ::: "memory"); __builtin_amdgcn_s_barrier(); asm volatile("" ::: "memory");
    }
};
struct EpiGateUp {
    static constexpr bool PERM = true;
    const float* ss; bf16_t* act;
    FK_DI void operator()(Acc& acc, const Unit& u, int wr, int wc, int fr, int fq, FK_LAS unsigned char*) const {
        const int row0 = u.pm * BM + wr * 64 + fr, col0 = u.pn * HALF + wc * 32 + 8 * fq;
        float rsv[8];
#pragma unroll
        for (int q = 0; q < 8; ++q) rsv[q] = ss[row0 + (q >> 2) * HALF + (q & 3) * 16];
#pragma unroll
        for (int ai = 0; ai < 2; ++ai)
#pragma unroll
            for (int m = 0; m < 4; ++m) { const int row = row0 + ai * HALF + m * 16; const float rs = rsqrtf(rsv[ai * 4 + m] * (1.f / 1024.f) + EPS);
                u32x4 w;
#pragma unroll
                for (int n = 0; n < 2; ++n) { const f32x4 g = acc[ai][0][m][n] * rs, up = acc[ai][1][m][n] * rs;
                    w[2 * n] = pk2(silu(g[0]) * up[0], silu(g[1]) * up[1]); w[2 * n + 1] = pk2(silu(g[2]) * up[2], silu(g[3]) * up[3]); }
                *(u32x4*)(act + (size_t)row * DFF + col0) = w; }
    }
};
}
namespace fk {
template <class Src>
FK_DI void transpose_item(const Src& src, int ldw, int K, bf16_t* WT, const float* gk, FK_LAS float* scr, int kb, int nb, int lane) {
    const int k0 = 64 * kb, n0 = 32 * nb;
    const float* colp = src(n0 + (lane & 31));
    float vv[32];
#pragma unroll
    for (int i = 0; i < 32; ++i) { const int kk = 2 * i + (lane >> 5); vv[i] = __builtin_nontemporal_load(colp + (size_t)(k0 + kk) * ldw); }
#pragma unroll
    for (int i = 0; i < 32; ++i) { const int kk = 2 * i + (lane >> 5); float v = vv[i]; if (gk) v *= gk[k0 + kk]; scr[kk * 33 + (lane & 31)] = v; }
    asm volatile("s_waitcnt lgkmcnt(0)" ::: "memory");
    const int c = lane & 7;
#pragma unroll
    for (int j = 0; j < 4; ++j) { const int n = (lane >> 3) + 8 * j; const FK_LAS float* s = scr + (8 * c) * 33 + n;
        u32x4 o; o.x = pk2(s[0 * 33], s[1 * 33]); o.y = pk2(s[2 * 33], s[3 * 33]); o.z = pk2(s[4 * 33], s[5 * 33]); o.w = pk2(s[6 * 33], s[7 * 33]);
        *(u32x4*)(WT + (size_t)(n0 + n) * K + k0 + 8 * c) = o; }
    asm volatile("s_waitcnt lgkmcnt(0)" ::: "memory");
}

FK_DI void late_weights(PP p, FK_LAS unsigned char* lds, int gw, int NGW, int wave, int lane) {
    unsigned char* ws = p->ws;
    FK_LAS float* scr = (FK_LAS float*)(lds + wave * 16384);
    const float* w_out = p->in[10]; const float* w_xq = p->in[13]; const float* w_xo = p->in[16]; const float* w_gate = p->in[18]; const float* w_up = p->in[19]; const float* w_down = p->in[20];
    const float* g_x = p->in[11]; const float* g_ffn = p->in[17];
    constexpr int I_SQ = (D / 64) * (D / 32), I_GU = (D / 64) * (2 * DFF / 32), I_DN = (DFF / 64) * (D / 32);
    constexpr int NITEMS = 2 * I_SQ + I_GU + I_DN;
    for (int it = gw; it < NITEMS; it += NGW) {
        int r = it;
        if (r < I_SQ) { auto src = [&](int n) { return w_out + n; }; transpose_item(src, D, D, (bf16_t*)(ws + WS_WOUT_T), (const float*)nullptr, scr, r / 32, r % 32, lane); continue; } r -= I_SQ;
        if (r < I_SQ) { auto src = [&](int n) { return w_xo + n; }; transpose_item(src, D, D, (bf16_t*)(ws + WS_WXO_T), (const float*)nullptr, scr, r / 32, r % 32, lane); continue; } r -= I_SQ;
        if (r < I_GU) { auto src = [&](int n) { const int blk = n >> 8, w = n & 255; return (w < 128 ? w_gate + blk * 128 + w : w_up + blk * 128 + (w - 128)); };
            transpose_item(src, DFF, D, (bf16_t*)(ws + WS_WGU_T), g_ffn, scr, r / (2 * DFF / 32), r % (2 * DFF / 32), lane); continue; } r -= I_GU;
        { auto src = [&](int n) { return w_down + n; }; transpose_item(src, D, DFF, (bf16_t*)(ws + WS_WDN_T), (const float*)nullptr, scr, r / 32, r % 32, lane); }
    }
    for (int k = gw; k < D; k += NGW) { const float sc = g_x[k] * 0.0625f; const f32x4* s = (const f32x4*)(w_xq + (size_t)k * D) + lane; u32x2* o = (u32x2*)((bf16_t*)(ws + WS_WXQ_G) + (size_t)k * D) + lane;
#pragma unroll
        for (int j = 0; j < 4; ++j) { const f32x4 v = s[64 * j] * sc; u32x2 w; w.x = pk2(v[0], v[1]); w.y = pk2(v[2], v[3]); o[64 * j] = w; } }
}

FK_DI void p0_prologue(PP p, FK_LAS unsigned char* lds, int gw, int NGW, int wave, int lane) {
    unsigned char* ws = p->ws;
    FK_LAS float* scr = (FK_LAS float*)(lds + wave * 16384);
    const float* w_in = p->in[3]; const float* w_xk = p->in[14]; const float* w_xv = p->in[15];
    const float* g_mix = p->in[2]; const float* g_mem = p->in[12];
    constexpr int I_IN = (D / 64) * (N1 / 32), I_SQ = (D / 64) * (D / 32);
    constexpr int NITEMS = I_IN + 2 * I_SQ;
    for (int it = gw; it < NITEMS; it += NGW) {
        int r = it;
        if (r < I_IN) { auto src = [&](int n) { if (n < 2048) return w_in + n; if (n < 2560) return w_in + n + 8; const int t = (n - 2560) >> 8, w = (n - 2560) & 255; return w_in + (w < 128 ? 2568 + 128 * t + w : 3080 + 128 * t + (w - 128)); };   transpose_item(src, INC, D, (bf16_t*)(ws + WS_WIN_T), (const float*)nullptr, scr, r / (N1 / 32), r % (N1 / 32), lane); continue; } r -= I_IN;
        if (r < I_SQ) { auto src = [&](int n) { return w_xk + n; }; transpose_item(src, D, D, (bf16_t*)(ws + WS_WXK_T), (const float*)nullptr, scr, r / 32, r % 32, lane); continue; } r -= I_SQ;
        { auto src = [&](int n) { return w_xv + n; }; transpose_item(src, D, D, (bf16_t*)(ws + WS_WXV_T), (const float*)nullptr, scr, r / 32, r % 32, lane); }
    }
    for (int i = gw * 64 + lane; i < M; i += NGW * 64) { ((float*)(ws + WS_SS1))[i] = 0.f; ((float*)(ws + WS_SS2))[i] = 0.f; ((float*)(ws + WS_SS3))[i] = 0.f; }
    for (int m = gw; m < NB * 256; m += NGW) { const f32x4* xr = (const f32x4*)(p->in[1] + (size_t)m * D) + lane; f32x4 v[4]; float s = 0.f;
#pragma unroll
        for (int j = 0; j < 4; ++j) { v[j] = xr[64 * j]; s += (v[j][0] * v[j][0] + v[j][1] * v[j][1]) + (v[j][2] * v[j][2] + v[j][3] * v[j][3]); }
        const float rs = rsqrtf(wave_sum(s) * (1.f / D) + EPS); u32x2* o = (u32x2*)((bf16_t*)(ws + WS_MEMN) + (size_t)m * D) + lane;
#pragma unroll
        for (int j = 0; j < 4; ++j) { const f32x4 g = ((const f32x4*)g_mem)[lane + 64 * j]; const f32x4 y = v[j] * rs * g; u32x2 w; w.x = pk2(y[0], y[1]); w.y = pk2(y[2], y[3]); o[64 * j] = w; } }
    {
        f32x4 gm[4]; f32x4 wab[4][4][2];
#pragma unroll
        for (int j = 0; j < 4; ++j) { gm[j] = ((const f32x4*)g_mix)[lane + 64 * j];
#pragma unroll
            for (int e = 0; e < 4; ++e) { const int k = 4 * lane + 256 * j + e; const f32x4* wp = (const f32x4*)(w_in + (size_t)k * INC + 2048); wab[j][e][0] = wp[0] * gm[j][e]; wab[j][e][1] = wp[1] * gm[j][e]; } }
        const float* a_log = p->in[5]; const float* dt_bias = p->in[6];
        bf16_t* XN = (bf16_t*)((unsigned char*)p->out + DO_XN); float* GB = (float*)(ws + WS_GB);
        f32x4 vn[4];
        { const f32x4* xr = (const f32x4*)(p->in[0] + (size_t)gw * D) + lane;
#pragma unroll
          for (int j = 0; j < 4; ++j) vn[j] = __builtin_nontemporal_load(xr + 64 * j); }
        for (int m = gw; m < M; m += NGW) { f32x4 v[4]; float s = 0.f;
#pragma unroll
            for (int j = 0; j < 4; ++j) { v[j] = vn[j]; s += (v[j][0] * v[j][0] + v[j][1] * v[j][1]) + (v[j][2] * v[j][2] + v[j][3] * v[j][3]); }
            if (m + NGW < M) { const f32x4* xr = (const f32x4*)(p->in[0] + (size_t)(m + NGW) * D) + lane;
#pragma unroll
                for (int j = 0; j < 4; ++j) vn[j] = __builtin_nontemporal_load(xr + 64 * j); }
            const float rs = rsqrtf(wave_sum(s) * (1.f / D) + EPS);
            f32x4 d0 = {0.f, 0.f, 0.f, 0.f}, d1 = {0.f, 0.f, 0.f, 0.f};
            u32x2* o = (u32x2*)(XN + (size_t)m * D) + lane;
#pragma unroll
            for (int j = 0; j < 4; ++j) { const f32x4 xs = v[j] * rs; const f32x4 y = xs * gm[j]; u32x2 w; w.x = pk2(y[0], y[1]); w.y = pk2(y[2], y[3]); o[64 * j] = w;
#pragma unroll
                for (int e = 0; e < 4; ++e) { d0 += wab[j][e][0] * xs[e]; d1 += wab[j][e][1] * xs[e]; } }
            float r8[8] = {d0[0], d0[1], d0[2], d0[3], d1[0], d1[1], d1[2], d1[3]};
#pragma unroll
            for (int q = 0; q < 8; ++q) r8[q] = wave_sum(r8[q]);
            float mine = r8[0];
#pragma unroll
            for (int q = 1; q < 8; ++q) mine = (lane == q) ? r8[q] : mine;
            if (lane < 4) { const float xx = mine + dt_bias[lane]; const float sp = xx > 20.f ? xx : log1pf(__expf(xx)); GB[(size_t)m * 8 + lane] = -__expf(a_log[lane]) * sp; }
            else if (lane < 8) { GB[(size_t)m * 8 + lane] = 1.f / (1.f + __expf(-mine)); }
        }
    }
}

FK_DI void p9_final(PP p, int gw, int NGW, int lane) {
    const float* ss = (const float*)(p->ws + WS_SS3); const f32x4* g = (const f32x4*)p->in[21]; const bf16_t* HB = (const bf16_t*)(p->ws + WS_HB);
    f32x4 gm[4];
#pragma unroll
    for (int j = 0; j < 2; ++j) { gm[2 * j] = g[2 * lane + 128 * j]; gm[2 * j + 1] = g[2 * lane + 128 * j + 1]; }
    for (int m0 = gw * 4; m0 < M; m0 += NGW * 4) {
        u32x4 hv[4][2]; float rs[4];
#pragma unroll
        for (int r = 0; r < 4; ++r) { const u32x4* hr = (const u32x4*)(HB + (size_t)(m0 + r) * D) + lane; hv[r][0] = hr[0]; hv[r][1] = hr[64]; rs[r] = row_rstd(ss, m0 + r); }
#pragma unroll
        for (int r = 0; r < 4; ++r) { f32x4* xr = (f32x4*)(p->out + (size_t)(m0 + r) * D) + 2 * lane;
#pragma unroll
            for (int j = 0; j < 2; ++j) { const u32x4 h = hv[r][j];
                xr[128 * j] = (f32x4){bf_lo(h.x), bf_hi(h.x), bf_lo(h.y), bf_hi(h.y)} * rs[r] * gm[2 * j];
                xr[128 * j + 1] = (f32x4){bf_lo(h.z), bf_hi(h.z), bf_lo(h.w), bf_hi(h.w)} * rs[r] * gm[2 * j + 1]; } }
    }
}
}
namespace fk {
#define FK_MFMA32(a, b, c) __builtin_amdgcn_mfma_f32_32x32x16_bf16((a), (b), (c), 0, 0, 0)
FK_DI int crow(int reg, int h) { return (reg & 3) + 8 * (reg >> 2) + 4 * h; }
FK_DI bf16x8 pack8(const f32x16& x, int s) {
    u32x4 p; p.x = pk2(x[8 * s], x[8 * s + 1]); p.y = pk2(x[8 * s + 2], x[8 * s + 3]); p.z = pk2(x[8 * s + 4], x[8 * s + 5]); p.w = pk2(x[8 * s + 6], x[8 * s + 7]);
    return __builtin_bit_cast(bf16x8, p);
}
FK_DI f32x16 zero16() { f32x16 z; for (int i = 0; i < 16; ++i) z[i] = 0.f; return z; }

constexpr int PL_QS = 0, PL_KS = 17408, PL_KT = 34816, PL_VT = 53248, PL_AF = 71680, PL_TP = 88064, PL_TPP = 97280, PL_TAB = 106496;
constexpr int QS_LD = 136, KT_LD = 72, TP_LD = 72;

FK_DI void st16_wt(__amdgpu_buffer_rsrc_t rs, unsigned off, u32x4 v) { __builtin_amdgcn_raw_buffer_store_b128(v, rs, off, 0, 16); }
FK_DI void p2_short_conv(PP p, int gw, int lane) {
    const bf16_t* SC = (const bf16_t*)(p->ws + WS_SC);
    const __amdgpu_buffer_rsrc_t mrs = __builtin_amdgcn_make_buffer_rsrc((void*)(p->ws + WS_MIX), 0, (int)((size_t)M * D * 2), 0x00020000);
    const float* csw = p->in[8]; const float* scg = p->in[9];
    float w0[8], w1[8], w2[8], g[8];
#pragma unroll
    for (int e = 0; e < 8; ++e) { w0[e] = csw[8 * lane + e]; w1[e] = csw[512 + 8 * lane + e]; w2[e] = csw[1024 + 8 * lane + e]; g[e] = scg[8 * lane + e]; }
    const int r0 = gw * 16;
    float p1[8], p2[8];
    auto prod = [&](int row, float* o) {
        const u32x4 c = *(const u32x4*)(SC + (size_t)row * 1024 + 512 + 8 * lane);
        #pragma unroll
        for (int q = 0; q < 4; ++q) { o[2 * q] = bf_lo(c[q]); o[2 * q + 1] = bf_hi(c[q]); }
    };
    const int t0 = r0 & (SEQ - 1);
    if (t0 >= 1) prod(r0 - 1, p1); else { for (int e = 0; e < 8; ++e) p1[e] = 0.f; }
    if (t0 >= 2) prod(r0 - 2, p2); else { for (int e = 0; e < 8; ++e) p2[e] = 0.f; }
    for (int i4 = 0; i4 < 4; ++i4) {
        u32x4 cv[4], bv[4];
#pragma unroll
        for (int r = 0; r < 4; ++r) { const size_t row = (size_t)(r0 + 4 * i4 + r); cv[r] = __builtin_nontemporal_load((const u32x4*)(SC + row * 1024 + 512 + 8 * lane)); bv[r] = __builtin_nontemporal_load((const u32x4*)(SC + row * 1024 + 8 * lane)); }
#pragma unroll
        for (int r = 0; r < 4; ++r) { const size_t row = (size_t)(r0 + 4 * i4 + r); float p0[8];
#pragma unroll
            for (int q = 0; q < 4; ++q) { p0[2 * q] = bf_lo(cv[r][q]); p0[2 * q + 1] = bf_hi(cv[r][q]); }
            const u32x4 b = bv[r]; float y[8]; float s = 0.f;
#pragma unroll
            for (int e = 0; e < 8; ++e) { const float bb = (e & 1) ? bf_hi(b[e >> 1]) : bf_lo(b[e >> 1]); y[e] = bb * (w0[e] * p2[e] + w1[e] * p1[e] + w2[e] * p0[e]); s += y[e] * y[e]; }
            s = sum8(s);
            const float rs = rsqrtf(s * (1.f / 64.f) + EPS);
            u32x4 o; o.x = pk2(y[0] * rs * g[0], y[1] * rs * g[1]); o.y = pk2(y[2] * rs * g[2], y[3] * rs * g[3]); o.z = pk2(y[4] * rs * g[4], y[5] * rs * g[5]); o.w = pk2(y[6] * rs * g[6], y[7] * rs * g[7]);
            st16_wt(mrs, (unsigned)((row * D + 512 + 8 * lane) * 2), o);
#pragma unroll
            for (int e = 0; e < 8; ++e) { p2[e] = p1[e]; p1[e] = p0[e]; } }
    }
}

constexpr int PL_CW = 107520;
struct P2Raw { u32x4 x[3][5]; float g, be; };
FK_DI void p2_load(PP p, int it, int tid, int lane, P2Raw& R) {
    const int n = it & 63, h = (it >> 6) & 3, b = it >> 8, cg = tid & 15, rg = tid >> 4;
    const bf16_t* QKV = (const bf16_t*)(p->ws + WS_QKV) + (size_t)(b * SEQ) * 1536 + h * 128 + cg * 8;
#pragma unroll
    for (int pt = 0; pt < 3; ++pt)
#pragma unroll
        for (int j = 0; j < 5; ++j) { const int tt = n * 64 + 2 * rg - 3 + j; R.x[pt][j] = (tt >= 0) ? *(const u32x4*)(QKV + (size_t)tt * 1536 + pt * 512) : (u32x4){0u, 0u, 0u, 0u}; }
    const float* GB = (const float*)(p->ws + WS_GB) + (size_t)(b * SEQ + n * 64 + lane) * 8 + h;
    R.g = GB[0]; R.be = GB[4];
}
#define P2_BAR() do { asm volatile("s_waitcnt lgkmcnt(0)" ::: "memory"); __builtin_amdgcn_s_barrier(); asm volatile("" ::: "memory"); } while (0)
FK_DI void p2_item(PP p, FK_LAS unsigned char* lds, int it, int it_next, int tid_in, int wave, int lane_in, P2Raw& R) {
    int tid = tid_in, lane = lane_in; asm volatile("" : "+v"(tid), "+v"(lane));
    unsigned char* item = p->ws + WS_CHUNK + (size_t)it * CH_BYTES;
    const __amdgpu_buffer_rsrc_t irs = __builtin_amdgcn_make_buffer_rsrc(item, 0, CH_BYTES, 0x00020000);
    const int hw = (it >> 6) & 3;
    FK_LAS float* TAB = (FK_LAS float*)(lds + PL_TAB);
    if (wave == 0) {
        float g = R.g; const float be = R.be;
#pragma unroll
        for (int o = 1; o < 64; o <<= 1) { const float t = __shfl_up(g, o); if (lane >= o) g += t; }
        const float gl = __shfl(g, 63);
        TAB[lane] = g; TAB[64 + lane] = __expf(g); TAB[128 + lane] = be; TAB[192 + lane] = __expf(gl - g);
        if (lane == 0) __hip_atomic_store((unsigned*)(p->ws + WS_GL) + it, __float_as_uint(__expf(gl)), __ATOMIC_RELAXED, __HIP_MEMORY_SCOPE_AGENT);
    }
    {
        const int cg = tid & 15, rg = tid >> 4;
#pragma unroll
        for (int pt = 0; pt < 3; ++pt) {
            float y0[8], y1[8];
#pragma unroll
            for (int e = 0; e < 8; ++e) { y0[e] = 0.f; y1[e] = 0.f; }
            float xf[8];
#pragma unroll
            for (int j = 0; j < 5; ++j) { const u32x4 x = R.x[pt][j];
#pragma unroll
                for (int q = 0; q < 4; ++q) { xf[2 * q] = bf_lo(x[q]); xf[2 * q + 1] = bf_hi(x[q]); }
                if (j < 4) { const FK_LAS f32x4* wp = (const FK_LAS f32x4*)(lds + PL_CW + hw * 6144 + ((pt * 4 + j) * 128 + cg * 8) * 4); const f32x4 wa = wp[0], wb = wp[1];
#pragma unroll
                    for (int e = 0; e < 4; ++e) { y0[e] += wa[e] * xf[e]; y0[4 + e] += wb[e] * xf[4 + e]; } }
                if (j >= 1) { const FK_LAS f32x4* wp = (const FK_LAS f32x4*)(lds + PL_CW + hw * 6144 + ((pt * 4 + j - 1) * 128 + cg * 8) * 4); const f32x4 wa = wp[0], wb = wp[1];
#pragma unroll
                    for (int e = 0; e < 4; ++e) { y1[e] += wa[e] * xf[e]; y1[4 + e] += wb[e] * xf[4 + e]; } }
            }
            float s0 = 0.f, s1 = 0.f;
#pragma unroll
            for (int e = 0; e < 8; ++e) { y0[e] = silu(y0[e]); y1[e] = silu(y1[e]); s0 += y0[e] * y0[e]; s1 += y1[e] * y1[e]; }
            if (pt < 2) { s0 = sum16(s0); s1 = sum16(s1);
                const float sc = (pt == 0 ? 0.08838834764831845f : 1.f), r0 = rsqrtf(s0 + EPS) * sc, r1 = rsqrtf(s1 + EPS) * sc;
#pragma unroll
                for (int e = 0; e < 8; ++e) { y0[e] *= r0; y1[e] *= r1; } }
            u32x4 o0, o1; o0.x = pk2(y0[0], y0[1]); o0.y = pk2(y0[2], y0[3]); o0.z = pk2(y0[4], y0[5]); o0.w = pk2(y0[6], y0[7]);
            o1.x = pk2(y1[0], y1[1]); o1.y = pk2(y1[2], y1[3]); o1.z = pk2(y1[4], y1[5]); o1.w = pk2(y1[6], y1[7]);
            if (pt <= 1) { FK_LAS unsigned char* dst = lds + (pt == 0 ? PL_QS : PL_KS) + ((2 * rg) * QS_LD + cg * 8) * 2; *(FK_LAS u32x4*)dst = o0; *(FK_LAS u32x4*)(dst + QS_LD * 2) = o1; }
            if (pt >= 1) { FK_LAS unsigned char* T = lds + (pt == 1 ? PL_KT : PL_VT) + ((cg * 8) * KT_LD + 2 * rg) * 2;
#pragma unroll
                for (int e = 0; e < 8; ++e) { const unsigned a0 = (e & 1) ? (o0[e >> 1] >> 16) : (o0[e >> 1] & 0xffffu), a1 = (e & 1) ? (o1[e >> 1] & 0xffff0000u) : (o1[e >> 1] << 16);
                    *(FK_LAS unsigned*)(T + e * KT_LD * 2) = a0 | a1; } }
        }
    }
    P2_BAR();
    if (it_next >= 0) p2_load(p, it_next, tid, lane, R);
    {
        const int r = lane & 31, hh = lane >> 5;
        if (wave < 4) {
            const int tj = wave >> 1, ti = wave & 1;
            f32x16 c = zero16();
            if (tj <= ti) {
#pragma unroll
                for (int s = 0; s < 8; ++s) { const bf16x8 a = *(const FK_LAS bf16x8*)(lds + PL_KS + ((32 * tj + r) * QS_LD + 16 * s + 8 * hh) * 2);
                    const bf16x8 bq = *(const FK_LAS bf16x8*)(lds + PL_QS + ((32 * ti + r) * QS_LD + 16 * s + 8 * hh) * 2); c = FK_MFMA32(a, bq, c); }
                const int i = 32 * ti + r; const float gci = TAB[i];
#pragma unroll
                for (int reg = 0; reg < 16; ++reg) { const int j = 32 * tj + crow(reg, hh); c[reg] = (i >= j) ? c[reg] * __expf(gci - TAB[j]) : 0.f; }
            }
#pragma unroll
            for (int s = 0; s < 2; ++s) st16_wt(irs, CH_ATF + (((ti * 4) + 2 * tj + s) * 64 + lane) * 16, __builtin_bit_cast(u32x4, pack8(c, s)));
        } else {
            const int ta = (wave - 4) >> 1, tb = (wave - 4) & 1;
            if (ta >= tb) {
                f32x16 c = zero16();
#pragma unroll
                for (int s = 0; s < 8; ++s) { const bf16x8 a = *(const FK_LAS bf16x8*)(lds + PL_KS + ((32 * ta + r) * QS_LD + 16 * s + 8 * hh) * 2);
                    const bf16x8 bk = *(const FK_LAS bf16x8*)(lds + PL_KS + ((32 * tb + r) * QS_LD + 16 * s + 8 * hh) * 2); c = FK_MFMA32(a, bk, c); }
                const int j = 32 * tb + r; const float gcj = TAB[j]; FK_LAS float* AF = (FK_LAS float*)(lds + PL_AF);
#pragma unroll
                for (int reg = 0; reg < 16; ++reg) { const int i = 32 * ta + crow(reg, hh); AF[i * 64 + j] = (i > j) ? TAB[128 + i] * c[reg] * __expf(TAB[i] - gcj) : 0.f; }
            }
        }
#pragma unroll
        for (int rep = 0; rep < 2; ++rep) { const int f = wave * 2 + rep;
            { const int mt = f >> 3, kk = f & 7; const int tok = 32 * mt + r; const float sc = TAB[64 + tok];
              const u32x2 lo = *(const FK_LAS u32x2*)(lds + PL_QS + (tok * QS_LD + 16 * kk + 4 * hh) * 2), hi = *(const FK_LAS u32x2*)(lds + PL_QS + (tok * QS_LD + 16 * kk + 8 + 4 * hh) * 2);
              u32x4 o; o.x = pk2(bf_lo(lo.x) * sc, bf_hi(lo.x) * sc); o.y = pk2(bf_lo(lo.y) * sc, bf_hi(lo.y) * sc); o.z = pk2(bf_lo(hi.x) * sc, bf_hi(hi.x) * sc); o.w = pk2(bf_lo(hi.y) * sc, bf_hi(hi.y) * sc);
              st16_wt(irs, CH_QDF + (f * 64 + lane) * 16, o); }
            { const int mt = f >> 2, ks = f & 3; const int dk = 32 * mt + r; const int tk = 16 * ks + 4 * hh;
              const u32x2 lo = *(const FK_LAS u32x2*)(lds + PL_KT + (dk * KT_LD + tk) * 2), hi = *(const FK_LAS u32x2*)(lds + PL_KT + (dk * KT_LD + tk + 8) * 2);
              const f32x4 f0 = *(const FK_LAS f32x4*)(TAB + 192 + tk), f1 = *(const FK_LAS f32x4*)(TAB + 192 + tk + 8);
              u32x4 o; o.x = pk2(bf_lo(lo.x) * f0[0], bf_hi(lo.x) * f0[1]); o.y = pk2(bf_lo(lo.y) * f0[2], bf_hi(lo.y) * f0[3]); o.z = pk2(bf_lo(hi.x) * f1[0], bf_hi(hi.x) * f1[1]); o.w = pk2(bf_lo(hi.y) * f1[2], bf_hi(hi.y) * f1[3]);
              st16_wt(irs, CH_KDF + (f * 64 + lane) * 16, o); }
        }
    }
    P2_BAR();
#ifndef NO_STEPD
    if (wave == 0) {
        const int c = lane & 31, hb = lane >> 5;
        const FK_LAS float* AF = (const FK_LAS float*)(lds + PL_AF) + (32 * hb) * 64 + 32 * hb;
        FK_LAS bf16_t* TP = (FK_LAS bf16_t*)(lds + PL_TP); FK_LAS bf16_t* TPP = (FK_LAS bf16_t*)(lds + PL_TPP);
        FK_LAS unsigned char* X1 = lds + PL_QS;
        asm volatile("" : "+v"(AF), "+v"(TP), "+v"(TPP), "+v"(X1));
        const int col = 32 * hb + c;
        const float bcol = TAB[128 + col], becol = bcol * TAB[64 + col];
        float t[32];
#pragma unroll
        for (int i = 0; i < 32; ++i) {
            float acc = (c == i) ? 1.f : 0.f;
#pragma unroll
            for (int j4 = 0; j4 < (i + 3) / 4; ++j4) { const f32x4 a = *(const FK_LAS f32x4*)(AF + i * 64 + 4 * j4);
#pragma unroll
                for (int e = 0; e < 4; ++e) if (4 * j4 + e < i) acc -= a[e] * t[4 * j4 + e]; }
            t[i] = acc;
            const unsigned pv = pk2(acc * becol, acc * bcol);
            TP[(32 * hb + i) * TP_LD + col] = (bf16_t)(pv & 0xffffu); TPP[(32 * hb + i) * TP_LD + col] = (bf16_t)(pv >> 16);
            if (hb == 0) { TP[i * TP_LD + 32 + c] = 0; TPP[i * TP_LD + 32 + c] = 0; }
            const unsigned tb = pk2(acc, acc);
            if (hb == 1) *(FK_LAS bf16_t*)(X1 + 2560 + i * 80 + c * 2) = (bf16_t)(tb & 0xffffu);
            if ((i & 1) == 1) asm volatile("" ::: "memory");
        }
        if (hb == 0) {
#pragma unroll
            for (int q = 0; q < 4; ++q) { u32x4 w; w.x = pk2(t[8 * q], t[8 * q + 1]); w.y = pk2(t[8 * q + 2], t[8 * q + 3]); w.z = pk2(t[8 * q + 4], t[8 * q + 5]); w.w = pk2(t[8 * q + 6], t[8 * q + 7]);
                *(FK_LAS u32x4*)(X1 + c * 80 + q * 16) = w; }
        }
        asm volatile("s_waitcnt lgkmcnt(0)" ::: "memory");
        f32x16 xacc = zero16();
        const FK_LAS float* A21 = (const FK_LAS float*)(lds + PL_AF) + (32 + c) * 64;
#pragma unroll
        for (int s2 = 0; s2 < 2; ++s2) { const f32x4 a0 = *(const FK_LAS f32x4*)(A21 + 16 * s2 + 8 * hb), a1 = *(const FK_LAS f32x4*)(A21 + 16 * s2 + 8 * hb + 4);
            u32x4 af; af.x = pk2(a0[0], a0[1]); af.y = pk2(a0[2], a0[3]); af.z = pk2(a1[0], a1[1]); af.w = pk2(a1[2], a1[3]);
            const bf16x8 bfrag = *(const FK_LAS bf16x8*)(X1 + c * 80 + (16 * s2 + 8 * hb) * 2);
            xacc = FK_MFMA32(__builtin_bit_cast(bf16x8, af), bfrag, xacc); }
        f32x16 yacc = zero16();
#pragma unroll
        for (int s2 = 0; s2 < 2; ++s2) { const u32x2 lo = *(const FK_LAS u32x2*)(X1 + 2560 + c * 80 + (16 * s2 + 4 * hb) * 2), hi = *(const FK_LAS u32x2*)(X1 + 2560 + c * 80 + (16 * s2 + 8 + 4 * hb) * 2);
            u32x4 af; af.x = lo.x; af.y = lo.y; af.z = hi.x; af.w = hi.y;
            yacc = FK_MFMA32(__builtin_bit_cast(bf16x8, af), pack8(xacc, s2), yacc); }
        const float bc0 = TAB[128 + c], bec0 = bc0 * TAB[64 + c];
#pragma unroll
        for (int reg = 0; reg < 16; ++reg) { const int i = 32 + crow(reg, hb); const unsigned pv = pk2(-yacc[reg] * bec0, -yacc[reg] * bc0);
            TP[i * TP_LD + c] = (bf16_t)(pv & 0xffffu); TPP[i * TP_LD + c] = (bf16_t)(pv >> 16); }
    }
#endif
    P2_BAR();
    {
        const int r = lane & 31, hh = lane >> 5;
        { const int mt = wave & 1, s4 = wave >> 1; f32x16 c = zero16();
#pragma unroll
          for (int s = 0; s < 4; ++s) { const bf16x8 a = *(const FK_LAS bf16x8*)(lds + PL_TPP + ((32 * mt + r) * TP_LD + 16 * s + 8 * hh) * 2);
              const bf16x8 bv = *(const FK_LAS bf16x8*)(lds + PL_VT + ((32 * s4 + r) * KT_LD + 16 * s + 8 * hh) * 2); c = FK_MFMA32(a, bv, c); }
          const unsigned dst = CH_UC + ((s4 * 64 + lane) * 2 + mt) * 32;
          st16_wt(irs, dst, __builtin_bit_cast(u32x4, pack8(c, 0))); st16_wt(irs, dst + 16, __builtin_bit_cast(u32x4, pack8(c, 1))); }
        { const int t = wave >> 1, mt = wave & 1; f32x16 c = zero16();
#pragma unroll
          for (int s = 0; s < 4; ++s) { const bf16x8 a = *(const FK_LAS bf16x8*)(lds + PL_KT + ((32 * t + r) * KT_LD + 16 * s + 8 * hh) * 2);
              const bf16x8 bt = *(const FK_LAS bf16x8*)(lds + PL_TP + ((32 * mt + r) * TP_LD + 16 * s + 8 * hh) * 2); c = FK_MFMA32(a, bt, c); }
#pragma unroll
          for (int s = 0; s < 2; ++s) st16_wt(irs, CH_WF + ((mt * 8 + 2 * t + s) * 64 + lane) * 16, __builtin_bit_cast(u32x4, pack8(c, s))); }
    }
    asm volatile("s_waitcnt vmcnt(0)" ::: "memory");
    P2_BAR();
    if (tid == 0) __hip_atomic_store((unsigned*)(p->ws + WS_FLAGS) + it, 1u, __ATOMIC_RELAXED, __HIP_MEMORY_SCOPE_AGENT);
}

#define SC_BAR() do { asm volatile("s_waitcnt lgkmcnt(0)" ::: "memory"); __builtin_amdgcn_s_barrier(); asm volatile("" ::: "memory"); } while (0)
constexpr int SC_STAGE = 57344, SC_OBUF = 2 * SC_STAGE, SC_OB_BYTES = 16384;

FK_DI void p3_scan(PP p, FK_LAS unsigned char* lds, int bh, int tid_in, int wave, int lane_in) {
    int lane = lane_in; asm volatile("" : "+v"(lane));
    const int b = bh >> 2, h = bh & 3;
    const unsigned char* items = p->ws + WS_CHUNK + (size_t)(bh * 64) * CH_BYTES;
    const float* GL = (const float*)(p->ws + WS_GL) + bh * 64;
    const int r = lane & 31, hh = lane >> 5;
    const __amdgpu_buffer_rsrc_t prs = __builtin_amdgcn_make_buffer_rsrc((void*)items, 0, 64 * CH_BYTES, 0x00020000);
    const unsigned* flags = (const unsigned*)(p->ws + WS_FLAGS) + bh * 64;
    if (wave < 4) {
        f32x16 S[4]; bf16x8 Sf[8];
#pragma unroll
        for (int t = 0; t < 4; ++t) S[t] = zero16();
#pragma unroll
        for (int k = 0; k < 8; ++k) Sf[k] = (bf16x8){0, 0, 0, 0, 0, 0, 0, 0};
        const unsigned ubase = CH_UC + wave * 4096 + lane * 64;
        u32x4 u0[4], u1[4];
        SC_BAR();
#define SC_ULD(ub, k) do { _Pragma("unroll") for (int i_ = 0; i_ < 4; ++i_) ub[i_] = __builtin_bit_cast(u32x4, __builtin_amdgcn_raw_buffer_load_b128(prs, ubase + (unsigned)(k) * CH_BYTES + i_ * 16, 0, 18)); } while (0)
        SC_ULD(u0, 0); SC_ULD(u1, 1);
        unsigned g0 = __hip_atomic_load((const unsigned*)GL, __ATOMIC_RELAXED, __HIP_MEMORY_SCOPE_AGENT), g1 = __hip_atomic_load((const unsigned*)GL + 1, __ATOMIC_RELAXED, __HIP_MEMORY_SCOPE_AGENT);
#define SC_STEP(n, ub, gv, RELOAD) do { \
            const FK_LAS unsigned char* st = lds + ((n) & 1) * SC_STAGE + lane * 16; \
            const float egl = __uint_as_float(gv); \
            f32x16 av[2]; \
            _Pragma("unroll") for (int mt = 0; mt < 2; ++mt) { av[mt] = zero16(); \
                _Pragma("unroll") for (int kk = 0; kk < 8; ++kk) { const bf16x8 wa = *(const FK_LAS bf16x8*)(st + CH_WF + (mt * 8 + kk) * 1024); av[mt] = FK_MFMA32(wa, Sf[kk], av[mt]); } } \
            bf16x8 Vf[4]; \
            _Pragma("unroll") for (int mt = 0; mt < 2; ++mt) { \
                _Pragma("unroll") for (int q = 0; q < 8; ++q) { const unsigned uw = ub[2 * mt + (q >> 2)][q & 3]; av[mt][2 * q] = bf_lo(uw) - av[mt][2 * q]; av[mt][2 * q + 1] = bf_hi(uw) - av[mt][2 * q + 1]; } \
                Vf[2 * mt] = pack8(av[mt], 0); Vf[2 * mt + 1] = pack8(av[mt], 1); } \
            if (RELOAD) { SC_ULD(ub, (n) + 2); gv = __hip_atomic_load((const unsigned*)GL + (n) + 2, __ATOMIC_RELAXED, __HIP_MEMORY_SCOPE_AGENT); } \
            f32x16 ao[2]; \
            _Pragma("unroll") for (int mt = 0; mt < 2; ++mt) { ao[mt] = zero16(); \
                _Pragma("unroll") for (int kk = 0; kk < 8; ++kk) { const bf16x8 qa = *(const FK_LAS bf16x8*)(st + CH_QDF + (mt * 8 + kk) * 1024); ao[mt] = FK_MFMA32(qa, Sf[kk], ao[mt]); } \
                _Pragma("unroll") for (int ks = 0; ks < 4; ++ks) { const bf16x8 aa = *(const FK_LAS bf16x8*)(st + CH_ATF + (mt * 4 + ks) * 1024); ao[mt] = FK_MFMA32(aa, Vf[ks], ao[mt]); } } \
            _Pragma("unroll") for (int t = 0; t < 4; ++t) { S[t] = S[t] * egl; \
                _Pragma("unroll") for (int ks = 0; ks < 4; ++ks) { const bf16x8 ka = *(const FK_LAS bf16x8*)(st + CH_KDF + (t * 4 + ks) * 1024); S[t] = FK_MFMA32(ka, Vf[ks], S[t]); } \
                Sf[2 * t] = pack8(S[t], 0); Sf[2 * t + 1] = pack8(S[t], 1); } \
            FK_LAS bf16_t* ob = (FK_LAS bf16_t*)(lds + SC_OBUF + ((n) & 1) * SC_OB_BYTES) + 32 * wave + r; \
            _Pragma("unroll") for (int mt = 0; mt < 2; ++mt) \
                _Pragma("unroll") for (int q = 0; q < 8; ++q) { const unsigned pv = pk2(ao[mt][2 * q], ao[mt][2 * q + 1]); \
                    ob[(32 * mt + crow(2 * q, hh)) * 128] = (bf16_t)(pv & 0xffffu); ob[(32 * mt + crow(2 * q + 1, hh)) * 128] = (bf16_t)(pv >> 16); } \
            SC_BAR(); } while (0)
        for (int n = 0; n < NCH - 8; n += 8) { SC_STEP(n, u0, g0, true); SC_STEP(n + 1, u1, g1, true); SC_STEP(n + 2, u0, g0, true); SC_STEP(n + 3, u1, g1, true); SC_STEP(n + 4, u0, g0, true); SC_STEP(n + 5, u1, g1, true); SC_STEP(n + 6, u0, g0, true); SC_STEP(n + 7, u1, g1, true); }
        SC_STEP(NCH - 8, u0, g0, true); SC_STEP(NCH - 7, u1, g1, true); SC_STEP(NCH - 6, u0, g0, true); SC_STEP(NCH - 5, u1, g1, true); SC_STEP(NCH - 4, u0, g0, true); SC_STEP(NCH - 3, u1, g1, true);
        SC_STEP(NCH - 2, u0, g0, false); SC_STEP(NCH - 1, u1, g1, false);
#undef SC_STEP
#undef SC_ULD
        SC_BAR();
    } else {
        const int e = wave - 4, l16 = lane & 15, rq = lane >> 4;
        const unsigned char* Zu = (const unsigned char*)p->out + DO_Z + ((size_t)b * SEQ * 512 + h * 128 + (size_t)(16 * e) * 512) * 2;
        unsigned char* Mu = p->ws + WS_MIX + ((size_t)b * SEQ * D + h * 128 + (size_t)(16 * e) * D) * 2;
        const __amdgpu_buffer_rsrc_t mxrs = __builtin_amdgcn_make_buffer_rsrc((void*)Mu, 0, SEQ * 2048, 0x00020000);
        unsigned* prog = (unsigned*)(p->ws + WS_PROG) + b;
        const unsigned zoff = (unsigned)(rq * 512 + 8 * l16) * 2u, moff = (unsigned)(rq * D + 8 * l16) * 2u, soff = (unsigned)lane * 16u;
        const unsigned src = (unsigned)(e * 14336) + (unsigned)lane * 16u;
        FK_LAS unsigned char* dstw = lds + e * 14336 + lane * 16;
        u32x4 sa[14], sb[14], sc[14]; u32x4 za[4], zb[4];
#define SC_POLL(k) do { unsigned sp_ = 0; while ((unsigned)__builtin_amdgcn_readfirstlane(__hip_atomic_load(flags + (k), __ATOMIC_RELAXED, __HIP_MEMORY_SCOPE_AGENT)) == 0u) { __builtin_amdgcn_s_sleep(2); if (++sp_ > (1u << 22)) break; } } while (0)
#define SC_LD(set, k) do { SC_POLL(k); _Pragma("unroll") for (int i = 0; i < 14; ++i) set[i] = __builtin_bit_cast(u32x4, __builtin_amdgcn_raw_buffer_load_b128(prs, src + (unsigned)(k) * CH_BYTES + i * 1024, 0, 18)); } while (0)
#define SC_WR(set, k) do { FK_LAS unsigned char* d_ = dstw + ((k) & 1) * SC_STAGE; _Pragma("unroll") for (int i = 0; i < 14; ++i) *(FK_LAS u32x4*)(d_ + i * 1024) = set[i]; } while (0)
#define SC_ZLD(zs, k) do { _Pragma("unroll") for (int q = 0; q < 4; ++q) zs[q] = __builtin_nontemporal_load((const u32x4*)(Zu + (size_t)((k) * 64 + 4 * q) * 1024 + zoff)); } while (0)
#define SC_GATE(zs, k) do { const FK_LAS unsigned char* ob = lds + SC_OBUF + ((k) & 1) * SC_OB_BYTES; \
            _Pragma("unroll") for (int q = 0; q < 4; ++q) { const int row = 16 * e + 4 * q + rq; const u32x4 ov = *(const FK_LAS u32x4*)(ob + row * 256 + l16 * 16); \
                float o[8] = {bf_lo(ov.x), bf_hi(ov.x), bf_lo(ov.y), bf_hi(ov.y), bf_lo(ov.z), bf_hi(ov.z), bf_lo(ov.w), bf_hi(ov.w)}; \
                float ss = 0.f; _Pragma("unroll") for (int j = 0; j < 8; ++j) ss += o[j] * o[j]; \
                ss = sum16(ss); \
                const float rs = rsqrtf(ss * (1.f / 128.f) + EPS); const u32x4 zv = zs[q]; \
                const float z[8] = {bf_lo(zv.x), bf_hi(zv.x), bf_lo(zv.y), bf_hi(zv.y), bf_lo(zv.z), bf_hi(zv.z), bf_lo(zv.w), bf_hi(zv.w)}; \
                u32x4 w; w.x = pk2(o[0] * rs * z[0], o[1] * rs * z[1]); w.y = pk2(o[2] * rs * z[2], o[3] * rs * z[3]); \
                w.z = pk2(o[4] * rs * z[4], o[5] * rs * z[5]); w.w = pk2(o[6] * rs * z[6], o[7] * rs * z[7]); \
                __builtin_amdgcn_raw_buffer_store_b128(w, mxrs, moff, (unsigned)((k) * 64 + 4 * q) * 2048u, 16); asm volatile("" ::: "memory"); } } while (0)
        SC_LD(sc, 0); SC_WR(sc, 0); SC_LD(sa, 1); SC_LD(sb, 2); SC_LD(sc, 3); SC_ZLD(za, 0);
        SC_BAR();
#define SC_PUB() do { asm volatile("s_waitcnt vmcnt(0)" ::: "memory"); if (lane == 0) __hip_atomic_fetch_add(prog, 1u, __ATOMIC_RELAXED, __HIP_MEMORY_SCOPE_AGENT); } while (0)
#define SC_LSTEP(n, set, zs, WR, LD, GT, ZL) do { \
            if ((n) == 29 || (n) == 57 || (n) == 61) SC_PUB();        \
            if (WR) SC_WR(set, (n) + 1); \
            if (LD) SC_LD(set, (n) + 4); \
            if (GT) SC_GATE(zs, (n) - 1); \
            if (ZL) SC_ZLD(zs, (n) + 1); \
            SC_BAR(); } while (0)
        SC_LSTEP(0, sa, zb, true, true, false, true); SC_LSTEP(1, sb, za, true, true, true, true); SC_LSTEP(2, sc, zb, true, true, true, true);
        for (int n = 3; n < NCH - 7; n += 6) {
            SC_LSTEP(n, sa, za, true, true, true, true); SC_LSTEP(n + 1, sb, zb, true, true, true, true); SC_LSTEP(n + 2, sc, za, true, true, true, true);
            SC_LSTEP(n + 3, sa, zb, true, true, true, true); SC_LSTEP(n + 4, sb, za, true, true, true, true); SC_LSTEP(n + 5, sc, zb, true, true, true, true); }
        SC_LSTEP(57, sa, za, true, true, true, true); SC_LSTEP(58, sb, zb, true, true, true, true); SC_LSTEP(59, sc, za, true, true, true, true);
        SC_LSTEP(60, sa, zb, true, false, true, true); SC_LSTEP(61, sb, za, true, false, true, true); SC_LSTEP(62, sc, zb, true, false, true, true);
        SC_LSTEP(63, sa, za, false, false, true, false);
        SC_LSTEP(64, sb, zb, false, false, true, false);
        SC_PUB();
#undef SC_PUB
#undef SC_LD
#undef SC_WR
#undef SC_ZLD
#undef SC_GATE
#undef SC_LSTEP
    }
}
}
namespace fk {
namespace cg = cooperative_groups;
#ifndef WGM_P1
#define WGM_P1 4
#endif
#ifndef WGM_P7
#define WGM_P7 4
#endif

struct ProbXW {
    const char* KB; const char* VB; const char* WXQ; const char* WXO; int lda, ldb, K; int G, c;
    FK_DI bool next(int i, Unit& u) const { const int L = i * G + c; if (L >= 256) return false; u.pm = L; u.pn = 0; return true; }
    FK_DI const char* aptr(const Unit& u) const { const int L = u.pm & 127, b = L >> 4, h = (L >> 2) & 3, q4 = L & 3;
        return (u.pm < 128) ? KB + ((size_t)(b * 256) * 1024 + h * 256) * 2 : WXO + ((size_t)(q4 * 256) * 1024 + h * 256) * 2; }
    FK_DI const char* bptr(const Unit& u) const { const int L = u.pm & 127, b = L >> 4, h = (L >> 2) & 3, q4 = L & 3;
        return (u.pm < 128) ? WXQ + ((size_t)(q4 * 256) * 1024 + h * 256) * 2 : VB + ((size_t)(b * 256) * 1024 + h * 256) * 2; }
};
struct EpiXW {
    static constexpr bool PERM = true;
    bf16_t* WQP; bf16_t* VWP;
    FK_DI void operator()(Acc& acc, const Unit& u, int wr, int wc, int fr, int fq, FK_LAS unsigned char*) const {
        const int L = u.pm & 127, b = L >> 4, h = (L >> 2) & 3, q4 = L & 3;
        bf16_t* base = (u.pm < 128) ? WQP + (size_t)b * 1048576 + (size_t)(h * 256) * 1024 + q4 * 256 : VWP + (size_t)b * 1048576 + (size_t)(q4 * 256) * 1024 + h * 256;
        const int row0 = wr * 64 + fr, col0 = wc * 32 + 8 * fq;
#pragma unroll
        for (int ai = 0; ai < 2; ++ai)
#pragma unroll
            for (int m = 0; m < 4; ++m) { bf16_t* rowp = base + (size_t)(row0 + ai * HALF + m * 16) * 1024 + col0;
#pragma unroll
                for (int bj = 0; bj < 2; ++bj) { const f32x4 v0 = acc[ai][bj][m][0], v1 = acc[ai][bj][m][1];
                    u32x4 w; w.x = pk2(v0[0], v0[1]); w.y = pk2(v0[2], v0[3]); w.z = pk2(v1[0], v1[1]); w.w = pk2(v1[2], v1[3]);
                    *(u32x4*)(rowp + bj * HALF) = w; } }
    }
};

struct ProbOne {
    const char* A; const char* Bt; int lda, ldb, K; int pm, pn;
    FK_DI bool next(int i, Unit& u) const { if (i) return false; u.pm = pm; u.pn = pn; return true; }
    FK_DI const char* aptr(const Unit& u) const { return A + (size_t)u.pm * 256 * lda * 2; }
    FK_DI const char* bptr(const Unit& u) const { return Bt + (size_t)u.pn * 256 * ldb * 2; }
};

__global__ void __launch_bounds__(512, 2) mega(Params p_arg) {
    PP p = (PP)__builtin_amdgcn_kernarg_segment_ptr();
    extern __shared__ __attribute__((aligned(16))) unsigned char lds_raw[];
    FK_LAS unsigned char* lds = (FK_LAS unsigned char*)lds_raw;
    cg::grid_group grid = cg::this_grid();
    int tid = threadIdx.x, lane = tid & 63; const int wave = __builtin_amdgcn_readfirstlane(tid >> 6);
    const int G = gridDim.x, bid = blockIdx.x, gw = bid * 8 + wave, NGW = G * 8;
#ifndef PHMASK
#define PHMASK 0x3ff
#endif
#define PH(k) (((PHMASK >> (k)) & 1) && p->dbg_lo <= (k) && (k) <= p->dbg_hi)
#ifndef REPMASK
#define REPMASK 0
#endif
#ifdef EXPK
#define TS0(k) if ((k) == EXPK && bid == 0 && tid == 0) *(volatile FK_LAS unsigned long long*)(lds + LDS_TOTAL) = __builtin_amdgcn_s_memrealtime();
#define TS1(k) if ((k) == EXPK && bid == 0 && tid == 0) *(volatile FK_LAS unsigned long long*)(lds + LDS_TOTAL + 8) = __builtin_amdgcn_s_memrealtime();
#else
#define TS0(k)
#define TS1(k)
#endif
#define REPS(k) asm volatile("" : "+s"(p)); unsigned char* ws = p->ws; for (int rep_ = 0; rep_ <= ((REPMASK >> (k)) & 1); ++rep_, ({ asm volatile("" : "+v"(tid), "+v"(lane)); }))
    constexpr bool AL = true, SP = true;
    volatile FK_LAS unsigned* xb_st = (volatile FK_LAS unsigned*)(lds + LDS_TOTAL + 16);
    if (tid < 2) xb_st[tid] = 0u;
    __syncthreads();
    XcdBarrier xb = xcd_barrier_post((unsigned*)(p->ws + WS_BAR), xb_st);
    if (p->dbg_lo == 0x7fffffff) grid.sync();
    { TS0(0) REPS(0) if (PH(0)) { p0_prologue(p, lds, gw, NGW, wave, lane); }
    }
    xcd_barrier(xb);
    TS1(0)
    { TS0(1) REPS(1) if (PH(1)) {
        { ProbStd S{(const char*)p->out + DO_XN, (const char*)(ws + WS_WIN_T), D, D, D, 0}; S.T.init(M / 256, N1 / 256, G, bid, WGM_P1);
          EpiBf16Split E{(bf16_t*)(ws + WS_QKV), (bf16_t*)((unsigned char*)p->out + DO_Z), (bf16_t*)(ws + WS_SC), 6, 8, 1536, 512, 1024, 10, p->in[7]};
          gemm_phase<EpiBf16Split, ProbStd, AL, SP>(lds, S, E); }
        if (bid < 64) { ProbStd S{(const char*)(ws + WS_MEMN), (const char*)(ws + WS_WXK_T), D, D, D, 0}; S.T.init(8, 8, G, bid);
          EpiBf16Split E{(bf16_t*)(ws + WS_KV), (bf16_t*)(ws + WS_KV) + (size_t)2048 * 1024, nullptr, 4, 8, 1024, 1024, 1024, 1 << 30, nullptr};
          gemm_phase<EpiBf16Split, ProbStd, AL, SP>(lds, S, E); }
        else late_weights(p, lds, (bid - 64) * 8 + wave, (G - 64) * 8, wave, lane);
    }
    }
    xcd_barrier(xb);
    TS1(1)
    { TS0(2) TS0(3) REPS(2) if (PH(2)) {
        if (bid < 32) p3_scan(p, lds, bid, tid, wave, lane);
        else if (G == 256) {
            { const float* cw = p->in[4];
              for (int i = tid; i < 4 * 3 * 4 * 128; i += 512) { const int hh_ = i / 1536, r_ = i % 1536, pt = r_ >> 9, k = (r_ >> 7) & 3, c = r_ & 127; ((FK_LAS float*)(lds + PL_CW))[i] = cw[k * 1536 + pt * 512 + hh_ * 128 + c]; } }
            const int w0 = bid - 32;
            auto item_of = [](int idx) { return (idx & 31) * 64 + (idx >> 5); };
            P2Raw R; p2_load(p, item_of(w0), tid, lane, R);
            __syncthreads();
            for (int idx = w0; idx < NITEM; idx += 224) { int it = item_of(idx); asm volatile("" : "+s"(it)); const int nx = idx + 224; p2_item(p, lds, it, nx < NITEM ? item_of(nx) : -1, tid, wave, lane, R); }
            for (int vw = w0 * 8 + wave; vw < 2048; vw += 224 * 8) p2_short_conv(p, vw, lane);
            asm volatile("s_waitcnt vmcnt(0)" ::: "memory");
            __syncthreads();
            if (tid == 0) __hip_atomic_fetch_add((unsigned*)(ws + WS_PROG) + 8, 1u, __ATOMIC_RELAXED, __HIP_MEMORY_SCOPE_AGENT);
            { ProbXW S{(const char*)(ws + WS_KV), (const char*)(ws + WS_KV) + (size_t)2048 * 1024 * 2, (const char*)(ws + WS_WXQ_G), (const char*)(ws + WS_WXO_T), D, D, 256, G - 32, bid - 32};
              EpiXW E{(bf16_t*)(ws + WS_WQP), (bf16_t*)(ws + WS_VWP)};
              gemm_phase<EpiXW, ProbXW, AL, SP>(lds, S, E); }
        }
        if (G == 256) {
            const int x = bid & 7;
            for (int r = 0; r < 3; ++r) {
                int t, level;
                if (bid < 32) { if (r > 0) break; t = 60 + (bid >> 3); level = 4; }
                else { t = ((bid - 32) >> 3) + 28 * r; if (t >= 60) break; level = t < 28 ? 1 : (t < 56 ? 2 : 3); }
                if (tid == 0) { unsigned* pg = (unsigned*)(ws + WS_PROG); unsigned sp_ = 0;
                    while (__hip_atomic_load(pg + x, __ATOMIC_RELAXED, __HIP_MEMORY_SCOPE_AGENT) < 16u * (unsigned)level || __hip_atomic_load(pg + 8, __ATOMIC_RELAXED, __HIP_MEMORY_SCOPE_AGENT) < 224u) { __builtin_amdgcn_s_sleep(8); if (++sp_ > (1u << 21)) break; }
                    __builtin_amdgcn_fence(__ATOMIC_ACQUIRE, "agent"); asm volatile("s_waitcnt vmcnt(0)" ::: "memory"); }
                __syncthreads();
                ProbOne S{(const char*)(ws + WS_MIX), (const char*)(ws + WS_WOUT_T), D, D, D, x * 16 + (t >> 2), t & 3};
                EpiResidB E{p->in[0], nullptr, (bf16_t*)(ws + WS_HB), (float*)(ws + WS_SS1)};
                gemm_phase<EpiResidB, ProbOne, AL, SP>(lds, S, E);
            }
        }
    }
    }
    xcd_barrier(xb);
    TS1(2) TS1(3)
    { TS0(5) REPS(5) if (PH(5)) { ProbStd S{(const char*)(ws + WS_HB), (const char*)(ws + WS_WQP), D, D, D, (size_t)2 * 1048576}; S.T.init(M / 256, 4, G, bid);
        EpiSoftmax E{(const float*)(ws + WS_SS1), (bf16_t*)(ws + WS_P)};
        gemm_phase<EpiSoftmax, ProbStd, AL, SP>(lds, S, E); }
    }
    xcd_barrier(xb);
    TS1(5)
    { TS0(6) REPS(6) if (PH(6)) { ProbStd S{(const char*)(ws + WS_P), (const char*)(ws + WS_VWP), D, D, D, (size_t)2 * 1048576}; S.T.init(M / 256, 4, G, bid);
        EpiResidB E{nullptr, (const bf16_t*)(ws + WS_HB), (bf16_t*)(ws + WS_HB), (float*)(ws + WS_SS2)};
        gemm_phase<EpiResidB, ProbStd, AL, SP>(lds, S, E); }
    }
    xcd_barrier(xb);
    TS1(6)
    { TS0(7) REPS(7) if (PH(7)) { ProbStd S{(const char*)(ws + WS_HB), (const char*)(ws + WS_WGU_T), D, D, D, 0}; S.T.init(M / 256, 2 * DFF / 256, G, bid, WGM_P7);
        EpiGateUp E{(const float*)(ws + WS_SS2), (bf16_t*)(ws + WS_ACT)};
        gemm_phase<EpiGateUp, ProbStd, AL, SP>(lds, S, E); }
    }
    xcd_barrier(xb);
    TS1(7)
    { TS0(8) REPS(8) if (PH(8)) { ProbStd S{(const char*)(ws + WS_ACT), (const char*)(ws + WS_WDN_T), DFF, DFF, DFF, 0}; S.T.init(M / 256, 4, G, bid);
        EpiFinal E{(const bf16_t*)(ws + WS_HB), p->out, (float*)(ws + WS_SS3), (unsigned*)(ws + WS_PCNT), p->in[21]};
        gemm_phase<EpiFinal, ProbStd, AL, SP>(lds, S, E); }
    }
    TS1(8)
#ifdef EXPK
    if (EXPK == 9) { __syncthreads(); TS1(9) }
    if (bid == 0 && tid == 0) { const unsigned long long ts0_ = *(volatile FK_LAS unsigned long long*)(lds + LDS_TOTAL), ts1_ = *(volatile FK_LAS unsigned long long*)(lds + LDS_TOTAL + 8);
        const unsigned long long te = __builtin_amdgcn_s_memrealtime(), dt = (ts1_ - ts0_) * EXPMULT;
        while (__builtin_amdgcn_s_memrealtime() - te < dt) __builtin_amdgcn_s_sleep(32); }
#endif
#undef PH
}

static int launch_mega(void* const* d_in, void* d_out, void* d_ws, size_t ws_size, hipStream_t stream, int lo, int hi) {
    static int grid_blocks = 0;
    if (!grid_blocks) {
        int dev = 0, cus = 0, per_cu = 0;
        hipGetDevice(&dev); hipDeviceGetAttribute(&cus, hipDeviceAttributeMultiprocessorCount, dev);
        if (hipFuncSetAttribute((const void*)mega, hipFuncAttributeMaxDynamicSharedMemorySize, LDS_TOTAL + 64) != hipSuccess) { fprintf(stderr, "hipFuncSetAttribute failed\n"); grid_blocks = -1; return -1; }
        hipOccupancyMaxActiveBlocksPerMultiprocessor(&per_cu, (const void*)mega, 512, LDS_TOTAL + 64);
        if (per_cu < 1) { fprintf(stderr, "occupancy query says %d blocks/CU\n", per_cu); per_cu = 1; }
        grid_blocks = cus * 1;
        if (ws_size < WS_END) { fprintf(stderr, "ws too small: %zu < %zu\n", ws_size, (size_t)WS_END); grid_blocks = -1; return -1; }
    }
    if (grid_blocks < 0) return -1;
    if (hipMemsetAsync((char*)d_ws + WS_BAR, 0, (WS_FLAGS - WS_BAR) + NITEM * 4 + 512 + 64, stream) != hipSuccess) { fprintf(stderr, "memset of barrier words failed\n"); return -1; }
    Params p{}; for (int i = 0; i < 22; ++i) p.in[i] = (const float*)d_in[i];
    p.out = (float*)d_out; p.ws = (unsigned char*)d_ws; p.dbg_lo = lo; p.dbg_hi = hi;
    void* args[] = {&p};
    hipError_t e = hipLaunchCooperativeKernel((const void*)mega, dim3(grid_blocks), dim3(512), args, LDS_TOTAL + 64, stream);
    if (e != hipSuccess) { fprintf(stderr, "cooperative launch failed: %s (grid %d)\n", hipGetErrorString(e), grid_blocks); return -1; }
    return 0;
}
}
extern "C" void kernel_launch(void* const* d_in, const int* in_sizes, int n_in, void* d_out, int out_size, void* d_ws, size_t ws_size, hipStream_t stream) {
    fk::launch_mega(d_in, d_out, d_ws, ws_size, stream, 0, 99);
}
```

```cpp
#include <hip/hip_runtime.h>
#include <hip/hip_cooperative_groups.h>
#include <cstdio>
namespace fk {
#define FK_LAS __attribute__((address_space(3)))
#define FK_DI __device__ __forceinline__
typedef unsigned short bf16_t;
typedef short bf16x8 __attribute__((ext_vector_type(8)));
typedef float f32x2 __attribute__((ext_vector_type(2)));
typedef float f32x4 __attribute__((ext_vector_type(4)));
typedef float f32x16 __attribute__((ext_vector_type(16)));
typedef unsigned u32x2 __attribute__((ext_vector_type(2)));
typedef unsigned u32x4 __attribute__((ext_vector_type(4)));
typedef __bf16 bf16v2 __attribute__((ext_vector_type(2)));

constexpr int M = 32768, D = 1024, SEQ = 4096, NB = 8, DFF = 2816, N1 = 3584, INC = 3592, NCH = 64  , NITEM = NB * 4 * NCH;
constexpr float EPS = 1e-6f;

FK_DI unsigned pk2(float lo, float hi) { f32x2 v = {lo, hi}; bf16v2 r = __builtin_convertvector(v, bf16v2); return __builtin_bit_cast(unsigned, r); }
FK_DI float bf_lo(unsigned u) { return __uint_as_float(u << 16); }
FK_DI float bf_hi(unsigned u) { return __uint_as_float(u & 0xffff0000u); }
FK_DI float silu(float x) { return x * __builtin_amdgcn_rcpf(1.f + __expf(-x)); }
template <int CTRL> FK_DI float dpp_mov(float v) { return __builtin_bit_cast(float, __builtin_amdgcn_update_dpp(0, __builtin_bit_cast(int, v), CTRL, 0xF, 0xF, true)); }
FK_DI float sum8(float v) { v += dpp_mov<0xB1>(v); v += dpp_mov<0x4E>(v); v += dpp_mov<0x141>(v); return v; }
FK_DI float sum16(float v) { v = sum8(v); v += dpp_mov<0x140>(v); return v; }
FK_DI float wave_sum(float v) {
    v = sum16(v);
    const float r0 = __builtin_bit_cast(float, __builtin_amdgcn_readlane(__builtin_bit_cast(int, v), 0)), r1 = __builtin_bit_cast(float, __builtin_amdgcn_readlane(__builtin_bit_cast(int, v), 16));
    const float r2 = __builtin_bit_cast(float, __builtin_amdgcn_readlane(__builtin_bit_cast(int, v), 32)), r3 = __builtin_bit_cast(float, __builtin_amdgcn_readlane(__builtin_bit_cast(int, v), 48));
    return (r0 + r1) + (r2 + r3);
}

constexpr size_t MiB = 1u << 20;
constexpr size_t WS_WIN_T = 0;
constexpr size_t WS_WOUT_T = 7 * MiB;
constexpr size_t WS_WXQ_G = 9 * MiB;
constexpr size_t WS_WXK_T = 11 * MiB;
constexpr size_t WS_WXV_T = 13 * MiB;
constexpr size_t WS_WXO_T = 15 * MiB;
constexpr size_t WS_WGU_T = 17 * MiB;
constexpr size_t WS_WDN_T = 28 * MiB;
constexpr size_t WS_WQP = 34 * MiB;
constexpr size_t WS_VWP = 50 * MiB;
constexpr size_t WS_MEMN = 66 * MiB;
constexpr size_t WS_KV = 70 * MiB;
constexpr size_t WS_GB = 78 * MiB;
constexpr size_t WS_SS1 = 79 * MiB, WS_SS2 = 81 * MiB, WS_SS3 = 83 * MiB;
constexpr size_t WS_GL = 85 * MiB;
constexpr size_t WS_BAR = 85 * MiB + 65536;
constexpr size_t WS_FLAGS = 85 * MiB + 131072;
constexpr size_t WS_PCNT = WS_FLAGS + 8192;
constexpr size_t WS_PROG = WS_PCNT + 512;
constexpr size_t WS_QKV = 86 * MiB;
constexpr size_t WS_SC = 182 * MiB;
constexpr size_t WS_CHUNK = 278 * MiB;
constexpr size_t WS_MIX = 422 * MiB;
constexpr size_t WS_END = 486 * MiB;
constexpr size_t WS_ORAW = WS_QKV;
constexpr size_t WS_HB = WS_QKV;
constexpr size_t WS_P = WS_SC;
constexpr size_t WS_ACT = 246 * MiB;
constexpr size_t DO_XN = 0, DO_Z = 64 * MiB;
constexpr int CH_WF = 0, CH_KDF = 16384, CH_QDF = 32768, CH_ATF = 49152, CH_UC = 57344, CH_BYTES = 73728;

struct Params {
    const float* in[22];
    float* out; unsigned char* ws;
    int dbg_lo, dbg_hi;
};
typedef const __attribute__((address_space(4))) Params* PP;
}
namespace fk {
#define XB_TMO      128
#define XB_XCNT(j)  (256  + 64 * (j))
#define XB_XSUB(j)  (1280 + 64 * (j))
#define XB_XGEN(j)  (2304 + 64 * (j))
#define XB_TOP      3328
#define XB_TOPGEN   3392
#define XCD_BAR_WORDS 3456
#define XB_SPIN_CAP (1u << 18)

__device__ __forceinline__ unsigned xb_ld(unsigned* p)              { return __hip_atomic_load(p, __ATOMIC_RELAXED, __HIP_MEMORY_SCOPE_AGENT); }
__device__ __forceinline__ unsigned xb_add(unsigned* p, unsigned v) { return __hip_atomic_fetch_add(p, v, __ATOMIC_RELAXED, __HIP_MEMORY_SCOPE_AGENT); }
__device__ __forceinline__ unsigned xb_xcc_id() { return (unsigned)__builtin_amdgcn_s_getreg((3 << 11) | 20) & 0xFu; }
#define XB_SPIN(cond, bar) do { unsigned _sp = 0; while (cond) { __builtin_amdgcn_s_sleep(1); \
    if ((++_sp & 255u) == 0u) { if (xb_ld(&(bar)[XB_TMO])) break; if (_sp > XB_SPIN_CAP) { atomicAdd(&(bar)[XB_TMO], 1u); break; } } } } while (0)

struct XcdBarrier {
    unsigned* bar; unsigned x;
    volatile FK_LAS unsigned* st;
};

__device__ __forceinline__ XcdBarrier xcd_barrier_post(unsigned* bar, volatile FK_LAS unsigned* st) {
    XcdBarrier b; b.bar = bar; b.x = xb_xcc_id(); b.st = st;
    if (threadIdx.x == 0) (void)xb_add(&bar[XB_XCNT(b.x)], 1u);
    return b;
}
__device__ __forceinline__ void xcd_barrier_complete(unsigned* bar, unsigned x, unsigned& nloc, unsigned& nx) {
    const unsigned G = gridDim.x * gridDim.y * gridDim.z;
    unsigned sum, cnt, mine, sp = 0u;
    for (;;) {
        sum = 0u; cnt = 0u; mine = 0u;
#pragma unroll
        for (unsigned j = 0; j < 16; ++j) { const unsigned c = xb_ld(&bar[XB_XCNT(j)]); sum += c; cnt += (c > 0u) ? 1u : 0u; mine = (j == x) ? c : mine; }
        if (sum == G) break;
        __builtin_amdgcn_s_sleep(1);
        if ((++sp & 255u) == 0u) { if (xb_ld(&bar[XB_TMO])) break; if (sp > XB_SPIN_CAP) { atomicAdd(&bar[XB_TMO], 1u); break; } }
    }
    nloc = mine > 0u ? mine : 1u; nx = cnt > 0u ? cnt : 1u;
}

__device__ __forceinline__ void xcd_barrier(const XcdBarrier& b) {
    asm volatile("s_waitcnt vmcnt(0)" ::: "memory");
    __syncthreads();
    if (threadIdx.x == 0) {
        unsigned* bar = b.bar;
        __builtin_amdgcn_s_waitcnt(0);
        unsigned nloc = b.st[0], nx = b.st[1];
        if (nloc == 0u) { xcd_barrier_complete(bar, b.x, nloc, nx); b.st[0] = nloc; b.st[1] = nx; }
        const unsigned old = xb_add(&bar[XB_XSUB(b.x)], 1u);
        const unsigned gen = old / nloc;
        if (old + 1u == (gen + 1u) * nloc) {
            __builtin_amdgcn_fence(__ATOMIC_RELEASE, "agent");
            asm volatile("s_waitcnt vmcnt(0)" ::: "memory");
            const unsigned og = xb_add(&bar[XB_TOP], 1u);
            const unsigned tg = og / nx;
            if (og + 1u == (tg + 1u) * nx) xb_add(&bar[XB_TOPGEN], 1u);
            else XB_SPIN(xb_ld(&bar[XB_TOPGEN]) == tg, bar);
            __builtin_amdgcn_fence(__ATOMIC_ACQUIRE, "agent");
            xb_add(&bar[XB_XGEN(b.x)], 1u);
            asm volatile("s_waitcnt vmcnt(0)" ::: "memory");
        } else {
            XB_SPIN(xb_ld(&bar[XB_XGEN(b.x)]) == gen, bar);
            __builtin_amdgcn_fence(__ATOMIC_ACQUIRE, "agent");
            asm volatile("s_waitcnt vmcnt(0)" ::: "memory");
        }
    }
    __syncthreads();
}

}
namespace fk {
#ifndef GEMM_WGM
#define GEMM_WGM 4
#endif
constexpr int BM = 256, BK = 64, HALF = 128, HTB = HALF * BK * 2, STAGE_BYTES = 8 * HTB, NXCD = 8, WGM = GEMM_WGM;
constexpr int LDS_EXCH = STAGE_BYTES;
constexpr int LDS_TOTAL = STAGE_BYTES + 16384;

FK_DI int lds_byte(int r, int c) { const int st = (r >> 4) * 2 + (c >> 5), rr = r & 15, cc = c & 31, ob = rr * 64 + cc * 2; return st * 1024 + (ob ^ (((ob >> 9) & 1) << 5)); }
FK_DI void stage_rc(int b, int& R, int& C) { const int st = b / 1024, sb = b % 1024, swz = sb ^ (((sb >> 9) & 1) << 5); R = (st >> 1) * 16 + swz / 64; C = (st & 1) * 32 + (swz % 64) / 2; }
FK_DI int perm32(int rho) { const int n = rho >> 4, i = rho & 15; return 8 * (i >> 2) + 4 * n + (i & 3); }

struct Unit { int pm, pn; };

struct TileOrder {
    int nM, nN, nwg, G, c, wgm;
    FK_DI void init(int nM_, int nN_, int G_, int c_, int wgm_ = WGM) { nM = nM_; nN = nN_; nwg = nM * nN; G = G_; c = c_; wgm = wgm_; }
    FK_DI bool next(int i, Unit& u) const {
        const long L = (long)i * G + c; if (L >= nwg) return false;
        int wgid = (int)L; { const int q = nwg / NXCD, r = nwg % NXCD, xcd = wgid % NXCD, off = wgid / NXCD; wgid = (xcd < r ? xcd * (q + 1) : r * (q + 1) + (xcd - r) * q) + off; }
        const int nig = wgm * nN, gid = wgid / nig, fm = gid * wgm, gsz = (nM - fm) < wgm ? (nM - fm) : wgm;
        u.pm = fm + ((wgid % nig) % gsz); u.pn = (wgid % nig) / gsz; return true;
    }
};
struct ProbStd {
    const char* A; const char* Bt; int lda, ldb, K; size_t b_bstride; TileOrder T;
    FK_DI bool next(int i, Unit& u) const { return T.next(i, u); }
    FK_DI const char* aptr(const Unit& u) const { return A + (size_t)u.pm * 256 * lda * 2; }
    FK_DI const char* bptr(const Unit& u) const { return Bt + (size_t)u.pn * 256 * ldb * 2 + (size_t)(u.pm >> 4) * b_bstride; }
};

typedef f32x4 Acc[2][2][4][2];

template <class Epi, class Prob, bool ALIGN_EPI, bool SP2>
FK_DI void gemm_phase(FK_LAS unsigned char* lds, const Prob& S, const Epi& E) {
    int tid = threadIdx.x; asm volatile("" : "+v"(tid));
    const int wid = __builtin_amdgcn_readfirstlane(tid >> 6), lane = tid & 63, wr = wid >> 2, wc = wid & 3, fr = lane & 15, fq = lane >> 4;
    const int K = S.K, nt = K / BK, lda = S.lda, ldb = S.ldb;
    unsigned voffA[2], voffB[2];
#pragma unroll
    for (int i = 0; i < 2; ++i) { int R, C; stage_rc(tid * 16 + i * 8192, R, C); const int Rb = Epi::PERM ? ((R & ~31) + perm32(R & 31)) : R;
        voffA[i] = (unsigned)(R * lda + C) * 2u; voffB[i] = (unsigned)(Rb * ldb + C) * 2u; }
    const size_t kstep = (size_t)(BK * 2);
    const size_t hstepA = (size_t)HALF * lda * 2, hstepB = (size_t)HALF * ldb * 2;
    const unsigned ldsw = (unsigned)wid * 1024u;
    const int aoff = lds_byte(wr * 64 + fr, fq * 8), boff = lds_byte(wc * 32 + fr, fq * 8);
#define PG8_SA(b, h) (((b) * 2 + (h)) * HTB)
#define PG8_SB(b, h) ((4 + (b) * 2 + (h)) * HTB)
#define PG8_STAGE(bufoff, gbase, voff) do { _Pragma("unroll") for (int _i = 0; _i < 2; ++_i) \
        __builtin_amdgcn_global_load_lds((const unsigned*)((const char*)(gbase) + (voff)[_i]), (FK_LAS unsigned*)(lds + (bufoff) + ldsw + _i * 8192), 16, 0, 0); } while (0)
#define PG8_LDA(dst, b, h) do { _Pragma("unroll") for (int m = 0; m < 4; ++m) _Pragma("unroll") for (int k = 0; k < 2; ++k) dst[m][k] = *(const FK_LAS bf16x8*)(lds + PG8_SA(b, h) + aoff + m * 2048 + k * 1024); } while (0)
#define PG8_LDB(dst, b, h) do { _Pragma("unroll") for (int n = 0; n < 2; ++n) _Pragma("unroll") for (int k = 0; k < 2; ++k) dst[n][k] = *(const FK_LAS bf16x8*)(lds + PG8_SB(b, h) + boff + n * 2048 + k * 1024); } while (0)
#define PG8_MMA(ai, bj, At, Bt) do { __builtin_amdgcn_s_setprio(1); _Pragma("unroll") for (int m = 0; m < 4; ++m) _Pragma("unroll") for (int n = 0; n < 2; ++n) _Pragma("unroll") for (int k = 0; k < 2; ++k) \
        acc[ai][bj][m][n] = __builtin_amdgcn_mfma_f32_16x16x32_bf16(Bt[n][k], At[m][k], acc[ai][bj][m][n], 0, 0, 0); __builtin_amdgcn_s_setprio(0); } while (0)
#define PG8_WAIT_V(n) asm volatile("s_waitcnt vmcnt(" #n ")" ::: "memory")
#define PG8_WAIT_L(n) asm volatile("s_waitcnt lgkmcnt(" #n ")" ::: "memory")
#define PG8_BAR __builtin_amdgcn_s_barrier()
#define PG8_SCHED __builtin_amdgcn_sched_barrier(0)
    Unit cur, nxt; int ui = 0;
    if (!S.next(0, cur)) return;
    Acc acc;
#pragma unroll
    for (int a = 0; a < 2; ++a)
#pragma unroll
        for (int b = 0; b < 2; ++b)
#pragma unroll
            for (int m = 0; m < 4; ++m)
#pragma unroll
                for (int n = 0; n < 2; ++n) acc[a][b][m][n] = (f32x4){0.f, 0.f, 0.f, 0.f};
    bf16x8 At[4][2], B0[2][2], B1[2][2];
    const char* cA = S.aptr(cur); const char* cB = S.bptr(cur);
    if constexpr (SP2) {
        PG8_STAGE(PG8_SB(0, 0), cB, voffB); PG8_STAGE(PG8_SB(0, 1), cB + hstepB, voffB); PG8_STAGE(PG8_SA(0, 0), cA, voffA); PG8_STAGE(PG8_SA(0, 1), cA + hstepA, voffA);
        if (wr == 1) PG8_BAR;
        PG8_WAIT_V(2); PG8_BAR;
        PG8_STAGE(PG8_SB(1, 0), cB + kstep, voffB); PG8_STAGE(PG8_SA(1, 0), cA + kstep, voffA); PG8_STAGE(PG8_SB(1, 1), cB + hstepB + kstep, voffB);
        PG8_WAIT_V(6); PG8_BAR;
    } else {
        PG8_STAGE(PG8_SB(0, 0), cB, voffB); PG8_STAGE(PG8_SA(0, 0), cA, voffA); PG8_STAGE(PG8_SB(0, 1), cB + hstepB, voffB); PG8_STAGE(PG8_SA(0, 1), cA + hstepA, voffA);
        if (wr == 1) PG8_BAR;
        PG8_WAIT_V(4); PG8_BAR;
        PG8_STAGE(PG8_SB(1, 0), cB + kstep, voffB); PG8_STAGE(PG8_SA(1, 0), cA + kstep, voffA); PG8_STAGE(PG8_SB(1, 1), cB + hstepB + kstep, voffB);
        PG8_WAIT_V(6); PG8_BAR;
    }
    for (;;) {
        const bool has_next = S.next(ui + 1, nxt);
        const char* nA = has_next ? S.aptr(nxt) : cA; const char* nB = has_next ? S.bptr(nxt) : cB;
        for (int t = 0; t < nt; t += 2) {
            const bool last = (t == nt - 2);
            const char* a1 = cA + (size_t)(t + 1) * kstep;
            const char* a2 = last ? nA : cA + (size_t)(t + 2) * kstep; const char* b2 = last ? nB : cB + (size_t)(t + 2) * kstep;
            const char* a3 = a2 + kstep; const char* b3 = b2 + kstep;
            if constexpr (SP2) {
            PG8_LDB(B0, 0, 0); PG8_LDB(B1, 0, 1); PG8_SCHED; PG8_LDA(At, 0, 0); PG8_STAGE(PG8_SA(1, 1), a1 + hstepA, voffA);
            PG8_WAIT_V(8); PG8_WAIT_L(0); PG8_BAR; PG8_MMA(0, 0, At, B0); PG8_MMA(0, 1, At, B1); PG8_BAR; PG8_SCHED;
            PG8_LDA(At, 0, 1); PG8_STAGE(PG8_SB(0, 0), b2, voffB); PG8_STAGE(PG8_SB(0, 1), b2 + hstepB, voffB); PG8_STAGE(PG8_SA(0, 0), a2, voffA);
            PG8_WAIT_V(8); PG8_WAIT_L(0); PG8_BAR; PG8_MMA(1, 0, At, B0); PG8_MMA(1, 1, At, B1); PG8_BAR; PG8_SCHED;
            PG8_LDB(B0, 1, 0); PG8_LDB(B1, 1, 1); PG8_SCHED; PG8_LDA(At, 1, 0); PG8_STAGE(PG8_SA(0, 1), a2 + hstepA, voffA);
            PG8_WAIT_V(8); PG8_WAIT_L(0); PG8_BAR; PG8_MMA(0, 0, At, B0); PG8_MMA(0, 1, At, B1); PG8_BAR; PG8_SCHED;
            PG8_LDA(At, 1, 1); PG8_STAGE(PG8_SB(1, 0), b3, voffB); PG8_STAGE(PG8_SB(1, 1), b3 + hstepB, voffB); PG8_STAGE(PG8_SA(1, 0), a3, voffA);
            PG8_WAIT_V(8); PG8_WAIT_L(0); PG8_BAR; PG8_MMA(1, 0, At, B0); PG8_MMA(1, 1, At, B1); PG8_BAR; PG8_SCHED;
            } else {
            PG8_LDB(B0, 0, 0); PG8_SCHED; PG8_LDA(At, 0, 0); PG8_STAGE(PG8_SA(1, 1), a1 + hstepA, voffA);
            PG8_WAIT_L(8); PG8_BAR; PG8_WAIT_L(0); PG8_MMA(0, 0, At, B0); PG8_BAR; PG8_SCHED;
            PG8_LDB(B1, 0, 1); PG8_STAGE(PG8_SB(0, 0), b2, voffB);
            PG8_BAR; PG8_WAIT_L(0); PG8_MMA(0, 1, At, B1); PG8_BAR;
            PG8_LDA(At, 0, 1); PG8_STAGE(PG8_SA(0, 0), a2, voffA);
            PG8_BAR; PG8_WAIT_L(0); PG8_MMA(1, 0, At, B0); PG8_BAR; PG8_SCHED;
            PG8_STAGE(PG8_SB(0, 1), b2 + hstepB, voffB);
            PG8_WAIT_V(6); PG8_BAR; PG8_MMA(1, 1, At, B1); PG8_BAR;
            PG8_LDB(B0, 1, 0); PG8_SCHED; PG8_LDA(At, 1, 0); PG8_STAGE(PG8_SA(0, 1), a2 + hstepA, voffA);
            PG8_WAIT_L(8); PG8_BAR; PG8_WAIT_L(0); PG8_MMA(0, 0, At, B0); PG8_BAR; PG8_SCHED;
            PG8_LDB(B1, 1, 1); PG8_STAGE(PG8_SB(1, 0), b3, voffB);
            PG8_BAR; PG8_WAIT_L(0); PG8_MMA(0, 1, At, B1); PG8_BAR;
            PG8_LDA(At, 1, 1); PG8_STAGE(PG8_SA(1, 0), a3, voffA);
            PG8_BAR; PG8_WAIT_L(0); PG8_MMA(1, 0, At, B0); PG8_BAR; PG8_SCHED;
            PG8_STAGE(PG8_SB(1, 1), b3 + hstepB, voffB);
            PG8_WAIT_V(6); PG8_BAR; PG8_MMA(1, 1, At, B1); PG8_BAR;
            }
        }
        if constexpr (ALIGN_EPI) { if (wr == 0) PG8_BAR; }
        E(acc, cur, wr, wc, fr, fq, lds);
        if (!has_next) break;
#pragma unroll
        for (int a = 0; a < 2; ++a)
#pragma unroll
            for (int b = 0; b < 2; ++b)
#pragma unroll
                for (int m = 0; m < 4; ++m)
#pragma unroll
                    for (int n = 0; n < 2; ++n) acc[a][b][m][n] = (f32x4){0.f, 0.f, 0.f, 0.f};
        cur = nxt; cA = nA; cB = nB; ++ui;
        if constexpr (ALIGN_EPI) { if (wr == 1) PG8_BAR; }
    }
    PG8_WAIT_V(0);
    if constexpr (!ALIGN_EPI) { if (wr == 0) PG8_BAR; }
    PG8_BAR;
#undef PG8_SA
#undef PG8_SB
#undef PG8_STAGE
#undef PG8_LDA
#undef PG8_LDB
#undef PG8_MMA
#undef PG8_WAIT_V
#undef PG8_WAIT_L
#undef PG8_BAR
#undef PG8_SCHED
}

struct EpiBf16Split {
    static constexpr bool PERM = true;
    bf16_t* o0; bf16_t* o1; bf16_t* o2; int t1, t2;
    int ld0, ld1, ld2;
    int t3;
    const float* gz;
    FK_DI void operator()(Acc& acc, const Unit& u, int wr, int wc, int fr, int fq, FK_LAS unsigned char*) const {
        bf16_t* base; int ld, ct; bool gate = false;
        if (u.pn < t1) { base = o0; ld = ld0; ct = u.pn; } else if (u.pn < t2) { base = o1; ld = ld1; ct = u.pn - t1; gate = (gz != nullptr); } else { base = o2; ld = ld2; ct = u.pn - t2; }
        const int row0 = u.pm * BM + wr * 64 + fr, col0 = ct * BM + wc * 32 + 8 * fq;
        if (u.pn >= t3) {
#pragma unroll
            for (int ai = 0; ai < 2; ++ai)
#pragma unroll
                for (int m = 0; m < 4; ++m) { const f32x4 v0 = acc[ai][0][m][0] * acc[ai][1][m][0], v1 = acc[ai][0][m][1] * acc[ai][1][m][1];
                    u32x4 w; w.x = pk2(v0[0], v0[1]); w.y = pk2(v0[2], v0[3]); w.z = pk2(v1[0], v1[1]); w.w = pk2(v1[2], v1[3]);
                    *(u32x4*)(o2 + (size_t)(row0 + ai * HALF + m * 16) * ld2 + 512 + (u.pn - t3) * HALF + wc * 32 + 8 * fq) = w; }
            return;
        }
        if (gate) {
            const f32x4 g0 = *(const f32x4*)(gz + (col0 & 127)), g1 = *(const f32x4*)(gz + (col0 & 127) + 4);
#pragma unroll
            for (int ai = 0; ai < 2; ++ai)
#pragma unroll
                for (int m = 0; m < 4; ++m)
#pragma unroll
                    for (int bj = 0; bj < 2; ++bj) { f32x4 v0 = acc[ai][bj][m][0], v1 = acc[ai][bj][m][1];
#pragma unroll
                        for (int j = 0; j < 4; ++j) { v0[j] = silu(v0[j]) * g0[j]; v1[j] = silu(v1[j]) * g1[j]; }
                        acc[ai][bj][m][0] = v0; acc[ai][bj][m][1] = v1; }
        }
#pragma unroll
        for (int ai = 0; ai < 2; ++ai)
#pragma unroll
            for (int m = 0; m < 4; ++m) { bf16_t* rowp = base + (size_t)(row0 + ai * HALF + m * 16) * ld + col0;
#pragma unroll
                for (int bj = 0; bj < 2; ++bj) { const f32x4 v0 = acc[ai][bj][m][0], v1 = acc[ai][bj][m][1];
                    u32x4 w; w.x = pk2(v0[0], v0[1]); w.y = pk2(v0[2], v0[3]); w.z = pk2(v1[0], v1[1]); w.w = pk2(v1[2], v1[3]);
                    *(u32x4*)(rowp + bj * HALF) = w; } }
    }
};
struct EpiBf16At {
    static constexpr bool PERM = true;
    bf16_t* o; int ld; size_t pm_stride, pn_stride;
    FK_DI void operator()(Acc& acc, const Unit& u, int wr, int wc, int fr, int fq, FK_LAS unsigned char*) const {
        bf16_t* base = o + (size_t)u.pm * pm_stride + (size_t)u.pn * pn_stride;
        const int row0 = wr * 64 + fr, col0 = wc * 32 + 8 * fq;
#pragma unroll
        for (int ai = 0; ai < 2; ++ai)
#pragma unroll
            for (int m = 0; m < 4; ++m) { bf16_t* rowp = base + (size_t)(row0 + ai * HALF + m * 16) * ld + col0;
#pragma unroll
                for (int bj = 0; bj < 2; ++bj) { const f32x4 v0 = acc[ai][bj][m][0], v1 = acc[ai][bj][m][1];
                    u32x4 w; w.x = pk2(v0[0], v0[1]); w.y = pk2(v0[2], v0[3]); w.z = pk2(v1[0], v1[1]); w.w = pk2(v1[2], v1[3]);
                    *(u32x4*)(rowp + bj * HALF) = w; } }
    }
};
struct EpiResid {
    static constexpr bool PERM = false;
    const float* base; float* hout; bf16_t* hb; float* ss;
    FK_DI void operator()(Acc& acc, const Unit& u, int wr, int wc, int fr, int fq, FK_LAS unsigned char*) const {
        const int row0 = u.pm * BM + wr * 64 + fr, col0 = u.pn * BM + wc * 32 + 4 * fq;
#pragma unroll
        for (int ai = 0; ai < 2; ++ai)
#pragma unroll
            for (int m = 0; m < 4; ++m) { const int row = row0 + ai * HALF + m * 16; const size_t off = (size_t)row * D + col0; float s = 0.f;
#pragma unroll
                for (int bj = 0; bj < 2; ++bj)
#pragma unroll
                    for (int n = 0; n < 2; ++n) { const f32x4 bs = *(const f32x4*)(base + off + bj * HALF + n * 16); const f32x4 o = bs + acc[ai][bj][m][n];
                        *(f32x4*)(hout + off + bj * HALF + n * 16) = o; s += (o[0] * o[0] + o[1] * o[1]) + (o[2] * o[2] + o[3] * o[3]);
                        if (hb) { u32x2 w; w.x = pk2(o[0], o[1]); w.y = pk2(o[2], o[3]); *(u32x2*)(hb + off + bj * HALF + n * 16) = w; } }
                s += __shfl_xor(s, 16); s += __shfl_xor(s, 32);
                if (fq == 0) __hip_atomic_fetch_add(ss + row, s, __ATOMIC_RELAXED, __HIP_MEMORY_SCOPE_AGENT);
                asm volatile("" ::: "memory"); }
    }
};

struct EpiResidB {
    static constexpr bool PERM = true;
    const float* xf; const bf16_t* hb_in; bf16_t* hb_out; float* ss;
    FK_DI void operator()(Acc& acc, const Unit& u, int wr, int wc, int fr, int fq, FK_LAS unsigned char*) const {
        const int row0 = u.pm * BM + wr * 64 + fr, col0 = u.pn * BM + wc * 32 + 8 * fq;
#pragma unroll
        for (int ai = 0; ai < 2; ++ai)
#pragma unroll
            for (int m = 0; m < 4; ++m) { const int row = row0 + ai * HALF + m * 16; const size_t off = (size_t)row * D + col0; float s = 0.f;
#pragma unroll
                for (int bj = 0; bj < 2; ++bj) { f32x4 b0, b1;
                    if (xf) { b0 = *(const f32x4*)(xf + off + bj * HALF); b1 = *(const f32x4*)(xf + off + bj * HALF + 4); }
                    else { const u32x4 hv = *(const u32x4*)(hb_in + off + bj * HALF); b0 = (f32x4){bf_lo(hv.x), bf_hi(hv.x), bf_lo(hv.y), bf_hi(hv.y)}; b1 = (f32x4){bf_lo(hv.z), bf_hi(hv.z), bf_lo(hv.w), bf_hi(hv.w)}; }
                    const f32x4 o0 = b0 + acc[ai][bj][m][0], o1 = b1 + acc[ai][bj][m][1];
                    s += ((o0[0] * o0[0] + o0[1] * o0[1]) + (o0[2] * o0[2] + o0[3] * o0[3])) + ((o1[0] * o1[0] + o1[1] * o1[1]) + (o1[2] * o1[2] + o1[3] * o1[3]));
                    u32x4 w; w.x = pk2(o0[0], o0[1]); w.y = pk2(o0[2], o0[3]); w.z = pk2(o1[0], o1[1]); w.w = pk2(o1[2], o1[3]);
                    *(u32x4*)(hb_out + off + bj * HALF) = w; }
                s += __shfl_xor(s, 16); s += __shfl_xor(s, 32);
                if (fq == 0) __hip_atomic_fetch_add(ss + row, s, __ATOMIC_RELAXED, __HIP_MEMORY_SCOPE_AGENT);
                asm volatile("" ::: "memory"); }
    }
};

struct EpiFinal {
    static constexpr bool PERM = true;
    const bf16_t* hb_in; float* out; float* ss; unsigned* cnt; const float* gfin;
    FK_DI void operator()(Acc& acc, const Unit& u, int wr, int wc, int fr, int fq, FK_LAS unsigned char*) const {
        const int row0 = u.pm * BM + wr * 64 + fr, col0 = u.pn * BM + wc * 32 + 8 * fq;
#pragma unroll
        for (int ai = 0; ai < 2; ++ai)
#pragma unroll
            for (int m = 0; m < 4; ++m) { const int row = row0 + ai * HALF + m * 16; const size_t off = (size_t)row * D + col0; float s = 0.f;
#pragma unroll
                for (int bj = 0; bj < 2; ++bj) { const u32x4 hv = *(const u32x4*)(hb_in + off + bj * HALF);
                    const f32x4 o0 = (f32x4){bf_lo(hv.x), bf_hi(hv.x), bf_lo(hv.y), bf_hi(hv.y)} + acc[ai][bj][m][0], o1 = (f32x4){bf_lo(hv.z), bf_hi(hv.z), bf_lo(hv.w), bf_hi(hv.w)} + acc[ai][bj][m][1];
                    acc[ai][bj][m][0] = o0; acc[ai][bj][m][1] = o1;
                    s += ((o0[0] * o0[0] + o0[1] * o0[1]) + (o0[2] * o0[2] + o0[3] * o0[3])) + ((o1[0] * o1[0] + o1[1] * o1[1]) + (o1[2] * o1[2] + o1[3] * o1[3])); }
                s += __shfl_xor(s, 16); s += __shfl_xor(s, 32);
                if (fq == 0) __hip_atomic_fetch_add(ss + row, s, __ATOMIC_RELAXED, __HIP_MEMORY_SCOPE_AGENT);
                asm volatile("" ::: "memory"); }
        asm volatile("s_waitcnt vmcnt(0)" ::: "memory"); __builtin_amdgcn_s_barrier(); asm volatile("" ::: "memory");
        if (threadIdx.x == 0) __hip_atomic_fetch_add(cnt + u.pm, 1u, __ATOMIC_RELAXED, __HIP_MEMORY_SCOPE_AGENT);
        { unsigned sp_ = 0; while ((unsigned)__builtin_amdgcn_readfirstlane(__hip_atomic_load(cnt + u.pm, __ATOMIC_RELAXED, __HIP_MEMORY_SCOPE_AGENT)) < 4u) { __builtin_amdgcn_s_sleep(2); if (++sp_ > (1u << 22)) break; } }
        float rsv[8];
#pragma unroll
        for (int q = 0; q < 8; ++q) rsv[q] = __uint_as_float(__hip_atomic_load((const unsigned*)ss + row0 + (q >> 2) * HALF + (q & 3) * 16, __ATOMIC_RELAXED, __HIP_MEMORY_SCOPE_AGENT));
        f32x4 gv[2][2];
#pragma unroll
        for (int bj = 0; bj < 2; ++bj) { gv[bj][0] = *(const f32x4*)(gfin + col0 + bj * HALF); gv[bj][1] = *(const f32x4*)(gfin + col0 + bj * HALF + 4); }
#pragma unroll
        for (int ai = 0; ai < 2; ++ai)
#pragma unroll
            for (int m = 0; m < 4; ++m) { const int row = row0 + ai * HALF + m * 16; const float rs = rsqrtf(rsv[ai * 4 + m] * (1.f / 1024.f) + EPS); float* op = out + (size_t)row * D + col0;
#pragma unroll
                for (int bj = 0; bj < 2; ++bj) { *(f32x4*)(op + bj * HALF) = acc[ai][bj][m][0] * rs * gv[bj][0]; *(f32x4*)(op + bj * HALF + 4) = acc[ai][bj][m][1] * rs * gv[bj][1]; } }
    }
};
FK_DI float row_rstd(const float* ss, int row) { return rsqrtf(ss[row] * (1.f / 1024.f) + EPS); }
struct EpiSoftmax {
    static constexpr bool PERM = true;
    const float* ss; bf16_t* P;
    FK_DI void operator()(Acc& acc, const Unit& u, int wr, int wc, int fr, int fq, FK_LAS unsigned char* lds) const {
        FK_LAS f32x2* X = (FK_LAS f32x2*)(lds + LDS_EXCH);
        const int row0 = u.pm * BM + wr * 64 + fr;
        float rsv[8];
#pragma unroll
        for (int q = 0; q < 8; ++q) rsv[q] = ss[row0 + (q >> 2) * HALF + (q & 3) * 16];
#pragma unroll
        for (int ai = 0; ai < 2; ++ai)
#pragma unroll
            for (int m = 0; m < 4; ++m) { const int rl = ai * HALF + wr * 64 + m * 16 + fr; const float rs = rsqrtf(rsv[ai * 4 + m] * (1.f / 1024.f) + EPS);
                float mx = -3.0e38f;
#pragma unroll
                for (int bj = 0; bj < 2; ++bj)
#pragma unroll
                    for (int n = 0; n < 2; ++n) { f32x4 v = acc[ai][bj][m][n] * rs; acc[ai][bj][m][n] = v; mx = fmaxf(fmaxf(mx, fmaxf(v[0], v[1])), fmaxf(v[2], v[3])); }
                mx = fmaxf(mx, __shfl_xor(mx, 16)); mx = fmaxf(mx, __shfl_xor(mx, 32));
                float sm = 0.f;
#pragma unroll
                for (int bj = 0; bj < 2; ++bj)
#pragma unroll
                    for (int n = 0; n < 2; ++n) { f32x4 v = acc[ai][bj][m][n];
#pragma unroll
                        for (int j = 0; j < 4; ++j) { v[j] = __expf(v[j] - mx); sm += v[j]; }
                        acc[ai][bj][m][n] = v; }
                sm += __shfl_xor(sm, 16); sm += __shfl_xor(sm, 32);
                if (fq == 0) X[rl * 4 + wc] = (f32x2){mx, sm};
            }
        asm volatile("s_waitcnt lgkmcnt(0)" ::: "memory"); __builtin_amdgcn_s_barrier(); asm volatile("" ::: "memory");
#pragma unroll
        for (int ai = 0; ai < 2; ++ai)
#pragma unroll
            for (int m = 0; m < 4; ++m) { const int rl = ai * HALF + wr * 64 + m * 16 + fr;
                const f32x2 x0 = X[rl * 4 + 0], x1 = X[rl * 4 + 1], x2 = X[rl * 4 + 2], x3 = X[rl * 4 + 3];
                const float Mx = fmaxf(fmaxf(x0.x, x1.x), fmaxf(x2.x, x3.x));
                const float tot = x0.y * __expf(x0.x - Mx) + x1.y * __expf(x1.x - Mx) + x2.y * __expf(x2.x - Mx) + x3.y * __expf(x3.x - Mx);
                const float mine = wc == 0 ? x0.x : (wc == 1 ? x1.x : (wc == 2 ? x2.x : x3.x));
                const float sc = __expf(mine - Mx) * __builtin_amdgcn_rcpf(tot);
                bf16_t* rowp = P + (size_t)(row0 + ai * HALF + m * 16) * D + u.pn * BM + wc * 32 + 8 * fq;
#pragma unroll
                for (int bj = 0; bj < 2; ++bj) { const f32x4 v0 = acc[ai][bj][m][0] * sc, v1 = acc[ai][bj][m][1] * sc;
                    u32x4 w; w.x = pk2(v0[0], v0[1]); w.y = pk2(v0[2], v0[3]); w.z = pk2(v1[0], v1[1]); w.w = pk2(v1[2], v1[3]);
                    *(u32x4*)(rowp + bj * HALF) = w; } }
        asm volatile("s_waitcnt lgkmcnt(0)" ::: "memory"); __builtin_amdgcn_s_barrier(); asm volatile("" ::: "memory");
    }
};
struct EpiGateUp {
    static constexpr bool PERM = true;
    const float* ss; bf16_t* act;
    FK_DI void operator()(Acc& acc, const Unit& u, int wr, int wc, int fr, int fq, FK_LAS unsigned char*) const {
        const int row0 = u.pm * BM + wr * 64 + fr, col0 = u.pn * HALF + wc * 32 + 8 * fq;
        float rsv[8];
#pragma unroll
        for (int q = 0; q < 8; ++q) rsv[q] = ss[row0 + (q >> 2) * HALF + (q & 3) * 16];
#pragma unroll
        for (int ai = 0; ai < 2; ++ai)
#pragma unroll
            for (int m = 0; m < 4; ++m) { const int row = row0 + ai * HALF + m * 16; const float rs = rsqrtf(rsv[ai * 4 + m] * (1.f / 1024.f) + EPS);
                u32x4 w;
#pragma unroll
                for (int n = 0; n < 2; ++n) { const f32x4 g = acc[ai][0][m][n] * rs, up = acc[ai][1][m][n] * rs;
                    w[2 * n] = pk2(silu(g[0]) * up[0], silu(g[1]) * up[1]); w[2 * n + 1] = pk2(silu(g[2]) * up[2], silu(g[3]) * up[3]); }
                *(u32x4*)(act + (size_t)row * DFF + col0) = w; }
    }
};
}
namespace fk {
template <class Src>
FK_DI void transpose_item(const Src& src, int ldw, int K, bf16_t* WT, const float* gk, FK_LAS float* scr, int kb, int nb, int lane) {
    const int k0 = 64 * kb, n0 = 32 * nb;
    const float* colp = src(n0 + (lane & 31));
    float vv[32];
#pragma unroll
    for (int i = 0; i < 32; ++i) { const int kk = 2 * i + (lane >> 5); vv[i] = __builtin_nontemporal_load(colp + (size_t)(k0 + kk) * ldw); }
#pragma unroll
    for (int i = 0; i < 32; ++i) { const int kk = 2 * i + (lane >> 5); float v = vv[i]; if (gk) v *= gk[k0 + kk]; scr[kk * 33 + (lane & 31)] = v; }
    asm volatile("s_waitcnt lgkmcnt(0)" ::: "memory");
    const int c = lane & 7;
#pragma unroll
    for (int j = 0; j < 4; ++j) { const int n = (lane >> 3) + 8 * j; const FK_LAS float* s = scr + (8 * c) * 33 + n;
        u32x4 o; o.x = pk2(s[0 * 33], s[1 * 33]); o.y = pk2(s[2 * 33], s[3 * 33]); o.z = pk2(s[4 * 33], s[5 * 33]); o.w = pk2(s[6 * 33], s[7 * 33]);
        *(u32x4*)(WT + (size_t)(n0 + n) * K + k0 + 8 * c) = o; }
    asm volatile("s_waitcnt lgkmcnt(0)" ::: "memory");
}

FK_DI void late_weights(PP p, FK_LAS unsigned char* lds, int gw, int NGW, int wave, int lane) {
    unsigned char* ws = p->ws;
    FK_LAS float* scr = (FK_LAS float*)(lds + wave * 16384);
    const float* w_out = p->in[10]; const float* w_xq = p->in[13]; const float* w_xo = p->in[16]; const float* w_gate = p->in[18]; const float* w_up = p->in[19]; const float* w_down = p->in[20];
    const float* g_x = p->in[11]; const float* g_ffn = p->in[17];
    constexpr int I_SQ = (D / 64) * (D / 32), I_GU = (D / 64) * (2 * DFF / 32), I_DN = (DFF / 64) * (D / 32);
    constexpr int NITEMS = 2 * I_SQ + I_GU + I_DN;
    for (int it = gw; it < NITEMS; it += NGW) {
        int r = it;
        if (r < I_SQ) { auto src = [&](int n) { return w_out + n; }; transpose_item(src, D, D, (bf16_t*)(ws + WS_WOUT_T), (const float*)nullptr, scr, r / 32, r % 32, lane); continue; } r -= I_SQ;
        if (r < I_SQ) { auto src = [&](int n) { return w_xo + n; }; transpose_item(src, D, D, (bf16_t*)(ws + WS_WXO_T), (const float*)nullptr, scr, r / 32, r % 32, lane); continue; } r -= I_SQ;
        if (r < I_GU) { auto src = [&](int n) { const int blk = n >> 8, w = n & 255; return (w < 128 ? w_gate + blk * 128 + w : w_up + blk * 128 + (w - 128)); };
            transpose_item(src, DFF, D, (bf16_t*)(ws + WS_WGU_T), g_ffn, scr, r / (2 * DFF / 32), r % (2 * DFF / 32), lane); continue; } r -= I_GU;
        { auto src = [&](int n) { return w_down + n; }; transpose_item(src, D, DFF, (bf16_t*)(ws + WS_WDN_T), (const float*)nullptr, scr, r / 32, r % 32, lane); }
    }
    for (int k = gw; k < D; k += NGW) { const float sc = g_x[k] * 0.0625f; const f32x4* s = (const f32x4*)(w_xq + (size_t)k * D) + lane; u32x2* o = (u32x2*)((bf16_t*)(ws + WS_WXQ_G) + (size_t)k * D) + lane;
#pragma unroll
        for (int j = 0; j < 4; ++j) { const f32x4 v = s[64 * j] * sc; u32x2 w; w.x = pk2(v[0], v[1]); w.y = pk2(v[2], v[3]); o[64 * j] = w; } }
}

FK_DI void p0_prologue(PP p, FK_LAS unsigned char* lds, int gw, int NGW, int wave, int lane) {
    unsigned char* ws = p->ws;
    FK_LAS float* scr = (FK_LAS float*)(lds + wave * 16384);
    const float* w_in = p->in[3]; const float* w_xk = p->in[14]; const float* w_xv = p->in[15];
    const float* g_mix = p->in[2]; const float* g_mem = p->in[12];
    constexpr int I_IN = (D / 64) * (N1 / 32), I_SQ = (D / 64) * (D / 32);
    constexpr int NITEMS = I_IN + 2 * I_SQ;
    for (int it = gw; it < NITEMS; it += NGW) {
        int r = it;
        if (r < I_IN) { auto src = [&](int n) { if (n < 2048) return w_in + n; if (n < 2560) return w_in + n + 8; const int t = (n - 2560) >> 8, w = (n - 2560) & 255; return w_in + (w < 128 ? 2568 + 128 * t + w : 3080 + 128 * t + (w - 128)); };   transpose_item(src, INC, D, (bf16_t*)(ws + WS_WIN_T), (const float*)nullptr, scr, r / (N1 / 32), r % (N1 / 32), lane); continue; } r -= I_IN;
        if (r < I_SQ) { auto src = [&](int n) { return w_xk + n; }; transpose_item(src, D, D, (bf16_t*)(ws + WS_WXK_T), (const float*)nullptr, scr, r / 32, r % 32, lane); continue; } r -= I_SQ;
        { auto src = [&](int n) { return w_xv + n; }; transpose_item(src, D, D, (bf16_t*)(ws + WS_WXV_T), (const float*)nullptr, scr, r / 32, r % 32, lane); }
    }
    for (int i = gw * 64 + lane; i < M; i += NGW * 64) { ((float*)(ws + WS_SS1))[i] = 0.f; ((float*)(ws + WS_SS2))[i] = 0.f; ((float*)(ws + WS_SS3))[i] = 0.f; }
    for (int m = gw; m < NB * 256; m += NGW) { const f32x4* xr = (const f32x4*)(p->in[1] + (size_t)m * D) + lane; f32x4 v[4]; float s = 0.f;
#pragma unroll
        for (int j = 0; j < 4; ++j) { v[j] = xr[64 * j]; s += (v[j][0] * v[j][0] + v[j][1] * v[j][1]) + (v[j][2] * v[j][2] + v[j][3] * v[j][3]); }
        const float rs = rsqrtf(wave_sum(s) * (1.f / D) + EPS); u32x2* o = (u32x2*)((bf16_t*)(ws + WS_MEMN) + (size_t)m * D) + lane;
#pragma unroll
        for (int j = 0; j < 4; ++j) { const f32x4 g = ((const f32x4*)g_mem)[lane + 64 * j]; const f32x4 y = v[j] * rs * g; u32x2 w; w.x = pk2(y[0], y[1]); w.y = pk2(y[2], y[3]); o[64 * j] = w; } }
    {
        f32x4 gm[4]; f32x4 wab[4][4][2];
#pragma unroll
        for (int j = 0; j < 4; ++j) { gm[j] = ((const f32x4*)g_mix)[lane + 64 * j];
#pragma unroll
            for (int e = 0; e < 4; ++e) { const int k = 4 * lane + 256 * j + e; const f32x4* wp = (const f32x4*)(w_in + (size_t)k * INC + 2048); wab[j][e][0] = wp[0] * gm[j][e]; wab[j][e][1] = wp[1] * gm[j][e]; } }
        const float* a_log = p->in[5]; const float* dt_bias = p->in[6];
        bf16_t* XN = (bf16_t*)((unsigned char*)p->out + DO_XN); float* GB = (float*)(ws + WS_GB);
        f32x4 vn[4];
        { const f32x4* xr = (const f32x4*)(p->in[0] + (size_t)gw * D) + lane;
#pragma unroll
          for (int j = 0; j < 4; ++j) vn[j] = __builtin_nontemporal_load(xr + 64 * j); }
        for (int m = gw; m < M; m += NGW) { f32x4 v[4]; float s = 0.f;
#pragma unroll
            for (int j = 0; j < 4; ++j) { v[j] = vn[j]; s += (v[j][0] * v[j][0] + v[j][1] * v[j][1]) + (v[j][2] * v[j][2] + v[j][3] * v[j][3]); }
            if (m + NGW < M) { const f32x4* xr = (const f32x4*)(p->in[0] + (size_t)(m + NGW) * D) + lane;
#pragma unroll
                for (int j = 0; j < 4; ++j) vn[j] = __builtin_nontemporal_load(xr + 64 * j); }
            const float rs = rsqrtf(wave_sum(s) * (1.f / D) + EPS);
            f32x4 d0 = {0.f, 0.f, 0.f, 0.f}, d1 = {0.f, 0.f, 0.f, 0.f};
            u32x2* o = (u32x2*)(XN + (size_t)m * D) + lane;
#pragma unroll
            for (int j = 0; j < 4; ++j) { const f32x4 xs = v[j] * rs; const f32x4 y = xs * gm[j]; u32x2 w; w.x = pk2(y[0], y[1]); w.y = pk2(y[2], y[3]); o[64 * j] = w;
#pragma unroll
                for (int e = 0; e < 4; ++e) { d0 += wab[j][e][0] * xs[e]; d1 += wab[j][e][1] * xs[e]; } }
            float r8[8] = {d0[0], d0[1], d0[2], d0[3], d1[0], d1[1], d1[2], d1[3]};
#pragma unroll
            for (int q = 0; q < 8; ++q) r8[q] = wave_sum(r8[q]);
            float mine = r8[0];
#pragma unroll
            for (int q = 1; q < 8; ++q) mine = (lane == q) ? r8[q] : mine;
            if (lane < 4) { const float xx = mine + dt_bias[lane]; const float sp = xx > 20.f ? xx : log1pf(__expf(xx)); GB[(size_t)m * 8 + lane] = -__expf(a_log[lane]) * sp; }
            else if (lane < 8) { GB[(size_t)m * 8 + lane] = 1.f / (1.f + __expf(-mine)); }
        }
    }
}

FK_DI void p9_final(PP p, int gw, int NGW, int lane) {
    const float* ss = (const float*)(p->ws + WS_SS3); const f32x4* g = (const f32x4*)p->in[21]; const bf16_t* HB = (const bf16_t*)(p->ws + WS_HB);
    f32x4 gm[4];
#pragma unroll
    for (int j = 0; j < 2; ++j) { gm[2 * j] = g[2 * lane + 128 * j]; gm[2 * j + 1] = g[2 * lane + 128 * j + 1]; }
    for (int m0 = gw * 4; m0 < M; m0 += NGW * 4) {
        u32x4 hv[4][2]; float rs[4];
#pragma unroll
        for (int r = 0; r < 4; ++r) { const u32x4* hr = (const u32x4*)(HB + (size_t)(m0 + r) * D) + lane; hv[r][0] = hr[0]; hv[r][1] = hr[64]; rs[r] = row_rstd(ss, m0 + r); }
#pragma unroll
        for (int r = 0; r < 4; ++r) { f32x4* xr = (f32x4*)(p->out + (size_t)(m0 + r) * D) + 2 * lane;
#pragma unroll
            for (int j = 0; j < 2; ++j) { const u32x4 h = hv[r][j];
                xr[128 * j] = (f32x4){bf_lo(h.x), bf_hi(h.x), bf_lo(h.y), bf_hi(h.y)} * rs[r] * gm[2 * j];
                xr[128 * j + 1] = (f32x4){bf_lo(h.z), bf_hi(h.z), bf_lo(h.w), bf_hi(h.w)} * rs[r] * gm[2 * j + 1]; } }
    }
}
}
namespace fk {
#define FK_MFMA32(a, b, c) __builtin_amdgcn_mfma_f32_32x32x16_bf16((a), (b), (c), 0, 0, 0)
FK_DI int crow(int reg, int h) { return (reg & 3) + 8 * (reg >> 2) + 4 * h; }
FK_DI bf16x8 pack8(const f32x16& x, int s) {
    u32x4 p; p.x = pk2(x[8 * s], x[8 * s + 1]); p.y = pk2(x[8 * s + 2], x[8 * s + 3]); p.z = pk2(x[8 * s + 4], x[8 * s + 5]); p.w = pk2(x[8 * s + 6], x[8 * s + 7]);
    return __builtin_bit_cast(bf16x8, p);
}
FK_DI f32x16 zero16() { f32x16 z; for (int i = 0; i < 16; ++i) z[i] = 0.f; return z; }

constexpr int PL_QS = 0, PL_KS = 17408, PL_KT = 34816, PL_VT = 53248, PL_AF = 71680, PL_TP = 88064, PL_TPP = 97280, PL_TAB = 106496;
constexpr int QS_LD = 136, KT_LD = 72, TP_LD = 72;

FK_DI void st16_wt(__amdgpu_buffer_rsrc_t rs, unsigned off, u32x4 v) { __builtin_amdgcn_raw_buffer_store_b128(v, rs, off, 0, 16); }
FK_DI void p2_short_conv(PP p, int gw, int lane) {
    const bf16_t* SC = (const bf16_t*)(p->ws + WS_SC);
    const __amdgpu_buffer_rsrc_t mrs = __builtin_amdgcn_make_buffer_rsrc((void*)(p->ws + WS_MIX), 0, (int)((size_t)M * D * 2), 0x00020000);
    const float* csw = p->in[8]; const float* scg = p->in[9];
    float w0[8], w1[8], w2[8], g[8];
#pragma unroll
    for (int e = 0; e < 8; ++e) { w0[e] = csw[8 * lane + e]; w1[e] = csw[512 + 8 * lane + e]; w2[e] = csw[1024 + 8 * lane + e]; g[e] = scg[8 * lane + e]; }
    const int r0 = gw * 16;
    float p1[8], p2[8];
    auto prod = [&](int row, float* o) {
        const u32x4 c = *(const u32x4*)(SC + (size_t)row * 1024 + 512 + 8 * lane);
        #pragma unroll
        for (int q = 0; q < 4; ++q) { o[2 * q] = bf_lo(c[q]); o[2 * q + 1] = bf_hi(c[q]); }
    };
    const int t0 = r0 & (SEQ - 1);
    if (t0 >= 1) prod(r0 - 1, p1); else { for (int e = 0; e < 8; ++e) p1[e] = 0.f; }
    if (t0 >= 2) prod(r0 - 2, p2); else { for (int e = 0; e < 8; ++e) p2[e] = 0.f; }
    {
        u32x4 cv[16], bv[16];
#pragma unroll
        for (int r = 0; r < 16; ++r) { const size_t row = (size_t)(r0 + r); cv[r] = __builtin_nontemporal_load((const u32x4*)(SC + row * 1024 + 512 + 8 * lane)); bv[r] = __builtin_nontemporal_load((const u32x4*)(SC + row * 1024 + 8 * lane)); }
#pragma unroll
        for (int r = 0; r < 16; ++r) { const size_t row = (size_t)(r0 + r); float p0[8];
#pragma unroll
            for (int q = 0; q < 4; ++q) { p0[2 * q] = bf_lo(cv[r][q]); p0[2 * q + 1] = bf_hi(cv[r][q]); }
            const u32x4 b = bv[r]; float y[8]; float s = 0.f;
#pragma unroll
            for (int e = 0; e < 8; ++e) { const float bb = (e & 1) ? bf_hi(b[e >> 1]) : bf_lo(b[e >> 1]); y[e] = bb * (w0[e] * p2[e] + w1[e] * p1[e] + w2[e] * p0[e]); s += y[e] * y[e]; }
            s = sum8(s);
            const float rs = rsqrtf(s * (1.f / 64.f) + EPS);
            u32x4 o; o.x = pk2(y[0] * rs * g[0], y[1] * rs * g[1]); o.y = pk2(y[2] * rs * g[2], y[3] * rs * g[3]); o.z = pk2(y[4] * rs * g[4], y[5] * rs * g[5]); o.w = pk2(y[6] * rs * g[6], y[7] * rs * g[7]);
            st16_wt(mrs, (unsigned)((row * D + 512 + 8 * lane) * 2), o);
#pragma unroll
            for (int e = 0; e < 8; ++e) { p2[e] = p1[e]; p1[e] = p0[e]; } }
    }
}

constexpr int PL_CW = 107520;
struct P2Raw { u32x4 x[3][5]; float g, be; };
FK_DI void p2_load(PP p, int it, int tid, int lane, P2Raw& R) {
    const int n = it & 63, h = (it >> 6) & 3, b = it >> 8, cg = tid & 15, rg = tid >> 4;
    const bf16_t* QKV = (const bf16_t*)(p->ws + WS_QKV) + (size_t)(b * SEQ) * 1536 + h * 128 + cg * 8;
#pragma unroll
    for (int pt = 0; pt < 3; ++pt)
#pragma unroll
        for (int j = 0; j < 5; ++j) { const int tt = n * 64 + 2 * rg - 3 + j; R.x[pt][j] = (tt >= 0) ? *(const u32x4*)(QKV + (size_t)tt * 1536 + pt * 512) : (u32x4){0u, 0u, 0u, 0u}; }
    const float* GB = (const float*)(p->ws + WS_GB) + (size_t)(b * SEQ + n * 64 + lane) * 8 + h;
    R.g = GB[0]; R.be = GB[4];
}
#define P2_BAR() do { asm volatile("s_waitcnt lgkmcnt(0)" ::: "memory"); __builtin_amdgcn_s_barrier(); asm volatile("" ::: "memory"); } while (0)
FK_DI void p2_item(PP p, FK_LAS unsigned char* lds, int it, int it_next, int tid_in, int wave, int lane_in, P2Raw& R) {
    int tid = tid_in, lane = lane_in; asm volatile("" : "+v"(tid), "+v"(lane));
    unsigned char* item = p->ws + WS_CHUNK + (size_t)it * CH_BYTES;
    const __amdgpu_buffer_rsrc_t irs = __builtin_amdgcn_make_buffer_rsrc(item, 0, CH_BYTES, 0x00020000);
    const int hw = (it >> 6) & 3;
    FK_LAS float* TAB = (FK_LAS float*)(lds + PL_TAB);
    if (wave == 0) {
        float g = R.g; const float be = R.be;
#pragma unroll
        for (int o = 1; o < 64; o <<= 1) { const float t = __shfl_up(g, o); if (lane >= o) g += t; }
        const float gl = __shfl(g, 63);
        TAB[lane] = g; TAB[64 + lane] = __expf(g); TAB[128 + lane] = be; TAB[192 + lane] = __expf(gl - g);
        if (lane == 0) __hip_atomic_store((unsigned*)(p->ws + WS_GL) + it, __float_as_uint(__expf(gl)), __ATOMIC_RELAXED, __HIP_MEMORY_SCOPE_AGENT);
    }
    {
        const int cg = tid & 15, rg = tid >> 4;
#pragma unroll
        for (int pt = 0; pt < 3; ++pt) {
            float y0[8], y1[8];
#pragma unroll
            for (int e = 0; e < 8; ++e) { y0[e] = 0.f; y1[e] = 0.f; }
            float xf[8];
#pragma unroll
            for (int j = 0; j < 5; ++j) { const u32x4 x = R.x[pt][j];
#pragma unroll
                for (int q = 0; q < 4; ++q) { xf[2 * q] = bf_lo(x[q]); xf[2 * q + 1] = bf_hi(x[q]); }
                if (j < 4) { const FK_LAS f32x4* wp = (const FK_LAS f32x4*)(lds + PL_CW + hw * 6144 + ((pt * 4 + j) * 128 + cg * 8) * 4); const f32x4 wa = wp[0], wb = wp[1];
#pragma unroll
                    for (int e = 0; e < 4; ++e) { y0[e] += wa[e] * xf[e]; y0[4 + e] += wb[e] * xf[4 + e]; } }
                if (j >= 1) { const FK_LAS f32x4* wp = (const FK_LAS f32x4*)(lds + PL_CW + hw * 6144 + ((pt * 4 + j - 1) * 128 + cg * 8) * 4); const f32x4 wa = wp[0], wb = wp[1];
#pragma unroll
                    for (int e = 0; e < 4; ++e) { y1[e] += wa[e] * xf[e]; y1[4 + e] += wb[e] * xf[4 + e]; } }
            }
            float s0 = 0.f, s1 = 0.f;
#pragma unroll
            for (int e = 0; e < 8; ++e) { y0[e] = silu(y0[e]); y1[e] = silu(y1[e]); s0 += y0[e] * y0[e]; s1 += y1[e] * y1[e]; }
            if (pt < 2) { s0 = sum16(s0); s1 = sum16(s1);
                const float sc = (pt == 0 ? 0.08838834764831845f : 1.f), r0 = rsqrtf(s0 + EPS) * sc, r1 = rsqrtf(s1 + EPS) * sc;
#pragma unroll
                for (int e = 0; e < 8; ++e) { y0[e] *= r0; y1[e] *= r1; } }
            u32x4 o0, o1; o0.x = pk2(y0[0], y0[1]); o0.y = pk2(y0[2], y0[3]); o0.z = pk2(y0[4], y0[5]); o0.w = pk2(y0[6], y0[7]);
            o1.x = pk2(y1[0], y1[1]); o1.y = pk2(y1[2], y1[3]); o1.z = pk2(y1[4], y1[5]); o1.w = pk2(y1[6], y1[7]);
            if (pt <= 1) { FK_LAS unsigned char* dst = lds + (pt == 0 ? PL_QS : PL_KS) + ((2 * rg) * QS_LD + cg * 8) * 2; *(FK_LAS u32x4*)dst = o0; *(FK_LAS u32x4*)(dst + QS_LD * 2) = o1; }
            if (pt >= 1) { FK_LAS unsigned char* T = lds + (pt == 1 ? PL_KT : PL_VT) + ((cg * 8) * KT_LD + 2 * rg) * 2;
#pragma unroll
                for (int e = 0; e < 8; ++e) { const unsigned a0 = (e & 1) ? (o0[e >> 1] >> 16) : (o0[e >> 1] & 0xffffu), a1 = (e & 1) ? (o1[e >> 1] & 0xffff0000u) : (o1[e >> 1] << 16);
                    *(FK_LAS unsigned*)(T + e * KT_LD * 2) = a0 | a1; } }
        }
    }
    P2_BAR();
    if (it_next >= 0) p2_load(p, it_next, tid, lane, R);
    {
        const int r = lane & 31, hh = lane >> 5;
        if (wave < 4) {
            const int tj = wave >> 1, ti = wave & 1;
            f32x16 c = zero16();
            if (tj <= ti) {
#pragma unroll
                for (int s = 0; s < 8; ++s) { const bf16x8 a = *(const FK_LAS bf16x8*)(lds + PL_KS + ((32 * tj + r) * QS_LD + 16 * s + 8 * hh) * 2);
                    const bf16x8 bq = *(const FK_LAS bf16x8*)(lds + PL_QS + ((32 * ti + r) * QS_LD + 16 * s + 8 * hh) * 2); c = FK_MFMA32(a, bq, c); }
                const int i = 32 * ti + r; const float gci = TAB[i];
#pragma unroll
                for (int reg = 0; reg < 16; ++reg) { const int j = 32 * tj + crow(reg, hh); c[reg] = (i >= j) ? c[reg] * __expf(gci - TAB[j]) : 0.f; }
            }
#pragma unroll
            for (int s = 0; s < 2; ++s) st16_wt(irs, CH_ATF + (((ti * 4) + 2 * tj + s) * 64 + lane) * 16, __builtin_bit_cast(u32x4, pack8(c, s)));
        } else {
            const int ta = (wave - 4) >> 1, tb = (wave - 4) & 1;
            if (ta >= tb) {
                f32x16 c = zero16();
#pragma unroll
                for (int s = 0; s < 8; ++s) { const bf16x8 a = *(const FK_LAS bf16x8*)(lds + PL_KS + ((32 * ta + r) * QS_LD + 16 * s + 8 * hh) * 2);
                    const bf16x8 bk = *(const FK_LAS bf16x8*)(lds + PL_KS + ((32 * tb + r) * QS_LD + 16 * s + 8 * hh) * 2); c = FK_MFMA32(a, bk, c); }
                const int j = 32 * tb + r; const float gcj = TAB[j]; FK_LAS float* AF = (FK_LAS float*)(lds + PL_AF);
#pragma unroll
                for (int reg = 0; reg < 16; ++reg) { const int i = 32 * ta + crow(reg, hh); AF[i * 64 + j] = (i > j) ? TAB[128 + i] * c[reg] * __expf(TAB[i] - gcj) : 0.f; }
            }
        }
#pragma unroll
        for (int rep = 0; rep < 2; ++rep) { const int f = wave * 2 + rep;
            { const int mt = f >> 3, kk = f & 7; const int tok = 32 * mt + r; const float sc = TAB[64 + tok];
              const u32x2 lo = *(const FK_LAS u32x2*)(lds + PL_QS + (tok * QS_LD + 16 * kk + 4 * hh) * 2), hi = *(const FK_LAS u32x2*)(lds + PL_QS + (tok * QS_LD + 16 * kk + 8 + 4 * hh) * 2);
              u32x4 o; o.x = pk2(bf_lo(lo.x) * sc, bf_hi(lo.x) * sc); o.y = pk2(bf_lo(lo.y) * sc, bf_hi(lo.y) * sc); o.z = pk2(bf_lo(hi.x) * sc, bf_hi(hi.x) * sc); o.w = pk2(bf_lo(hi.y) * sc, bf_hi(hi.y) * sc);
              st16_wt(irs, CH_QDF + (f * 64 + lane) * 16, o); }
            { const int mt = f >> 2, ks = f & 3; const int dk = 32 * mt + r; const int tk = 16 * ks + 4 * hh;
              const u32x2 lo = *(const FK_LAS u32x2*)(lds + PL_KT + (dk * KT_LD + tk) * 2), hi = *(const FK_LAS u32x2*)(lds + PL_KT + (dk * KT_LD + tk + 8) * 2);
              const f32x4 f0 = *(const FK_LAS f32x4*)(TAB + 192 + tk), f1 = *(const FK_LAS f32x4*)(TAB + 192 + tk + 8);
              u32x4 o; o.x = pk2(bf_lo(lo.x) * f0[0], bf_hi(lo.x) * f0[1]); o.y = pk2(bf_lo(lo.y) * f0[2], bf_hi(lo.y) * f0[3]); o.z = pk2(bf_lo(hi.x) * f1[0], bf_hi(hi.x) * f1[1]); o.w = pk2(bf_lo(hi.y) * f1[2], bf_hi(hi.y) * f1[3]);
              st16_wt(irs, CH_KDF + (f * 64 + lane) * 16, o); }
        }
    }
    P2_BAR();
#ifndef NO_STEPD
    if (wave == 0) {
        const int c = lane & 31, hb = lane >> 5;
        const FK_LAS float* AF = (const FK_LAS float*)(lds + PL_AF) + (32 * hb) * 64 + 32 * hb;
        FK_LAS bf16_t* TP = (FK_LAS bf16_t*)(lds + PL_TP); FK_LAS bf16_t* TPP = (FK_LAS bf16_t*)(lds + PL_TPP);
        FK_LAS unsigned char* X1 = lds + PL_QS;
        asm volatile("" : "+v"(AF), "+v"(TP), "+v"(TPP), "+v"(X1));
        const int col = 32 * hb + c;
        const float bcol = TAB[128 + col], becol = bcol * TAB[64 + col];
        float t[32];
#pragma unroll
        for (int i = 0; i < 32; ++i) {
            float acc = (c == i) ? 1.f : 0.f;
#pragma unroll
            for (int j4 = 0; j4 < (i + 3) / 4; ++j4) { const f32x4 a = *(const FK_LAS f32x4*)(AF + i * 64 + 4 * j4);
#pragma unroll
                for (int e = 0; e < 4; ++e) if (4 * j4 + e < i) acc -= a[e] * t[4 * j4 + e]; }
            t[i] = acc;
            const unsigned pv = pk2(acc * becol, acc * bcol);
            TP[(32 * hb + i) * TP_LD + col] = (bf16_t)(pv & 0xffffu); TPP[(32 * hb + i) * TP_LD + col] = (bf16_t)(pv >> 16);
            if (hb == 0) { TP[i * TP_LD + 32 + c] = 0; TPP[i * TP_LD + 32 + c] = 0; }
            const unsigned tb = pk2(acc, acc);
            if (hb == 1) *(FK_LAS bf16_t*)(X1 + 2560 + i * 80 + c * 2) = (bf16_t)(tb & 0xffffu);
            if ((i & 1) == 1) asm volatile("" ::: "memory");
        }
        if (hb == 0) {
#pragma unroll
            for (int q = 0; q < 4; ++q) { u32x4 w; w.x = pk2(t[8 * q], t[8 * q + 1]); w.y = pk2(t[8 * q + 2], t[8 * q + 3]); w.z = pk2(t[8 * q + 4], t[8 * q + 5]); w.w = pk2(t[8 * q + 6], t[8 * q + 7]);
                *(FK_LAS u32x4*)(X1 + c * 80 + q * 16) = w; }
        }
        asm volatile("s_waitcnt lgkmcnt(0)" ::: "memory");
        f32x16 xacc = zero16();
        const FK_LAS float* A21 = (const FK_LAS float*)(lds + PL_AF) + (32 + c) * 64;
#pragma unroll
        for (int s2 = 0; s2 < 2; ++s2) { const f32x4 a0 = *(const FK_LAS f32x4*)(A21 + 16 * s2 + 8 * hb), a1 = *(const FK_LAS f32x4*)(A21 + 16 * s2 + 8 * hb + 4);
            u32x4 af; af.x = pk2(a0[0], a0[1]); af.y = pk2(a0[2], a0[3]); af.z = pk2(a1[0], a1[1]); af.w = pk2(a1[2], a1[3]);
            const bf16x8 bfrag = *(const FK_LAS bf16x8*)(X1 + c * 80 + (16 * s2 + 8 * hb) * 2);
            xacc = FK_MFMA32(__builtin_bit_cast(bf16x8, af), bfrag, xacc); }
        f32x16 yacc = zero16();
#pragma unroll
        for (int s2 = 0; s2 < 2; ++s2) { const u32x2 lo = *(const FK_LAS u32x2*)(X1 + 2560 + c * 80 + (16 * s2 + 4 * hb) * 2), hi = *(const FK_LAS u32x2*)(X1 + 2560 + c * 80 + (16 * s2 + 8 + 4 * hb) * 2);
            u32x4 af; af.x = lo.x; af.y = lo.y; af.z = hi.x; af.w = hi.y;
            yacc = FK_MFMA32(__builtin_bit_cast(bf16x8, af), pack8(xacc, s2), yacc); }
        const float bc0 = TAB[128 + c], bec0 = bc0 * TAB[64 + c];
#pragma unroll
        for (int reg = 0; reg < 16; ++reg) { const int i = 32 + crow(reg, hb); const unsigned pv = pk2(-yacc[reg] * bec0, -yacc[reg] * bc0);
            TP[i * TP_LD + c] = (bf16_t)(pv & 0xffffu); TPP[i * TP_LD + c] = (bf16_t)(pv >> 16); }
    }
#endif
    P2_BAR();
    {
        const int r = lane & 31, hh = lane >> 5;
        { const int mt = wave & 1, s4 = wave >> 1; f32x16 c = zero16();
#pragma unroll
          for (int s = 0; s < 4; ++s) { const bf16x8 a = *(const FK_LAS bf16x8*)(lds + PL_TPP + ((32 * mt + r) * TP_LD + 16 * s + 8 * hh) * 2);
              const bf16x8 bv = *(const FK_LAS bf16x8*)(lds + PL_VT + ((32 * s4 + r) * KT_LD + 16 * s + 8 * hh) * 2); c = FK_MFMA32(a, bv, c); }
          const unsigned dst = CH_UC + ((s4 * 64 + lane) * 2 + mt) * 32;
          st16_wt(irs, dst, __builtin_bit_cast(u32x4, pack8(c, 0))); st16_wt(irs, dst + 16, __builtin_bit_cast(u32x4, pack8(c, 1))); }
        { const int t = wave >> 1, mt = wave & 1; f32x16 c = zero16();
#pragma unroll
          for (int s = 0; s < 4; ++s) { const bf16x8 a = *(const FK_LAS bf16x8*)(lds + PL_KT + ((32 * t + r) * KT_LD + 16 * s + 8 * hh) * 2);
              const bf16x8 bt = *(const FK_LAS bf16x8*)(lds + PL_TP + ((32 * mt + r) * TP_LD + 16 * s + 8 * hh) * 2); c = FK_MFMA32(a, bt, c); }
#pragma unroll
          for (int s = 0; s < 2; ++s) st16_wt(irs, CH_WF + ((mt * 8 + 2 * t + s) * 64 + lane) * 16, __builtin_bit_cast(u32x4, pack8(c, s))); }
    }
    asm volatile("s_waitcnt vmcnt(0)" ::: "memory");
    P2_BAR();
    if (tid == 0) __hip_atomic_store((unsigned*)(p->ws + WS_FLAGS) + it, 1u, __ATOMIC_RELAXED, __HIP_MEMORY_SCOPE_AGENT);
}

#define SC_BAR() do { asm volatile("s_waitcnt lgkmcnt(0)" ::: "memory"); __builtin_amdgcn_s_barrier(); asm volatile("" ::: "memory"); } while (0)
constexpr int SC_STAGE = 57344, SC_OBUF = 2 * SC_STAGE, SC_OB_BYTES = 16384;

FK_DI void p3_scan(PP p, FK_LAS unsigned char* lds, int bh, int tid_in, int wave, int lane_in) {
    int lane = lane_in; asm volatile("" : "+v"(lane));
    const int b = bh >> 2, h = bh & 3;
    const unsigned char* items = p->ws + WS_CHUNK + (size_t)(bh * 64) * CH_BYTES;
    const float* GL = (const float*)(p->ws + WS_GL) + bh * 64;
    const int r = lane & 31, hh = lane >> 5;
    const __amdgpu_buffer_rsrc_t prs = __builtin_amdgcn_make_buffer_rsrc((void*)items, 0, 64 * CH_BYTES, 0x00020000);
    const unsigned* flags = (const unsigned*)(p->ws + WS_FLAGS) + bh * 64;
    if (wave < 4) {
        f32x16 S[4]; bf16x8 Sf[8];
#pragma unroll
        for (int t = 0; t < 4; ++t) S[t] = zero16();
#pragma unroll
        for (int k = 0; k < 8; ++k) Sf[k] = (bf16x8){0, 0, 0, 0, 0, 0, 0, 0};
        const unsigned ubase = CH_UC + wave * 4096 + lane * 64;
        u32x4 u0[4], u1[4];
        SC_BAR();
#define SC_ULD(ub, k) do { _Pragma("unroll") for (int i_ = 0; i_ < 4; ++i_) ub[i_] = __builtin_bit_cast(u32x4, __builtin_amdgcn_raw_buffer_load_b128(prs, ubase + (unsigned)(k) * CH_BYTES + i_ * 16, 0, 18)); } while (0)
        SC_ULD(u0, 0); SC_ULD(u1, 1);
        unsigned g0 = __hip_atomic_load((const unsigned*)GL, __ATOMIC_RELAXED, __HIP_MEMORY_SCOPE_AGENT), g1 = __hip_atomic_load((const unsigned*)GL + 1, __ATOMIC_RELAXED, __HIP_MEMORY_SCOPE_AGENT);
#define SC_STEP(n, ub, gv, RELOAD) do { \
            const FK_LAS unsigned char* st = lds + ((n) & 1) * SC_STAGE + lane * 16; \
            const float egl = __uint_as_float(gv); \
            f32x16 av[2]; \
            _Pragma("unroll") for (int mt = 0; mt < 2; ++mt) { av[mt] = zero16(); \
                _Pragma("unroll") for (int kk = 0; kk < 8; ++kk) { const bf16x8 wa = *(const FK_LAS bf16x8*)(st + CH_WF + (mt * 8 + kk) * 1024); av[mt] = FK_MFMA32(wa, Sf[kk], av[mt]); } } \
            bf16x8 Vf[4]; \
            _Pragma("unroll") for (int mt = 0; mt < 2; ++mt) { \
                _Pragma("unroll") for (int q = 0; q < 8; ++q) { const unsigned uw = ub[2 * mt + (q >> 2)][q & 3]; av[mt][2 * q] = bf_lo(uw) - av[mt][2 * q]; av[mt][2 * q + 1] = bf_hi(uw) - av[mt][2 * q + 1]; } \
                Vf[2 * mt] = pack8(av[mt], 0); Vf[2 * mt + 1] = pack8(av[mt], 1); } \
            if (RELOAD) { SC_ULD(ub, (n) + 2); gv = __hip_atomic_load((const unsigned*)GL + (n) + 2, __ATOMIC_RELAXED, __HIP_MEMORY_SCOPE_AGENT); } \
            f32x16 ao[2]; \
            _Pragma("unroll") for (int mt = 0; mt < 2; ++mt) { ao[mt] = zero16(); \
                _Pragma("unroll") for (int kk = 0; kk < 8; ++kk) { const bf16x8 qa = *(const FK_LAS bf16x8*)(st + CH_QDF + (mt * 8 + kk) * 1024); ao[mt] = FK_MFMA32(qa, Sf[kk], ao[mt]); } \
                _Pragma("unroll") for (int ks = 0; ks < 4; ++ks) { const bf16x8 aa = *(const FK_LAS bf16x8*)(st + CH_ATF + (mt * 4 + ks) * 1024); ao[mt] = FK_MFMA32(aa, Vf[ks], ao[mt]); } } \
            _Pragma("unroll") for (int t = 0; t < 4; ++t) { S[t] = S[t] * egl; \
                _Pragma("unroll") for (int ks = 0; ks < 4; ++ks) { const bf16x8 ka = *(const FK_LAS bf16x8*)(st + CH_KDF + (t * 4 + ks) * 1024); S[t] = FK_MFMA32(ka, Vf[ks], S[t]); } \
                Sf[2 * t] = pack8(S[t], 0); Sf[2 * t + 1] = pack8(S[t], 1); } \
            FK_LAS bf16_t* ob = (FK_LAS bf16_t*)(lds + SC_OBUF + ((n) & 1) * SC_OB_BYTES) + 32 * wave + r; \
            _Pragma("unroll") for (int mt = 0; mt < 2; ++mt) \
                _Pragma("unroll") for (int q = 0; q < 8; ++q) { const unsigned pv = pk2(ao[mt][2 * q], ao[mt][2 * q + 1]); \
                    ob[(32 * mt + crow(2 * q, hh)) * 128] = (bf16_t)(pv & 0xffffu); ob[(32 * mt + crow(2 * q + 1, hh)) * 128] = (bf16_t)(pv >> 16); } \
            SC_BAR(); } while (0)
        for (int n = 0; n < NCH - 8; n += 8) { SC_STEP(n, u0, g0, true); SC_STEP(n + 1, u1, g1, true); SC_STEP(n + 2, u0, g0, true); SC_STEP(n + 3, u1, g1, true); SC_STEP(n + 4, u0, g0, true); SC_STEP(n + 5, u1, g1, true); SC_STEP(n + 6, u0, g0, true); SC_STEP(n + 7, u1, g1, true); }
        SC_STEP(NCH - 8, u0, g0, true); SC_STEP(NCH - 7, u1, g1, true); SC_STEP(NCH - 6, u0, g0, true); SC_STEP(NCH - 5, u1, g1, true); SC_STEP(NCH - 4, u0, g0, true); SC_STEP(NCH - 3, u1, g1, true);
        SC_STEP(NCH - 2, u0, g0, false); SC_STEP(NCH - 1, u1, g1, false);
#undef SC_STEP
#undef SC_ULD
        SC_BAR();
    } else {
        const int e = wave - 4, l16 = lane & 15, rq = lane >> 4;
        const unsigned char* Zu = (const unsigned char*)p->out + DO_Z + ((size_t)b * SEQ * 512 + h * 128 + (size_t)(16 * e) * 512) * 2;
        unsigned char* Mu = p->ws + WS_MIX + ((size_t)b * SEQ * D + h * 128 + (size_t)(16 * e) * D) * 2;
        const __amdgpu_buffer_rsrc_t mxrs = __builtin_amdgcn_make_buffer_rsrc((void*)Mu, 0, SEQ * 2048, 0x00020000);
        unsigned* prog = (unsigned*)(p->ws + WS_PROG) + b;
        const unsigned zoff = (unsigned)(rq * 512 + 8 * l16) * 2u, moff = (unsigned)(rq * D + 8 * l16) * 2u, soff = (unsigned)lane * 16u;
        const unsigned src = (unsigned)(e * 14336) + (unsigned)lane * 16u;
        FK_LAS unsigned char* dstw = lds + e * 14336 + lane * 16;
        u32x4 sa[14], sb[14], sc[14]; u32x4 za[4], zb[4];
#define SC_POLL(k) do { unsigned sp_ = 0; while ((unsigned)__builtin_amdgcn_readfirstlane(__hip_atomic_load(flags + (k), __ATOMIC_RELAXED, __HIP_MEMORY_SCOPE_AGENT)) == 0u) { __builtin_amdgcn_s_sleep(2); if (++sp_ > (1u << 22)) break; } } while (0)
#define SC_LD(set, k) do { SC_POLL(k); _Pragma("unroll") for (int i = 0; i < 14; ++i) set[i] = __builtin_bit_cast(u32x4, __builtin_amdgcn_raw_buffer_load_b128(prs, src + (unsigned)(k) * CH_BYTES + i * 1024, 0, 18)); } while (0)
#define SC_WR(set, k) do { FK_LAS unsigned char* d_ = dstw + ((k) & 1) * SC_STAGE; _Pragma("unroll") for (int i = 0; i < 14; ++i) *(FK_LAS u32x4*)(d_ + i * 1024) = set[i]; } while (0)
#define SC_ZLD(zs, k) do { _Pragma("unroll") for (int q = 0; q < 4; ++q) zs[q] = __builtin_nontemporal_load((const u32x4*)(Zu + (size_t)((k) * 64 + 4 * q) * 1024 + zoff)); } while (0)
#define SC_GATE(zs, k) do { const FK_LAS unsigned char* ob = lds + SC_OBUF + ((k) & 1) * SC_OB_BYTES; \
            _Pragma("unroll") for (int q = 0; q < 4; ++q) { const int row = 16 * e + 4 * q + rq; const u32x4 ov = *(const FK_LAS u32x4*)(ob + row * 256 + l16 * 16); \
                float o[8] = {bf_lo(ov.x), bf_hi(ov.x), bf_lo(ov.y), bf_hi(ov.y), bf_lo(ov.z), bf_hi(ov.z), bf_lo(ov.w), bf_hi(ov.w)}; \
                float ss = 0.f; _Pragma("unroll") for (int j = 0; j < 8; ++j) ss += o[j] * o[j]; \
                ss = sum16(ss); \
                const float rs = rsqrtf(ss * (1.f / 128.f) + EPS); const u32x4 zv = zs[q]; \
                const float z[8] = {bf_lo(zv.x), bf_hi(zv.x), bf_lo(zv.y), bf_hi(zv.y), bf_lo(zv.z), bf_hi(zv.z), bf_lo(zv.w), bf_hi(zv.w)}; \
                u32x4 w; w.x = pk2(o[0] * rs * z[0], o[1] * rs * z[1]); w.y = pk2(o[2] * rs * z[2], o[3] * rs * z[3]); \
                w.z = pk2(o[4] * rs * z[4], o[5] * rs * z[5]); w.w = pk2(o[6] * rs * z[6], o[7] * rs * z[7]); \
                __builtin_amdgcn_raw_buffer_store_b128(w, mxrs, moff, (unsigned)((k) * 64 + 4 * q) * 2048u, 16); asm volatile("" ::: "memory"); } } while (0)
        SC_LD(sc, 0); SC_WR(sc, 0); SC_LD(sa, 1); SC_LD(sb, 2); SC_LD(sc, 3); SC_ZLD(za, 0);
        SC_BAR();
#define SC_PUB() do { asm volatile("s_waitcnt vmcnt(0)" ::: "memory"); if (lane == 0) __hip_atomic_fetch_add(prog, 1u, __ATOMIC_RELAXED, __HIP_MEMORY_SCOPE_AGENT); } while (0)
#define SC_LSTEP(n, set, zs, WR, LD, GT, ZL) do { \
            if ((n) == 29 || (n) == 57 || (n) == 61) SC_PUB();        \
            if (WR) SC_WR(set, (n) + 1); \
            if (LD) SC_LD(set, (n) + 4); \
            if (GT) SC_GATE(zs, (n) - 1); \
            if (ZL) SC_ZLD(zs, (n) + 1); \
            SC_BAR(); } while (0)
        SC_LSTEP(0, sa, zb, true, true, false, true); SC_LSTEP(1, sb, za, true, true, true, true); SC_LSTEP(2, sc, zb, true, true, true, true);
        for (int n = 3; n < NCH - 7; n += 6) {
            SC_LSTEP(n, sa, za, true, true, true, true); SC_LSTEP(n + 1, sb, zb, true, true, true, true); SC_LSTEP(n + 2, sc, za, true, true, true, true);
            SC_LSTEP(n + 3, sa, zb, true, true, true, true); SC_LSTEP(n + 4, sb, za, true, true, true, true); SC_LSTEP(n + 5, sc, zb, true, true, true, true); }
        SC_LSTEP(57, sa, za, true, true, true, true); SC_LSTEP(58, sb, zb, true, true, true, true); SC_LSTEP(59, sc, za, true, true, true, true);
        SC_LSTEP(60, sa, zb, true, false, true, true); SC_LSTEP(61, sb, za, true, false, true, true); SC_LSTEP(62, sc, zb, true, false, true, true);
        SC_LSTEP(63, sa, za, false, false, true, false);
        SC_LSTEP(64, sb, zb, false, false, true, false);
        SC_PUB();
#undef SC_PUB
#undef SC_LD
#undef SC_WR
#undef SC_ZLD
#undef SC_GATE
#undef SC_LSTEP
    }
}
}
namespace fk {
namespace cg = cooperative_groups;
#ifndef WGM_P1
#define WGM_P1 4
#endif
#ifndef WGM_P7
#define WGM_P7 4
#endif

struct ProbXW {
    const char* KB; const char* VB; const char* WXQ; const char* WXO; int lda, ldb, K; int G, c;
    FK_DI bool next(int i, Unit& u) const { const int L = i * G + c; if (L >= 256) return false; u.pm = L; u.pn = 0; return true; }
    FK_DI const char* aptr(const Unit& u) const { const int L = u.pm & 127, b = L >> 4, h = (L >> 2) & 3, q4 = L & 3;
        return (u.pm < 128) ? KB + ((size_t)(b * 256) * 1024 + h * 256) * 2 : WXO + ((size_t)(q4 * 256) * 1024 + h * 256) * 2; }
    FK_DI const char* bptr(const Unit& u) const { const int L = u.pm & 127, b = L >> 4, h = (L >> 2) & 3, q4 = L & 3;
        return (u.pm < 128) ? WXQ + ((size_t)(q4 * 256) * 1024 + h * 256) * 2 : VB + ((size_t)(b * 256) * 1024 + h * 256) * 2; }
};
struct EpiXW {
    static constexpr bool PERM = true;
    bf16_t* WQP; bf16_t* VWP;
    FK_DI void operator()(Acc& acc, const Unit& u, int wr, int wc, int fr, int fq, FK_LAS unsigned char*) const {
        const int L = u.pm & 127, b = L >> 4, h = (L >> 2) & 3, q4 = L & 3;
        bf16_t* base = (u.pm < 128) ? WQP + (size_t)b * 1048576 + (size_t)(h * 256) * 1024 + q4 * 256 : VWP + (size_t)b * 1048576 + (size_t)(q4 * 256) * 1024 + h * 256;
        const int row0 = wr * 64 + fr, col0 = wc * 32 + 8 * fq;
#pragma unroll
        for (int ai = 0; ai < 2; ++ai)
#pragma unroll
            for (int m = 0; m < 4; ++m) { bf16_t* rowp = base + (size_t)(row0 + ai * HALF + m * 16) * 1024 + col0;
#pragma unroll
                for (int bj = 0; bj < 2; ++bj) { const f32x4 v0 = acc[ai][bj][m][0], v1 = acc[ai][bj][m][1];
                    u32x4 w; w.x = pk2(v0[0], v0[1]); w.y = pk2(v0[2], v0[3]); w.z = pk2(v1[0], v1[1]); w.w = pk2(v1[2], v1[3]);
                    *(u32x4*)(rowp + bj * HALF) = w; } }
    }
};

struct ProbOne {
    const char* A; const char* Bt; int lda, ldb, K; int pm, pn;
    FK_DI bool next(int i, Unit& u) const { if (i) return false; u.pm = pm; u.pn = pn; return true; }
    FK_DI const char* aptr(const Unit& u) const { return A + (size_t)u.pm * 256 * lda * 2; }
    FK_DI const char* bptr(const Unit& u) const { return Bt + (size_t)u.pn * 256 * ldb * 2; }
};

__global__ void __launch_bounds__(512, 2) mega(Params p_arg) {
    PP p = (PP)__builtin_amdgcn_kernarg_segment_ptr();
    extern __shared__ __attribute__((aligned(16))) unsigned char lds_raw[];
    FK_LAS unsigned char* lds = (FK_LAS unsigned char*)lds_raw;
    cg::grid_group grid = cg::this_grid();
    int tid = threadIdx.x, lane = tid & 63; const int wave = __builtin_amdgcn_readfirstlane(tid >> 6);
    const int G = gridDim.x, bid = blockIdx.x, gw = bid * 8 + wave, NGW = G * 8;
#ifndef PHMASK
#define PHMASK 0x3ff
#endif
#define PH(k) (((PHMASK >> (k)) & 1) && p->dbg_lo <= (k) && (k) <= p->dbg_hi)
#ifndef REPMASK
#define REPMASK 0
#endif
#ifdef EXPK
#define TS0(k) if ((k) == EXPK && bid == 0 && tid == 0) *(volatile FK_LAS unsigned long long*)(lds + LDS_TOTAL) = __builtin_amdgcn_s_memrealtime();
#define TS1(k) if ((k) == EXPK && bid == 0 && tid == 0) *(volatile FK_LAS unsigned long long*)(lds + LDS_TOTAL + 8) = __builtin_amdgcn_s_memrealtime();
#else
#define TS0(k)
#define TS1(k)
#endif
#define REPS(k) asm volatile("" : "+s"(p)); unsigned char* ws = p->ws; for (int rep_ = 0; rep_ <= ((REPMASK >> (k)) & 1); ++rep_, ({ asm volatile("" : "+v"(tid), "+v"(lane)); }))
    constexpr bool AL = true, SP = true;
    volatile FK_LAS unsigned* xb_st = (volatile FK_LAS unsigned*)(lds + LDS_TOTAL + 16);
    if (tid < 2) xb_st[tid] = 0u;
    __syncthreads();
    XcdBarrier xb = xcd_barrier_post((unsigned*)(p->ws + WS_BAR), xb_st);
    if (p->dbg_lo == 0x7fffffff) grid.sync();
    { TS0(0) REPS(0) if (PH(0)) { p0_prologue(p, lds, gw, NGW, wave, lane); }
    }
    xcd_barrier(xb);
    TS1(0)
    { TS0(1) REPS(1) if (PH(1)) {
        { ProbStd S{(const char*)p->out + DO_XN, (const char*)(ws + WS_WIN_T), D, D, D, 0}; S.T.init(M / 256, N1 / 256, G, bid, WGM_P1);
          EpiBf16Split E{(bf16_t*)(ws + WS_QKV), (bf16_t*)((unsigned char*)p->out + DO_Z), (bf16_t*)(ws + WS_SC), 6, 8, 1536, 512, 1024, 10, p->in[7]};
          gemm_phase<EpiBf16Split, ProbStd, AL, SP>(lds, S, E); }
        if (bid < 64) { ProbStd S{(const char*)(ws + WS_MEMN), (const char*)(ws + WS_WXK_T), D, D, D, 0}; S.T.init(8, 8, G, bid);
          EpiBf16Split E{(bf16_t*)(ws + WS_KV), (bf16_t*)(ws + WS_KV) + (size_t)2048 * 1024, nullptr, 4, 8, 1024, 1024, 1024, 1 << 30, nullptr};
          gemm_phase<EpiBf16Split, ProbStd, AL, SP>(lds, S, E); }
        else late_weights(p, lds, (bid - 64) * 8 + wave, (G - 64) * 8, wave, lane);
    }
    }
    xcd_barrier(xb);
    TS1(1)
    { TS0(2) TS0(3) REPS(2) if (PH(2)) {
        if (bid < 32) p3_scan(p, lds, bid, tid, wave, lane);
        else if (G == 256) {
            { const float* cw = p->in[4];
              for (int i = tid; i < 4 * 3 * 4 * 128; i += 512) { const int hh_ = i / 1536, r_ = i % 1536, pt = r_ >> 9, k = (r_ >> 7) & 3, c = r_ & 127; ((FK_LAS float*)(lds + PL_CW))[i] = cw[k * 1536 + pt * 512 + hh_ * 128 + c]; } }
            const int w0 = bid - 32;
            auto item_of = [](int idx) { return (idx & 31) * 64 + (idx >> 5); };
            P2Raw R; p2_load(p, item_of(w0), tid, lane, R);
            __syncthreads();
            for (int idx = w0; idx < NITEM; idx += 224) { int it = item_of(idx); asm volatile("" : "+s"(it)); const int nx = idx + 224; p2_item(p, lds, it, nx < NITEM ? item_of(nx) : -1, tid, wave, lane, R); }
            for (int vw = w0 * 8 + wave; vw < 2048; vw += 224 * 8) p2_short_conv(p, vw, lane);
            asm volatile("s_waitcnt vmcnt(0)" ::: "memory");
            __syncthreads();
            if (tid == 0) __hip_atomic_fetch_add((unsigned*)(ws + WS_PROG) + 8, 1u, __ATOMIC_RELAXED, __HIP_MEMORY_SCOPE_AGENT);
        }
        if (G == 256) {
            const int x = bid & 7;
            for (int r = 0; r < 3; ++r) {
                int t, level;
                if (bid < 32) { if (r > 0) break; t = 60 + (bid >> 3); level = 4; }
                else { t = ((bid - 32) >> 3) + 28 * r; if (t >= 60) break; level = t < 28 ? 1 : (t < 56 ? 2 : 3); }
                if (tid == 0) { unsigned* pg = (unsigned*)(ws + WS_PROG); unsigned sp_ = 0;
                    while (__hip_atomic_load(pg + x, __ATOMIC_RELAXED, __HIP_MEMORY_SCOPE_AGENT) < 16u * (unsigned)level || __hip_atomic_load(pg + 8, __ATOMIC_RELAXED, __HIP_MEMORY_SCOPE_AGENT) < 224u) { __builtin_amdgcn_s_sleep(8); if (++sp_ > (1u << 21)) break; }
                    __builtin_amdgcn_fence(__ATOMIC_ACQUIRE, "agent"); asm volatile("s_waitcnt vmcnt(0)" ::: "memory"); }
                __syncthreads();
                ProbOne S{(const char*)(ws + WS_MIX), (const char*)(ws + WS_WOUT_T), D, D, D, x * 16 + (t >> 2), t & 3};
                EpiResidB E{p->in[0], nullptr, (bf16_t*)(ws + WS_HB), (float*)(ws + WS_SS1)};
                gemm_phase<EpiResidB, ProbOne, AL, SP>(lds, S, E);
            }
            if (bid >= 32) { const int j = (bid - 32) >> 3, wq = j >= 4 ? (j - 4) * 8 + x : 256;
              ProbXW S{(const char*)(ws + WS_KV), (const char*)(ws + WS_KV) + (size_t)2048 * 1024 * 2, (const char*)(ws + WS_WXQ_G), (const char*)(ws + WS_WXO_T), D, D, 256, 192, wq};
              EpiXW E{(bf16_t*)(ws + WS_WQP), (bf16_t*)(ws + WS_VWP)};
              gemm_phase<EpiXW, ProbXW, AL, SP>(lds, S, E); }
        }
    }
    }
    xcd_barrier(xb);
    TS1(2) TS1(3)
    { TS0(5) REPS(5) if (PH(5)) { ProbStd S{(const char*)(ws + WS_HB), (const char*)(ws + WS_WQP), D, D, D, (size_t)2 * 1048576}; S.T.init(M / 256, 4, G, bid);
        EpiSoftmax E{(const float*)(ws + WS_SS1), (bf16_t*)(ws + WS_P)};
        gemm_phase<EpiSoftmax, ProbStd, AL, SP>(lds, S, E); }
    }
    xcd_barrier(xb);
    TS1(5)
    { TS0(6) REPS(6) if (PH(6)) { ProbStd S{(const char*)(ws + WS_P), (const char*)(ws + WS_VWP), D, D, D, (size_t)2 * 1048576}; S.T.init(M / 256, 4, G, bid);
        EpiResidB E{nullptr, (const bf16_t*)(ws + WS_HB), (bf16_t*)(ws + WS_HB), (float*)(ws + WS_SS2)};
        gemm_phase<EpiResidB, ProbStd, AL, SP>(lds, S, E); }
    }
    xcd_barrier(xb);
    TS1(6)
    { TS0(7) REPS(7) if (PH(7)) { ProbStd S{(const char*)(ws + WS_HB), (const char*)(ws + WS_WGU_T), D, D, D, 0}; S.T.init(M / 256, 2 * DFF / 256, G, bid, WGM_P7);
        EpiGateUp E{(const float*)(ws + WS_SS2), (bf16_t*)(ws + WS_ACT)};
        gemm_phase<EpiGateUp, ProbStd, AL, SP>(lds, S, E); }
    }
    xcd_barrier(xb);
    TS1(7)
    { TS0(8) REPS(8) if (PH(8)) { ProbStd S{(const char*)(ws + WS_ACT), (const char*)(ws + WS_WDN_T), DFF, DFF, DFF, 0}; S.T.init(M / 256, 4, G, bid);
        EpiFinal E{(const bf16_t*)(ws + WS_HB), p->out, (float*)(ws + WS_SS3), (unsigned*)(ws + WS_PCNT), p->in[21]};
        gemm_phase<EpiFinal, ProbStd, AL, SP>(lds, S, E); }
    }
    TS1(8)
#ifdef EXPK
    if (EXPK == 9) { __syncthreads(); TS1(9) }
    if (bid == 0 && tid == 0) { const unsigned long long ts0_ = *(volatile FK_LAS unsigned long long*)(lds + LDS_TOTAL), ts1_ = *(volatile FK_LAS unsigned long long*)(lds + LDS_TOTAL + 8);
        const unsigned long long te = __builtin_amdgcn_s_memrealtime(), dt = (ts1_ - ts0_) * EXPMULT;
        while (__builtin_amdgcn_s_memrealtime() - te < dt) __builtin_amdgcn_s_sleep(32); }
#endif
#undef PH
}

static int launch_mega(void* const* d_in, void* d_out, void* d_ws, size_t ws_size, hipStream_t stream, int lo, int hi) {
    static int grid_blocks = 0;
    if (!grid_blocks) {
        int dev = 0, cus = 0, per_cu = 0;
        hipGetDevice(&dev); hipDeviceGetAttribute(&cus, hipDeviceAttributeMultiprocessorCount, dev);
        if (hipFuncSetAttribute((const void*)mega, hipFuncAttributeMaxDynamicSharedMemorySize, LDS_TOTAL + 64) != hipSuccess) { fprintf(stderr, "hipFuncSetAttribute failed\n"); grid_blocks = -1; return -1; }
        hipOccupancyMaxActiveBlocksPerMultiprocessor(&per_cu, (const void*)mega, 512, LDS_TOTAL + 64);
        if (per_cu < 1) { fprintf(stderr, "occupancy query says %d blocks/CU\n", per_cu); per_cu = 1; }
        grid_blocks = cus * 1;
        if (ws_size < WS_END) { fprintf(stderr, "ws too small: %zu < %zu\n", ws_size, (size_t)WS_END); grid_blocks = -1; return -1; }
    }
    if (grid_blocks < 0) return -1;
    if (hipMemsetAsync((char*)d_ws + WS_BAR, 0, (WS_FLAGS - WS_BAR) + NITEM * 4 + 512 + 64, stream) != hipSuccess) { fprintf(stderr, "memset of barrier words failed\n"); return -1; }
    Params p{}; for (int i = 0; i < 22; ++i) p.in[i] = (const float*)d_in[i];
    p.out = (float*)d_out; p.ws = (unsigned char*)d_ws; p.dbg_lo = lo; p.dbg_hi = hi;
    void* args[] = {&p};
    hipError_t e = hipLaunchCooperativeKernel((const void*)mega, dim3(grid_blocks), dim3(512), args, LDS_TOTAL + 64, stream);
    if (e != hipSuccess) { fprintf(stderr, "cooperative launch failed: %s (grid %d)\n", hipGetErrorString(e), grid_blocks); return -1; }
    return 0;
}
}
extern "C" void kernel_launch(void* const* d_in, const int* in_sizes, int n_in, void* d_out, int out_size, void* d_ws, size_t ws_size, hipStream_t stream) {
    fk::launch_mega(d_in, d_out, d_ws, ws_size, stream, 0, 99);
}
```

```cpp
#include <hip/hip_runtime.h>
#include <hip/hip_cooperative_groups.h>
#include <cstdio>
namespace fk {
#define FK_LAS __attribute__((address_space(3)))
#define FK_DI __device__ __forceinline__
typedef unsigned short bf16_t;
typedef short bf16x8 __attribute__((ext_vector_type(8)));
typedef float f32x2 __attribute__((ext_vector_type(2)));
typedef float f32x4 __attribute__((ext_vector_type(4)));
typedef float f32x16 __attribute__((ext_vector_type(16)));
typedef unsigned u32x2 __attribute__((ext_vector_type(2)));
typedef unsigned u32x4 __attribute__((ext_vector_type(4)));
typedef __bf16 bf16v2 __attribute__((ext_vector_type(2)));

constexpr int M = 32768, D = 1024, SEQ = 4096, NB = 8, DFF = 2816, N1 = 3584, INC = 3592, NCH = 64  , NITEM = NB * 4 * NCH;
constexpr float EPS = 1e-6f;

FK_DI unsigned pk2(float lo, float hi) { f32x2 v = {lo, hi}; bf16v2 r = __builtin_convertvector(v, bf16v2); return __builtin_bit_cast(unsigned, r); }
FK_DI float bf_lo(unsigned u) { return __uint_as_float(u << 16); }
FK_DI float bf_hi(unsigned u) { return __uint_as_float(u & 0xffff0000u); }
FK_DI float silu(float x) { return x * __builtin_amdgcn_rcpf(1.f + __expf(-x)); }
template <int CTRL> FK_DI float dpp_mov(float v) { return __builtin_bit_cast(float, __builtin_amdgcn_update_dpp(0, __builtin_bit_cast(int, v), CTRL, 0xF, 0xF, true)); }
FK_DI float sum8(float v) { v += dpp_mov<0xB1>(v); v += dpp_mov<0x4E>(v); v += dpp_mov<0x141>(v); return v; }
FK_DI float sum16(float v) { v = sum8(v); v += dpp_mov<0x140>(v); return v; }
FK_DI float wave_sum(float v) {
    v = sum16(v);
    const float r0 = __builtin_bit_cast(float, __builtin_amdgcn_readlane(__builtin_bit_cast(int, v), 0)), r1 = __builtin_bit_cast(float, __builtin_amdgcn_readlane(__builtin_bit_cast(int, v), 16));
    const float r2 = __builtin_bit_cast(float, __builtin_amdgcn_readlane(__builtin_bit_cast(int, v), 32)), r3 = __builtin_bit_cast(float, __builtin_amdgcn_readlane(__builtin_bit_cast(int, v), 48));
    return (r0 + r1) + (r2 + r3);
}

constexpr size_t MiB = 1u << 20;
constexpr size_t WS_WIN_T = 0;
constexpr size_t WS_WOUT_T = 7 * MiB;
constexpr size_t WS_WXQ_G = 9 * MiB;
constexpr size_t WS_WXK_T = 11 * MiB;
constexpr size_t WS_WXV_T = 13 * MiB;
constexpr size_t WS_WXO_T = 15 * MiB;
constexpr size_t WS_WGU_T = 17 * MiB;
constexpr size_t WS_WDN_T = 28 * MiB;
constexpr size_t WS_WQP = 34 * MiB;
constexpr size_t WS_VWP = 50 * MiB;
constexpr size_t WS_MEMN = 66 * MiB;
constexpr size_t WS_KV = 70 * MiB;
constexpr size_t WS_GB = 78 * MiB;
constexpr size_t WS_SS1 = 79 * MiB, WS_SS2 = 81 * MiB, WS_SS3 = 83 * MiB;
constexpr size_t WS_GL = 85 * MiB;
constexpr size_t WS_BAR = 85 * MiB + 65536;
constexpr size_t WS_FLAGS = 85 * MiB + 131072;
constexpr size_t WS_PCNT = WS_FLAGS + 8192;
constexpr size_t WS_PROG = WS_PCNT + 512;
constexpr size_t WS_QKV = 86 * MiB;
constexpr size_t WS_SC = 182 * MiB;
constexpr size_t WS_CHUNK = 278 * MiB;
constexpr size_t WS_MIX = 422 * MiB;
constexpr size_t WS_END = 486 * MiB;
constexpr size_t WS_ORAW = WS_QKV;
constexpr size_t WS_HB = WS_QKV;
constexpr size_t WS_P = WS_SC;
constexpr size_t WS_ACT = 246 * MiB;
constexpr size_t DO_XN = 0, DO_Z = 64 * MiB;
constexpr int CH_WF = 0, CH_KDF = 16384, CH_QDF = 32768, CH_ATF = 49152, CH_UC = 57344, CH_BYTES = 73728;

struct Params {
    const float* in[22];
    float* out; unsigned char* ws;
    int dbg_lo, dbg_hi;
};
typedef const __attribute__((address_space(4))) Params* PP;
}
namespace fk {
#define XB_TMO      128
#define XB_XCNT(j)  (256  + 64 * (j))
#define XB_XSUB(j)  (1280 + 64 * (j))
#define XB_XGEN(j)  (2304 + 64 * (j))
#define XB_TOP      3328
#define XB_TOPGEN   3392
#define XCD_BAR_WORDS 3456
#define XB_SPIN_CAP (1u << 18)

__device__ __forceinline__ unsigned xb_ld(unsigned* p)              { return __hip_atomic_load(p, __ATOMIC_RELAXED, __HIP_MEMORY_SCOPE_AGENT); }
__device__ __forceinline__ unsigned xb_add(unsigned* p, unsigned v) { return __hip_atomic_fetch_add(p, v, __ATOMIC_RELAXED, __HIP_MEMORY_SCOPE_AGENT); }
__device__ __forceinline__ unsigned xb_xcc_id() { return (unsigned)__builtin_amdgcn_s_getreg((3 << 11) | 20) & 0xFu; }
#define XB_SPIN(cond, bar) do { unsigned _sp = 0; while (cond) { __builtin_amdgcn_s_sleep(1); \
    if ((++_sp & 255u) == 0u) { if (xb_ld(&(bar)[XB_TMO])) break; if (_sp > XB_SPIN_CAP) { atomicAdd(&(bar)[XB_TMO], 1u); break; } } } } while (0)

struct XcdBarrier {
    unsigned* bar; unsigned x;
    volatile FK_LAS unsigned* st;
};

__device__ __forceinline__ XcdBarrier xcd_barrier_post(unsigned* bar, volatile FK_LAS unsigned* st) {
    XcdBarrier b; b.bar = bar; b.x = xb_xcc_id(); b.st = st;
    if (threadIdx.x == 0) (void)xb_add(&bar[XB_XCNT(b.x)], 1u);
    return b;
}
__device__ __forceinline__ void xcd_barrier_complete(unsigned* bar, unsigned x, unsigned& nloc, unsigned& nx) {
    const unsigned G = gridDim.x * gridDim.y * gridDim.z;
    unsigned sum, cnt, mine, sp = 0u;
    for (;;) {
        sum = 0u; cnt = 0u; mine = 0u;
#pragma unroll
        for (unsigned j = 0; j < 16; ++j) { const unsigned c = xb_ld(&bar[XB_XCNT(j)]); sum += c; cnt += (c > 0u) ? 1u : 0u; mine = (j == x) ? c : mine; }
        if (sum == G) break;
        __builtin_amdgcn_s_sleep(1);
        if ((++sp & 255u) == 0u) { if (xb_ld(&bar[XB_TMO])) break; if (sp > XB_SPIN_CAP) { atomicAdd(&bar[XB_TMO], 1u); break; } }
    }
    nloc = mine > 0u ? mine : 1u; nx = cnt > 0u ? cnt : 1u;
}

__device__ __forceinline__ void xcd_barrier(const XcdBarrier& b) {
    asm volatile("s_waitcnt vmcnt(0)" ::: "memory");
    __syncthreads();
    if (threadIdx.x == 0) {
        unsigned* bar = b.bar;
        __builtin_amdgcn_s_waitcnt(0);
        unsigned nloc = b.st[0], nx = b.st[1];
        if (nloc == 0u) { xcd_barrier_complete(bar, b.x, nloc, nx); b.st[0] = nloc; b.st[1] = nx; }
        const unsigned old = xb_add(&bar[XB_XSUB(b.x)], 1u);
        const unsigned gen = old / nloc;
        if (old + 1u == (gen + 1u) * nloc) {
            __builtin_amdgcn_fence(__ATOMIC_RELEASE, "agent");
            asm volatile("s_waitcnt vmcnt(0)" ::: "memory");
            const unsigned og = xb_add(&bar[XB_TOP], 1u);
            const unsigned tg = og / nx;
            if (og + 1u == (tg + 1u) * nx) xb_add(&bar[XB_TOPGEN], 1u);
            else XB_SPIN(xb_ld(&bar[XB_TOPGEN]) == tg, bar);
            __builtin_amdgcn_fence(__ATOMIC_ACQUIRE, "agent");
            xb_add(&bar[XB_XGEN(b.x)], 1u);
            asm volatile("s_waitcnt vmcnt(0)" ::: "memory");
        } else {
            XB_SPIN(xb_ld(&bar[XB_XGEN(b.x)]) == gen, bar);
            __builtin_amdgcn_fence(__ATOMIC_ACQUIRE, "agent");
            asm volatile("s_waitcnt vmcnt(0)" ::: "memory");
        }
    }
    __syncthreads();
}

}
namespace fk {
#ifndef GEMM_WGM
#define GEMM_WGM 4
#endif
constexpr int BM = 256, BK = 64, HALF = 128, HTB = HALF * BK * 2, STAGE_BYTES = 8 * HTB, NXCD = 8, WGM = GEMM_WGM;
constexpr int LDS_EXCH = STAGE_BYTES;
constexpr int LDS_TOTAL = STAGE_BYTES + 16384;

FK_DI int lds_byte(int r, int c) { const int st = (r >> 4) * 2 + (c >> 5), rr = r & 15, cc = c & 31, ob = rr * 64 + cc * 2; return st * 1024 + (ob ^ (((ob >> 9) & 1) << 5)); }
FK_DI void stage_rc(int b, int& R, int& C) { const int st = b / 1024, sb = b % 1024, swz = sb ^ (((sb >> 9) & 1) << 5); R = (st >> 1) * 16 + swz / 64; C = (st & 1) * 32 + (swz % 64) / 2; }
FK_DI int perm32(int rho) { const int n = rho >> 4, i = rho & 15; return 8 * (i >> 2) + 4 * n + (i & 3); }

struct Unit { int pm, pn; };

struct TileOrder {
    int nM, nN, nwg, G, c, wgm;
    FK_DI void init(int nM_, int nN_, int G_, int c_, int wgm_ = WGM) { nM = nM_; nN = nN_; nwg = nM * nN; G = G_; c = c_; wgm = wgm_; }
    FK_DI bool next(int i, Unit& u) const {
        const long L = (long)i * G + c; if (L >= nwg) return false;
        int wgid = (int)L; { const int q = nwg / NXCD, r = nwg % NXCD, xcd = wgid % NXCD, off = wgid / NXCD; wgid = (xcd < r ? xcd * (q + 1) : r * (q + 1) + (xcd - r) * q) + off; }
        const int nig = wgm * nN, gid = wgid / nig, fm = gid * wgm, gsz = (nM - fm) < wgm ? (nM - fm) : wgm;
        u.pm = fm + ((wgid % nig) % gsz); u.pn = (wgid % nig) / gsz; return true;
    }
};
struct ProbStd {
    static constexpr int AUXA = 0;
    const char* A; const char* Bt; int lda, ldb, K; size_t b_bstride; TileOrder T;
    FK_DI bool next(int i, Unit& u) const { return T.next(i, u); }
    FK_DI const char* aptr(const Unit& u) const { return A + (size_t)u.pm * 256 * lda * 2; }
    FK_DI const char* bptr(const Unit& u) const { return Bt + (size_t)u.pn * 256 * ldb * 2 + (size_t)(u.pm >> 4) * b_bstride; }
};

typedef f32x4 Acc[2][2][4][2];

template <class Epi, class Prob, bool ALIGN_EPI, bool SP2>
FK_DI void gemm_phase(FK_LAS unsigned char* lds, const Prob& S, const Epi& E) {
    int tid = threadIdx.x; asm volatile("" : "+v"(tid));
    const int wid = __builtin_amdgcn_readfirstlane(tid >> 6), lane = tid & 63, wr = wid >> 2, wc = wid & 3, fr = lane & 15, fq = lane >> 4;
    const int K = S.K, nt = K / BK, lda = S.lda, ldb = S.ldb;
    unsigned voffA[2], voffB[2];
#pragma unroll
    for (int i = 0; i < 2; ++i) { int R, C; stage_rc(tid * 16 + i * 8192, R, C); const int Rb = Epi::PERM ? ((R & ~31) + perm32(R & 31)) : R;
        voffA[i] = (unsigned)(R * lda + C) * 2u; voffB[i] = (unsigned)(Rb * ldb + C) * 2u; }
    const size_t kstep = (size_t)(BK * 2);
    const size_t hstepA = (size_t)HALF * lda * 2, hstepB = (size_t)HALF * ldb * 2;
    const unsigned ldsw = (unsigned)wid * 1024u;
    const int aoff = lds_byte(wr * 64 + fr, fq * 8), boff = lds_byte(wc * 32 + fr, fq * 8);
#define PG8_SA(b, h) (((b) * 2 + (h)) * HTB)
#define PG8_SB(b, h) ((4 + (b) * 2 + (h)) * HTB)
#define PG8_STAGE(bufoff, gbase, voff) do { _Pragma("unroll") for (int _i = 0; _i < 2; ++_i) \
        __builtin_amdgcn_global_load_lds((const unsigned*)((const char*)(gbase) + (voff)[_i]), (FK_LAS unsigned*)(lds + (bufoff) + ldsw + _i * 8192), 16, 0, 0); } while (0)
#define PG8_STAGEA(bufoff, gbase, voff) do { _Pragma("unroll") for (int _i = 0; _i < 2; ++_i) \
        __builtin_amdgcn_global_load_lds((const unsigned*)((const char*)(gbase) + (voff)[_i]), (FK_LAS unsigned*)(lds + (bufoff) + ldsw + _i * 8192), 16, 0, Prob::AUXA); } while (0)
#define PG8_LDA(dst, b, h) do { _Pragma("unroll") for (int m = 0; m < 4; ++m) _Pragma("unroll") for (int k = 0; k < 2; ++k) dst[m][k] = *(const FK_LAS bf16x8*)(lds + PG8_SA(b, h) + aoff + m * 2048 + k * 1024); } while (0)
#define PG8_LDB(dst, b, h) do { _Pragma("unroll") for (int n = 0; n < 2; ++n) _Pragma("unroll") for (int k = 0; k < 2; ++k) dst[n][k] = *(const FK_LAS bf16x8*)(lds + PG8_SB(b, h) + boff + n * 2048 + k * 1024); } while (0)
#define PG8_MMA(ai, bj, At, Bt) do { __builtin_amdgcn_s_setprio(1); _Pragma("unroll") for (int m = 0; m < 4; ++m) _Pragma("unroll") for (int n = 0; n < 2; ++n) _Pragma("unroll") for (int k = 0; k < 2; ++k) \
        acc[ai][bj][m][n] = __builtin_amdgcn_mfma_f32_16x16x32_bf16(Bt[n][k], At[m][k], acc[ai][bj][m][n], 0, 0, 0); __builtin_amdgcn_s_setprio(0); } while (0)
#define PG8_WAIT_V(n) asm volatile("s_waitcnt vmcnt(" #n ")" ::: "memory")
#define PG8_WAIT_L(n) asm volatile("s_waitcnt lgkmcnt(" #n ")" ::: "memory")
#define PG8_BAR __builtin_amdgcn_s_barrier()
#define PG8_SCHED __builtin_amdgcn_sched_barrier(0)
    Unit cur, nxt; int ui = 0;
    if (!S.next(0, cur)) return;
    Acc acc;
#pragma unroll
    for (int a = 0; a < 2; ++a)
#pragma unroll
        for (int b = 0; b < 2; ++b)
#pragma unroll
            for (int m = 0; m < 4; ++m)
#pragma unroll
                for (int n = 0; n < 2; ++n) acc[a][b][m][n] = (f32x4){0.f, 0.f, 0.f, 0.f};
    bf16x8 At[4][2], B0[2][2], B1[2][2];
    const char* cA = S.aptr(cur); const char* cB = S.bptr(cur);
    if constexpr (SP2) {
        PG8_STAGE(PG8_SB(0, 0), cB, voffB); PG8_STAGE(PG8_SB(0, 1), cB + hstepB, voffB); PG8_STAGEA(PG8_SA(0, 0), cA, voffA); PG8_STAGEA(PG8_SA(0, 1), cA + hstepA, voffA);
        if (wr == 1) PG8_BAR;
        PG8_WAIT_V(2); PG8_BAR;
        PG8_STAGE(PG8_SB(1, 0), cB + kstep, voffB); PG8_STAGEA(PG8_SA(1, 0), cA + kstep, voffA); PG8_STAGE(PG8_SB(1, 1), cB + hstepB + kstep, voffB);
        PG8_WAIT_V(6); PG8_BAR;
    } else {
        PG8_STAGE(PG8_SB(0, 0), cB, voffB); PG8_STAGEA(PG8_SA(0, 0), cA, voffA); PG8_STAGE(PG8_SB(0, 1), cB + hstepB, voffB); PG8_STAGEA(PG8_SA(0, 1), cA + hstepA, voffA);
        if (wr == 1) PG8_BAR;
        PG8_WAIT_V(4); PG8_BAR;
        PG8_STAGE(PG8_SB(1, 0), cB + kstep, voffB); PG8_STAGEA(PG8_SA(1, 0), cA + kstep, voffA); PG8_STAGE(PG8_SB(1, 1), cB + hstepB + kstep, voffB);
        PG8_WAIT_V(6); PG8_BAR;
    }
    for (;;) {
        const bool has_next = S.next(ui + 1, nxt);
        const char* nA = has_next ? S.aptr(nxt) : cA; const char* nB = has_next ? S.bptr(nxt) : cB;
        for (int t = 0; t < nt; t += 2) {
            const bool last = (t == nt - 2);
            const char* a1 = cA + (size_t)(t + 1) * kstep;
            const char* a2 = last ? nA : cA + (size_t)(t + 2) * kstep; const char* b2 = last ? nB : cB + (size_t)(t + 2) * kstep;
            const char* a3 = a2 + kstep; const char* b3 = b2 + kstep;
            if constexpr (SP2) {
            PG8_LDB(B0, 0, 0); PG8_LDB(B1, 0, 1); PG8_SCHED; PG8_LDA(At, 0, 0); PG8_STAGEA(PG8_SA(1, 1), a1 + hstepA, voffA);
            PG8_WAIT_V(8); PG8_WAIT_L(0); PG8_BAR; PG8_MMA(0, 0, At, B0); PG8_MMA(0, 1, At, B1); PG8_BAR; PG8_SCHED;
            PG8_LDA(At, 0, 1); PG8_STAGE(PG8_SB(0, 0), b2, voffB); PG8_STAGE(PG8_SB(0, 1), b2 + hstepB, voffB); PG8_STAGEA(PG8_SA(0, 0), a2, voffA);
            PG8_WAIT_V(8); PG8_WAIT_L(0); PG8_BAR; PG8_MMA(1, 0, At, B0); PG8_MMA(1, 1, At, B1); PG8_BAR; PG8_SCHED;
            PG8_LDB(B0, 1, 0); PG8_LDB(B1, 1, 1); PG8_SCHED; PG8_LDA(At, 1, 0); PG8_STAGEA(PG8_SA(0, 1), a2 + hstepA, voffA);
            PG8_WAIT_V(8); PG8_WAIT_L(0); PG8_BAR; PG8_MMA(0, 0, At, B0); PG8_MMA(0, 1, At, B1); PG8_BAR; PG8_SCHED;
            PG8_LDA(At, 1, 1); PG8_STAGE(PG8_SB(1, 0), b3, voffB); PG8_STAGE(PG8_SB(1, 1), b3 + hstepB, voffB); PG8_STAGEA(PG8_SA(1, 0), a3, voffA);
            PG8_WAIT_V(8); PG8_WAIT_L(0); PG8_BAR; PG8_MMA(1, 0, At, B0); PG8_MMA(1, 1, At, B1); PG8_BAR; PG8_SCHED;
            } else {
            PG8_LDB(B0, 0, 0); PG8_SCHED; PG8_LDA(At, 0, 0); PG8_STAGEA(PG8_SA(1, 1), a1 + hstepA, voffA);
            PG8_WAIT_L(8); PG8_BAR; PG8_WAIT_L(0); PG8_MMA(0, 0, At, B0); PG8_BAR; PG8_SCHED;
            PG8_LDB(B1, 0, 1); PG8_STAGE(PG8_SB(0, 0), b2, voffB);
            PG8_BAR; PG8_WAIT_L(0); PG8_MMA(0, 1, At, B1); PG8_BAR;
            PG8_LDA(At, 0, 1); PG8_STAGEA(PG8_SA(0, 0), a2, voffA);
            PG8_BAR; PG8_WAIT_L(0); PG8_MMA(1, 0, At, B0); PG8_BAR; PG8_SCHED;
            PG8_STAGE(PG8_SB(0, 1), b2 + hstepB, voffB);
            PG8_WAIT_V(6); PG8_BAR; PG8_MMA(1, 1, At, B1); PG8_BAR;
            PG8_LDB(B0, 1, 0); PG8_SCHED; PG8_LDA(At, 1, 0); PG8_STAGEA(PG8_SA(0, 1), a2 + hstepA, voffA);
            PG8_WAIT_L(8); PG8_BAR; PG8_WAIT_L(0); PG8_MMA(0, 0, At, B0); PG8_BAR; PG8_SCHED;
            PG8_LDB(B1, 1, 1); PG8_STAGE(PG8_SB(1, 0), b3, voffB);
            PG8_BAR; PG8_WAIT_L(0); PG8_MMA(0, 1, At, B1); PG8_BAR;
            PG8_LDA(At, 1, 1); PG8_STAGEA(PG8_SA(1, 0), a3, voffA);
            PG8_BAR; PG8_WAIT_L(0); PG8_MMA(1, 0, At, B0); PG8_BAR; PG8_SCHED;
            PG8_STAGE(PG8_SB(1, 1), b3 + hstepB, voffB);
            PG8_WAIT_V(6); PG8_BAR; PG8_MMA(1, 1, At, B1); PG8_BAR;
            }
        }
        if constexpr (ALIGN_EPI) { if (wr == 0) PG8_BAR; }
        E(acc, cur, wr, wc, fr, fq, lds);
        if (!has_next) break;
#pragma unroll
        for (int a = 0; a < 2; ++a)
#pragma unroll
            for (int b = 0; b < 2; ++b)
#pragma unroll
                for (int m = 0; m < 4; ++m)
#pragma unroll
                    for (int n = 0; n < 2; ++n) acc[a][b][m][n] = (f32x4){0.f, 0.f, 0.f, 0.f};
        cur = nxt; cA = nA; cB = nB; ++ui;
        if constexpr (ALIGN_EPI) { if (wr == 1) PG8_BAR; }
    }
    PG8_WAIT_V(0);
    if constexpr (!ALIGN_EPI) { if (wr == 0) PG8_BAR; }
    PG8_BAR;
#undef PG8_SA
#undef PG8_SB
#undef PG8_STAGE
#undef PG8_STAGEA
#undef PG8_LDA
#undef PG8_LDB
#undef PG8_MMA
#undef PG8_WAIT_V
#undef PG8_WAIT_L
#undef PG8_BAR
#undef PG8_SCHED
}

struct EpiBf16Split {
    static constexpr bool PERM = true;
    bf16_t* o0; bf16_t* o1; bf16_t* o2; int t1, t2;
    int ld0, ld1, ld2;
    int t3;
    const float* gz;
    FK_DI void operator()(Acc& acc, const Unit& u, int wr, int wc, int fr, int fq, FK_LAS unsigned char*) const {
        bf16_t* base; int ld, ct; bool gate = false;
        if (u.pn < t1) { base = o0; ld = ld0; ct = u.pn; } else if (u.pn < t2) { base = o1; ld = ld1; ct = u.pn - t1; gate = (gz != nullptr); } else { base = o2; ld = ld2; ct = u.pn - t2; }
        const int row0 = u.pm * BM + wr * 64 + fr, col0 = ct * BM + wc * 32 + 8 * fq;
        if (u.pn >= t3) {
#pragma unroll
            for (int ai = 0; ai < 2; ++ai)
#pragma unroll
                for (int m = 0; m < 4; ++m) { const f32x4 v0 = acc[ai][0][m][0] * acc[ai][1][m][0], v1 = acc[ai][0][m][1] * acc[ai][1][m][1];
                    u32x4 w; w.x = pk2(v0[0], v0[1]); w.y = pk2(v0[2], v0[3]); w.z = pk2(v1[0], v1[1]); w.w = pk2(v1[2], v1[3]);
                    *(u32x4*)(o2 + (size_t)(row0 + ai * HALF + m * 16) * ld2 + 512 + (u.pn - t3) * HALF + wc * 32 + 8 * fq) = w; }
            return;
        }
        if (gate) {
            const f32x4 g0 = *(const f32x4*)(gz + (col0 & 127)), g1 = *(const f32x4*)(gz + (col0 & 127) + 4);
#pragma unroll
            for (int ai = 0; ai < 2; ++ai)
#pragma unroll
                for (int m = 0; m < 4; ++m)
#pragma unroll
                    for (int bj = 0; bj < 2; ++bj) { f32x4 v0 = acc[ai][bj][m][0], v1 = acc[ai][bj][m][1];
#pragma unroll
                        for (int j = 0; j < 4; ++j) { v0[j] = silu(v0[j]) * g0[j]; v1[j] = silu(v1[j]) * g1[j]; }
                        acc[ai][bj][m][0] = v0; acc[ai][bj][m][1] = v1; }
        }
#pragma unroll
        for (int ai = 0; ai < 2; ++ai)
#pragma unroll
            for (int m = 0; m < 4; ++m) { bf16_t* rowp = base + (size_t)(row0 + ai * HALF + m * 16) * ld + col0;
#pragma unroll
                for (int bj = 0; bj < 2; ++bj) { const f32x4 v0 = acc[ai][bj][m][0], v1 = acc[ai][bj][m][1];
                    u32x4 w; w.x = pk2(v0[0], v0[1]); w.y = pk2(v0[2], v0[3]); w.z = pk2(v1[0], v1[1]); w.w = pk2(v1[2], v1[3]);
                    *(u32x4*)(rowp + bj * HALF) = w; } }
    }
};
struct EpiBf16At {
    static constexpr bool PERM = true;
    bf16_t* o; int ld; size_t pm_stride, pn_stride;
    FK_DI void operator()(Acc& acc, const Unit& u, int wr, int wc, int fr, int fq, FK_LAS unsigned char*) const {
        bf16_t* base = o + (size_t)u.pm * pm_stride + (size_t)u.pn * pn_stride;
        const int row0 = wr * 64 + fr, col0 = wc * 32 + 8 * fq;
#pragma unroll
        for (int ai = 0; ai < 2; ++ai)
#pragma unroll
            for (int m = 0; m < 4; ++m) { bf16_t* rowp = base + (size_t)(row0 + ai * HALF + m * 16) * ld + col0;
#pragma unroll
                for (int bj = 0; bj < 2; ++bj) { const f32x4 v0 = acc[ai][bj][m][0], v1 = acc[ai][bj][m][1];
                    u32x4 w; w.x = pk2(v0[0], v0[1]); w.y = pk2(v0[2], v0[3]); w.z = pk2(v1[0], v1[1]); w.w = pk2(v1[2], v1[3]);
                    *(u32x4*)(rowp + bj * HALF) = w; } }
    }
};
struct EpiResid {
    static constexpr bool PERM = false;
    const float* base; float* hout; bf16_t* hb; float* ss;
    FK_DI void operator()(Acc& acc, const Unit& u, int wr, int wc, int fr, int fq, FK_LAS unsigned char*) const {
        const int row0 = u.pm * BM + wr * 64 + fr, col0 = u.pn * BM + wc * 32 + 4 * fq;
#pragma unroll
        for (int ai = 0; ai < 2; ++ai)
#pragma unroll
            for (int m = 0; m < 4; ++m) { const int row = row0 + ai * HALF + m * 16; const size_t off = (size_t)row * D + col0; float s = 0.f;
#pragma unroll
                for (int bj = 0; bj < 2; ++bj)
#pragma unroll
                    for (int n = 0; n < 2; ++n) { const f32x4 bs = *(const f32x4*)(base + off + bj * HALF + n * 16); const f32x4 o = bs + acc[ai][bj][m][n];
                        *(f32x4*)(hout + off + bj * HALF + n * 16) = o; s += (o[0] * o[0] + o[1] * o[1]) + (o[2] * o[2] + o[3] * o[3]);
                        if (hb) { u32x2 w; w.x = pk2(o[0], o[1]); w.y = pk2(o[2], o[3]); *(u32x2*)(hb + off + bj * HALF + n * 16) = w; } }
                s += __shfl_xor(s, 16); s += __shfl_xor(s, 32);
                if (fq == 0) __hip_atomic_fetch_add(ss + row, s, __ATOMIC_RELAXED, __HIP_MEMORY_SCOPE_AGENT);
                asm volatile("" ::: "memory"); }
    }
};

struct EpiResidB {
    static constexpr bool PERM = true;
    const float* xf; const bf16_t* hb_in; bf16_t* hb_out; float* ss;
    FK_DI void operator()(Acc& acc, const Unit& u, int wr, int wc, int fr, int fq, FK_LAS unsigned char*) const {
        const int row0 = u.pm * BM + wr * 64 + fr, col0 = u.pn * BM + wc * 32 + 8 * fq;
#pragma unroll
        for (int ai = 0; ai < 2; ++ai)
#pragma unroll
            for (int m = 0; m < 4; ++m) { const int row = row0 + ai * HALF + m * 16; const size_t off = (size_t)row * D + col0; float s = 0.f;
#pragma unroll
                for (int bj = 0; bj < 2; ++bj) { f32x4 b0, b1;
                    if (xf) { b0 = *(const f32x4*)(xf + off + bj * HALF); b1 = *(const f32x4*)(xf + off + bj * HALF + 4); }
                    else { const u32x4 hv = *(const u32x4*)(hb_in + off + bj * HALF); b0 = (f32x4){bf_lo(hv.x), bf_hi(hv.x), bf_lo(hv.y), bf_hi(hv.y)}; b1 = (f32x4){bf_lo(hv.z), bf_hi(hv.z), bf_lo(hv.w), bf_hi(hv.w)}; }
                    const f32x4 o0 = b0 + acc[ai][bj][m][0], o1 = b1 + acc[ai][bj][m][1];
                    s += ((o0[0] * o0[0] + o0[1] * o0[1]) + (o0[2] * o0[2] + o0[3] * o0[3])) + ((o1[0] * o1[0] + o1[1] * o1[1]) + (o1[2] * o1[2] + o1[3] * o1[3]));
                    u32x4 w; w.x = pk2(o0[0], o0[1]); w.y = pk2(o0[2], o0[3]); w.z = pk2(o1[0], o1[1]); w.w = pk2(o1[2], o1[3]);
                    *(u32x4*)(hb_out + off + bj * HALF) = w; }
                s += __shfl_xor(s, 16); s += __shfl_xor(s, 32);
                if (fq == 0) __hip_atomic_fetch_add(ss + row, s, __ATOMIC_RELAXED, __HIP_MEMORY_SCOPE_AGENT);
                asm volatile("" ::: "memory"); }
    }
};

struct EpiFinal {
    static constexpr bool PERM = true;
    const bf16_t* hb_in; float* out; float* ss; unsigned* cnt; const float* gfin;
    FK_DI void operator()(Acc& acc, const Unit& u, int wr, int wc, int fr, int fq, FK_LAS unsigned char*) const {
        const int row0 = u.pm * BM + wr * 64 + fr, col0 = u.pn * BM + wc * 32 + 8 * fq;
#pragma unroll
        for (int ai = 0; ai < 2; ++ai)
#pragma unroll
            for (int m = 0; m < 4; ++m) { const int row = row0 + ai * HALF + m * 16; const size_t off = (size_t)row * D + col0; float s = 0.f;
#pragma unroll
                for (int bj = 0; bj < 2; ++bj) { const u32x4 hv = *(const u32x4*)(hb_in + off + bj * HALF);
                    const f32x4 o0 = (f32x4){bf_lo(hv.x), bf_hi(hv.x), bf_lo(hv.y), bf_hi(hv.y)} + acc[ai][bj][m][0], o1 = (f32x4){bf_lo(hv.z), bf_hi(hv.z), bf_lo(hv.w), bf_hi(hv.w)} + acc[ai][bj][m][1];
                    acc[ai][bj][m][0] = o0; acc[ai][bj][m][1] = o1;
                    s += ((o0[0] * o0[0] + o0[1] * o0[1]) + (o0[2] * o0[2] + o0[3] * o0[3])) + ((o1[0] * o1[0] + o1[1] * o1[1]) + (o1[2] * o1[2] + o1[3] * o1[3])); }
                s += __shfl_xor(s, 16); s += __shfl_xor(s, 32);
                if (fq == 0) __hip_atomic_fetch_add(ss + row, s, __ATOMIC_RELAXED, __HIP_MEMORY_SCOPE_AGENT);
                asm volatile("" ::: "memory"); }
        asm volatile("s_waitcnt vmcnt(0)" ::: "memory"); __builtin_amdgcn_s_barrier(); asm volatile("" ::: "memory");
        if (threadIdx.x == 0) __hip_atomic_fetch_add(cnt + u.pm, 1u, __ATOMIC_RELAXED, __HIP_MEMORY_SCOPE_AGENT);
        { unsigned sp_ = 0; while ((unsigned)__builtin_amdgcn_readfirstlane(__hip_atomic_load(cnt + u.pm, __ATOMIC_RELAXED, __HIP_MEMORY_SCOPE_AGENT)) < 4u) { __builtin_amdgcn_s_sleep(2); if (++sp_ > (1u << 22)) break; } }
        float rsv[8];
#pragma unroll
        for (int q = 0; q < 8; ++q) rsv[q] = __uint_as_float(__hip_atomic_load((const unsigned*)ss + row0 + (q >> 2) * HALF + (q & 3) * 16, __ATOMIC_RELAXED, __HIP_MEMORY_SCOPE_AGENT));
        f32x4 gv[2][2];
#pragma unroll
        for (int bj = 0; bj < 2; ++bj) { gv[bj][0] = *(const f32x4*)(gfin + col0 + bj * HALF); gv[bj][1] = *(const f32x4*)(gfin + col0 + bj * HALF + 4); }
#pragma unroll
        for (int ai = 0; ai < 2; ++ai)
#pragma unroll
            for (int m = 0; m < 4; ++m) { const int row = row0 + ai * HALF + m * 16; const float rs = rsqrtf(rsv[ai * 4 + m] * (1.f / 1024.f) + EPS); float* op = out + (size_t)row * D + col0;
#pragma unroll
                for (int bj = 0; bj < 2; ++bj) { *(f32x4*)(op + bj * HALF) = acc[ai][bj][m][0] * rs * gv[bj][0]; *(f32x4*)(op + bj * HALF + 4) = acc[ai][bj][m][1] * rs * gv[bj][1]; } }
    }
};
FK_DI float row_rstd(const float* ss, int row) { return rsqrtf(ss[row] * (1.f / 1024.f) + EPS); }
struct EpiSoftmax {
    static constexpr bool PERM = true;
    const float* ss; bf16_t* P;
    FK_DI void operator()(Acc& acc, const Unit& u, int wr, int wc, int fr, int fq, FK_LAS unsigned char* lds) const {
        FK_LAS f32x2* X = (FK_LAS f32x2*)(lds + LDS_EXCH);
        const int row0 = u.pm * BM + wr * 64 + fr;
        float rsv[8];
#pragma unroll
        for (int q = 0; q < 8; ++q) rsv[q] = ss[row0 + (q >> 2) * HALF + (q & 3) * 16];
#pragma unroll
        for (int ai = 0; ai < 2; ++ai)
#pragma unroll
            for (int m = 0; m < 4; ++m) { const int rl = ai * HALF + wr * 64 + m * 16 + fr; const float rs = rsqrtf(rsv[ai * 4 + m] * (1.f / 1024.f) + EPS);
                float mx = -3.0e38f;
#pragma unroll
                for (int bj = 0; bj < 2; ++bj)
#pragma unroll
                    for (int n = 0; n < 2; ++n) { f32x4 v = acc[ai][bj][m][n] * rs; acc[ai][bj][m][n] = v; mx = fmaxf(fmaxf(mx, fmaxf(v[0], v[1])), fmaxf(v[2], v[3])); }
                mx = fmaxf(mx, __shfl_xor(mx, 16)); mx = fmaxf(mx, __shfl_xor(mx, 32));
                float sm = 0.f;
#pragma unroll
                for (int bj = 0; bj < 2; ++bj)
#pragma unroll
                    for (int n = 0; n < 2; ++n) { f32x4 v = acc[ai][bj][m][n];
#pragma unroll
                        for (int j = 0; j < 4; ++j) { v[j] = __expf(v[j] - mx); sm += v[j]; }
                        acc[ai][bj][m][n] = v; }
                sm += __shfl_xor(sm, 16); sm += __shfl_xor(sm, 32);
                if (fq == 0) X[rl * 4 + wc] = (f32x2){mx, sm};
            }
        asm volatile("s_waitcnt lgkmcnt(0)" ::: "memory"); __builtin_amdgcn_s_barrier(); asm volatile("" ::: "memory");
#pragma unroll
        for (int ai = 0; ai < 2; ++ai)
#pragma unroll
            for (int m = 0; m < 4; ++m) { const int rl = ai * HALF + wr * 64 + m * 16 + fr;
                const f32x2 x0 = X[rl * 4 + 0], x1 = X[rl * 4 + 1], x2 = X[rl * 4 + 2], x3 = X[rl * 4 + 3];
                const float Mx = fmaxf(fmaxf(x0.x, x1.x), fmaxf(x2.x, x3.x));
                const float tot = x0.y * __expf(x0.x - Mx) + x1.y * __expf(x1.x - Mx) + x2.y * __expf(x2.x - Mx) + x3.y * __expf(x3.x - Mx);
                const float mine = wc == 0 ? x0.x : (wc == 1 ? x1.x : (wc == 2 ? x2.x : x3.x));
                const float sc = __expf(mine - Mx) * __builtin_amdgcn_rcpf(tot);
                bf16_t* rowp = P + (size_t)(row0 + ai * HALF + m * 16) * D + u.pn * BM + wc * 32 + 8 * fq;
#pragma unroll
                for (int bj = 0; bj < 2; ++bj) { const f32x4 v0 = acc[ai][bj][m][0] * sc, v1 = acc[ai][bj][m][1] * sc;
                    u32x4 w; w.x = pk2(v0[0], v0[1]); w.y = pk2(v0[2], v0[3]); w.z = pk2(v1[0], v1[1]); w.w = pk2(v1[2], v1[3]);
                    *(u32x4*)(rowp + bj * HALF) = w; } }
        asm volatile("s_waitcnt lgkmcnt(0)" ::: "memory"); __builtin_amdgcn_s_barrier(); asm volatile("" ::: "memory");
    }
};
struct EpiGateUp {
    static constexpr bool PERM = true;
    const float* ss; bf16_t* act;
    FK_DI void operator()(Acc& acc, const Unit& u, int wr, int wc, int fr, int fq, FK_LAS unsigned char*) const {
        const int row0 = u.pm * BM + wr * 64 + fr, col0 = u.pn * HALF + wc * 32 + 8 * fq;
        float rsv[8];
#pragma unroll
        for (int q = 0; q < 8; ++q) rsv[q] = ss[row0 + (q >> 2) * HALF + (q & 3) * 16];
#pragma unroll
        for (int ai = 0; ai < 2; ++ai)
#pragma unroll
            for (int m = 0; m < 4; ++m) { const int row = row0 + ai * HALF + m * 16; const float rs = rsqrtf(rsv[ai * 4 + m] * (1.f / 1024.f) + EPS);
                u32x4 w;
#pragma unroll
                for (int n = 0; n < 2; ++n) { const f32x4 g = acc[ai][0][m][n] * rs, up = acc[ai][1][m][n] * rs;
                    w[2 * n] = pk2(silu(g[0]) * up[0], silu(g[1]) * up[1]); w[2 * n + 1] = pk2(silu(g[2]) * up[2], silu(g[3]) * up[3]); }
                *(u32x4*)(act + (size_t)row * DFF + col0) = w; }
    }
};
}
namespace fk {
template <class Src>
FK_DI void transpose_item(const Src& src, int ldw, int K, bf16_t* WT, const float* gk, FK_LAS float* scr, int kb, int nb, int lane) {
    const int k0 = 64 * kb, n0 = 32 * nb;
    const float* colp = src(n0 + (lane & 31));
    float vv[32];
#pragma unroll
    for (int i = 0; i < 32; ++i) { const int kk = 2 * i + (lane >> 5); vv[i] = __builtin_nontemporal_load(colp + (size_t)(k0 + kk) * ldw); }
#pragma unroll
    for (int i = 0; i < 32; ++i) { const int kk = 2 * i + (lane >> 5); float v = vv[i]; if (gk) v *= gk[k0 + kk]; scr[kk * 33 + (lane & 31)] = v; }
    asm volatile("s_waitcnt lgkmcnt(0)" ::: "memory");
    const int c = lane & 7;
#pragma unroll
    for (int j = 0; j < 4; ++j) { const int n = (lane >> 3) + 8 * j; const FK_LAS float* s = scr + (8 * c) * 33 + n;
        u32x4 o; o.x = pk2(s[0 * 33], s[1 * 33]); o.y = pk2(s[2 * 33], s[3 * 33]); o.z = pk2(s[4 * 33], s[5 * 33]); o.w = pk2(s[6 * 33], s[7 * 33]);
        *(u32x4*)(WT + (size_t)(n0 + n) * K + k0 + 8 * c) = o; }
    asm volatile("s_waitcnt lgkmcnt(0)" ::: "memory");
}

FK_DI void late_weights(PP p, FK_LAS unsigned char* lds, int gw, int NGW, int wave, int lane) {
    unsigned char* ws = p->ws;
    FK_LAS float* scr = (FK_LAS float*)(lds + wave * 16384);
    const float* w_out = p->in[10]; const float* w_xq = p->in[13]; const float* w_xo = p->in[16]; const float* w_gate = p->in[18]; const float* w_up = p->in[19]; const float* w_down = p->in[20];
    const float* g_x = p->in[11]; const float* g_ffn = p->in[17];
    constexpr int I_SQ = (D / 64) * (D / 32), I_GU = (D / 64) * (2 * DFF / 32), I_DN = (DFF / 64) * (D / 32);
    constexpr int NITEMS = 2 * I_SQ + I_GU + I_DN;
    for (int it = gw; it < NITEMS; it += NGW) {
        int r = it;
        if (r < I_SQ) { auto src = [&](int n) { return w_out + n; }; transpose_item(src, D, D, (bf16_t*)(ws + WS_WOUT_T), (const float*)nullptr, scr, r / 32, r % 32, lane); continue; } r -= I_SQ;
        if (r < I_SQ) { auto src = [&](int n) { return w_xo + n; }; transpose_item(src, D, D, (bf16_t*)(ws + WS_WXO_T), (const float*)nullptr, scr, r / 32, r % 32, lane); continue; } r -= I_SQ;
        if (r < I_GU) { auto src = [&](int n) { const int blk = n >> 8, w = n & 255; return (w < 128 ? w_gate + blk * 128 + w : w_up + blk * 128 + (w - 128)); };
            transpose_item(src, DFF, D, (bf16_t*)(ws + WS_WGU_T), g_ffn, scr, r / (2 * DFF / 32), r % (2 * DFF / 32), lane); continue; } r -= I_GU;
        { auto src = [&](int n) { return w_down + n; }; transpose_item(src, D, DFF, (bf16_t*)(ws + WS_WDN_T), (const float*)nullptr, scr, r / 32, r % 32, lane); }
    }
    for (int k = gw; k < D; k += NGW) { const float sc = g_x[k] * 0.0625f; const f32x4* s = (const f32x4*)(w_xq + (size_t)k * D) + lane; u32x2* o = (u32x2*)((bf16_t*)(ws + WS_WXQ_G) + (size_t)k * D) + lane;
#pragma unroll
        for (int j = 0; j < 4; ++j) { const f32x4 v = s[64 * j] * sc; u32x2 w; w.x = pk2(v[0], v[1]); w.y = pk2(v[2], v[3]); o[64 * j] = w; } }
}

FK_DI void p0_prologue(PP p, FK_LAS unsigned char* lds, int gw, int NGW, int wave, int lane) {
    unsigned char* ws = p->ws;
    FK_LAS float* scr = (FK_LAS float*)(lds + wave * 16384);
    const float* w_in = p->in[3]; const float* w_xk = p->in[14]; const float* w_xv = p->in[15];
    const float* g_mix = p->in[2]; const float* g_mem = p->in[12];
    constexpr int I_IN = (D / 64) * (N1 / 32), I_SQ = (D / 64) * (D / 32);
    constexpr int NITEMS = I_IN + 2 * I_SQ;
    for (int it = gw; it < NITEMS; it += NGW) {
        int r = it;
        if (r < I_IN) { auto src = [&](int n) { if (n < 2048) return w_in + n; if (n < 2560) return w_in + n + 8; const int t = (n - 2560) >> 8, w = (n - 2560) & 255; return w_in + (w < 128 ? 2568 + 128 * t + w : 3080 + 128 * t + (w - 128)); };   transpose_item(src, INC, D, (bf16_t*)(ws + WS_WIN_T), (const float*)nullptr, scr, r / (N1 / 32), r % (N1 / 32), lane); continue; } r -= I_IN;
        if (r < I_SQ) { auto src = [&](int n) { return w_xk + n; }; transpose_item(src, D, D, (bf16_t*)(ws + WS_WXK_T), (const float*)nullptr, scr, r / 32, r % 32, lane); continue; } r -= I_SQ;
        { auto src = [&](int n) { return w_xv + n; }; transpose_item(src, D, D, (bf16_t*)(ws + WS_WXV_T), (const float*)nullptr, scr, r / 32, r % 32, lane); }
    }
    for (int i = gw * 64 + lane; i < M; i += NGW * 64) { ((float*)(ws + WS_SS1))[i] = 0.f; ((float*)(ws + WS_SS2))[i] = 0.f; ((float*)(ws + WS_SS3))[i] = 0.f; }
    for (int m = gw; m < NB * 256; m += NGW) { const f32x4* xr = (const f32x4*)(p->in[1] + (size_t)m * D) + lane; f32x4 v[4]; float s = 0.f;
#pragma unroll
        for (int j = 0; j < 4; ++j) { v[j] = xr[64 * j]; s += (v[j][0] * v[j][0] + v[j][1] * v[j][1]) + (v[j][2] * v[j][2] + v[j][3] * v[j][3]); }
        const float rs = rsqrtf(wave_sum(s) * (1.f / D) + EPS); u32x2* o = (u32x2*)((bf16_t*)(ws + WS_MEMN) + (size_t)m * D) + lane;
#pragma unroll
        for (int j = 0; j < 4; ++j) { const f32x4 g = ((const f32x4*)g_mem)[lane + 64 * j]; const f32x4 y = v[j] * rs * g; u32x2 w; w.x = pk2(y[0], y[1]); w.y = pk2(y[2], y[3]); o[64 * j] = w; } }
    {
        f32x4 gm[4]; f32x4 wab[4][4][2];
#pragma unroll
        for (int j = 0; j < 4; ++j) { gm[j] = ((const f32x4*)g_mix)[lane + 64 * j];
#pragma unroll
            for (int e = 0; e < 4; ++e) { const int k = 4 * lane + 256 * j + e; const f32x4* wp = (const f32x4*)(w_in + (size_t)k * INC + 2048); wab[j][e][0] = wp[0] * gm[j][e]; wab[j][e][1] = wp[1] * gm[j][e]; } }
        const float* a_log = p->in[5]; const float* dt_bias = p->in[6];
        bf16_t* XN = (bf16_t*)((unsigned char*)p->out + DO_XN); float* GB = (float*)(ws + WS_GB);
        f32x4 vn[4];
        { const f32x4* xr = (const f32x4*)(p->in[0] + (size_t)gw * D) + lane;
#pragma unroll
          for (int j = 0; j < 4; ++j) vn[j] = __builtin_nontemporal_load(xr + 64 * j); }
        for (int m = gw; m < M; m += NGW) { f32x4 v[4]; float s = 0.f;
#pragma unroll
            for (int j = 0; j < 4; ++j) { v[j] = vn[j]; s += (v[j][0] * v[j][0] + v[j][1] * v[j][1]) + (v[j][2] * v[j][2] + v[j][3] * v[j][3]); }
            if (m + NGW < M) { const f32x4* xr = (const f32x4*)(p->in[0] + (size_t)(m + NGW) * D) + lane;
#pragma unroll
                for (int j = 0; j < 4; ++j) vn[j] = __builtin_nontemporal_load(xr + 64 * j); }
            const float rs = rsqrtf(wave_sum(s) * (1.f / D) + EPS);
            f32x4 d0 = {0.f, 0.f, 0.f, 0.f}, d1 = {0.f, 0.f, 0.f, 0.f};
            u32x2* o = (u32x2*)(XN + (size_t)m * D) + lane;
#pragma unroll
            for (int j = 0; j < 4; ++j) { const f32x4 xs = v[j] * rs; const f32x4 y = xs * gm[j]; u32x2 w; w.x = pk2(y[0], y[1]); w.y = pk2(y[2], y[3]); o[64 * j] = w;
#pragma unroll
                for (int e = 0; e < 4; ++e) { d0 += wab[j][e][0] * xs[e]; d1 += wab[j][e][1] * xs[e]; } }
            float r8[8] = {d0[0], d0[1], d0[2], d0[3], d1[0], d1[1], d1[2], d1[3]};
#pragma unroll
            for (int q = 0; q < 8; ++q) r8[q] = wave_sum(r8[q]);
            float mine = r8[0];
#pragma unroll
            for (int q = 1; q < 8; ++q) mine = (lane == q) ? r8[q] : mine;
            if (lane < 4) { const float xx = mine + dt_bias[lane]; const float sp = xx > 20.f ? xx : log1pf(__expf(xx)); GB[(size_t)m * 8 + lane] = -__expf(a_log[lane]) * sp; }
            else if (lane < 8) { GB[(size_t)m * 8 + lane] = 1.f / (1.f + __expf(-mine)); }
        }
    }
}

FK_DI void p9_final(PP p, int gw, int NGW, int lane) {
    const float* ss = (const float*)(p->ws + WS_SS3); const f32x4* g = (const f32x4*)p->in[21]; const bf16_t* HB = (const bf16_t*)(p->ws + WS_HB);
    f32x4 gm[4];
#pragma unroll
    for (int j = 0; j < 2; ++j) { gm[2 * j] = g[2 * lane + 128 * j]; gm[2 * j + 1] = g[2 * lane + 128 * j + 1]; }
    for (int m0 = gw * 4; m0 < M; m0 += NGW * 4) {
        u32x4 hv[4][2]; float rs[4];
#pragma unroll
        for (int r = 0; r < 4; ++r) { const u32x4* hr = (const u32x4*)(HB + (size_t)(m0 + r) * D) + lane; hv[r][0] = hr[0]; hv[r][1] = hr[64]; rs[r] = row_rstd(ss, m0 + r); }
#pragma unroll
        for (int r = 0; r < 4; ++r) { f32x4* xr = (f32x4*)(p->out + (size_t)(m0 + r) * D) + 2 * lane;
#pragma unroll
            for (int j = 0; j < 2; ++j) { const u32x4 h = hv[r][j];
                xr[128 * j] = (f32x4){bf_lo(h.x), bf_hi(h.x), bf_lo(h.y), bf_hi(h.y)} * rs[r] * gm[2 * j];
                xr[128 * j + 1] = (f32x4){bf_lo(h.z), bf_hi(h.z), bf_lo(h.w), bf_hi(h.w)} * rs[r] * gm[2 * j + 1]; } }
    }
}
}
namespace fk {
#define FK_MFMA32(a, b, c) __builtin_amdgcn_mfma_f32_32x32x16_bf16((a), (b), (c), 0, 0, 0)
FK_DI int crow(int reg, int h) { return (reg & 3) + 8 * (reg >> 2) + 4 * h; }
FK_DI bf16x8 pack8(const f32x16& x, int s) {
    u32x4 p; p.x = pk2(x[8 * s], x[8 * s + 1]); p.y = pk2(x[8 * s + 2], x[8 * s + 3]); p.z = pk2(x[8 * s + 4], x[8 * s + 5]); p.w = pk2(x[8 * s + 6], x[8 * s + 7]);
    return __builtin_bit_cast(bf16x8, p);
}
FK_DI f32x16 zero16() { f32x16 z; for (int i = 0; i < 16; ++i) z[i] = 0.f; return z; }

constexpr int PL_QS = 0, PL_KS = 17408, PL_KT = 34816, PL_VT = 53248, PL_AF = 71680, PL_TP = 88064, PL_TPP = 97280, PL_TAB = 106496;
constexpr int QS_LD = 136, KT_LD = 72, TP_LD = 72;

FK_DI void st16_wt(__amdgpu_buffer_rsrc_t rs, unsigned off, u32x4 v) { __builtin_amdgcn_raw_buffer_store_b128(v, rs, off, 0, 16); }
FK_DI void p2_short_conv(PP p, int gw, int lane) {
    const bf16_t* SC = (const bf16_t*)(p->ws + WS_SC);
    const __amdgpu_buffer_rsrc_t mrs = __builtin_amdgcn_make_buffer_rsrc((void*)(p->ws + WS_MIX), 0, (int)((size_t)M * D * 2), 0x00020000);
    const float* csw = p->in[8]; const float* scg = p->in[9];
    float w0[8], w1[8], w2[8], g[8];
#pragma unroll
    for (int e = 0; e < 8; ++e) { w0[e] = csw[8 * lane + e]; w1[e] = csw[512 + 8 * lane + e]; w2[e] = csw[1024 + 8 * lane + e]; g[e] = scg[8 * lane + e]; }
    const int r0 = gw * 16;
    float p1[8], p2[8];
    auto prod = [&](int row, float* o) {
        const u32x4 c = *(const u32x4*)(SC + (size_t)row * 1024 + 512 + 8 * lane);
        #pragma unroll
        for (int q = 0; q < 4; ++q) { o[2 * q] = bf_lo(c[q]); o[2 * q + 1] = bf_hi(c[q]); }
    };
    const int t0 = r0 & (SEQ - 1);
    if (t0 >= 1) prod(r0 - 1, p1); else { for (int e = 0; e < 8; ++e) p1[e] = 0.f; }
    if (t0 >= 2) prod(r0 - 2, p2); else { for (int e = 0; e < 8; ++e) p2[e] = 0.f; }
    {
        u32x4 cv[16], bv[16];
#pragma unroll
        for (int r = 0; r < 16; ++r) { const size_t row = (size_t)(r0 + r); cv[r] = __builtin_nontemporal_load((const u32x4*)(SC + row * 1024 + 512 + 8 * lane)); bv[r] = __builtin_nontemporal_load((const u32x4*)(SC + row * 1024 + 8 * lane)); }
#pragma unroll
        for (int r = 0; r < 16; ++r) { const size_t row = (size_t)(r0 + r); float p0[8];
#pragma unroll
            for (int q = 0; q < 4; ++q) { p0[2 * q] = bf_lo(cv[r][q]); p0[2 * q + 1] = bf_hi(cv[r][q]); }
            const u32x4 b = bv[r]; float y[8]; float s = 0.f;
#pragma unroll
            for (int e = 0; e < 8; ++e) { const float bb = (e & 1) ? bf_hi(b[e >> 1]) : bf_lo(b[e >> 1]); y[e] = bb * (w0[e] * p2[e] + w1[e] * p1[e] + w2[e] * p0[e]); s += y[e] * y[e]; }
            s = sum8(s);
            const float rs = rsqrtf(s * (1.f / 64.f) + EPS);
            u32x4 o; o.x = pk2(y[0] * rs * g[0], y[1] * rs * g[1]); o.y = pk2(y[2] * rs * g[2], y[3] * rs * g[3]); o.z = pk2(y[4] * rs * g[4], y[5] * rs * g[5]); o.w = pk2(y[6] * rs * g[6], y[7] * rs * g[7]);
            st16_wt(mrs, (unsigned)((row * D + 512 + 8 * lane) * 2), o);
#pragma unroll
            for (int e = 0; e < 8; ++e) { p2[e] = p1[e]; p1[e] = p0[e]; } }
    }
}

constexpr int PL_CW = 107520;
struct P2Raw { u32x4 x[3][5]; float g, be; };
FK_DI void p2_load(PP p, int it, int tid, int lane, P2Raw& R) {
    const int n = it & 63, h = (it >> 6) & 3, b = it >> 8, cg = tid & 15, rg = tid >> 4;
    const bf16_t* QKV = (const bf16_t*)(p->ws + WS_QKV) + (size_t)(b * SEQ) * 1536 + h * 128 + cg * 8;
#pragma unroll
    for (int pt = 0; pt < 3; ++pt)
#pragma unroll
        for (int j = 0; j < 5; ++j) { const int tt = n * 64 + 2 * rg - 3 + j; R.x[pt][j] = (tt >= 0) ? *(const u32x4*)(QKV + (size_t)tt * 1536 + pt * 512) : (u32x4){0u, 0u, 0u, 0u}; }
    const float* GB = (const float*)(p->ws + WS_GB) + (size_t)(b * SEQ + n * 64 + lane) * 8 + h;
    R.g = GB[0]; R.be = GB[4];
}
#define P2_BAR() do { asm volatile("s_waitcnt lgkmcnt(0)" ::: "memory"); __builtin_amdgcn_s_barrier(); asm volatile("" ::: "memory"); } while (0)
FK_DI void p2_item(PP p, FK_LAS unsigned char* lds, int it, int it_next, int tid_in, int wave, int lane_in, P2Raw& R) {
    int tid = tid_in, lane = lane_in; asm volatile("" : "+v"(tid), "+v"(lane));
    unsigned char* item = p->ws + WS_CHUNK + (size_t)it * CH_BYTES;
    const __amdgpu_buffer_rsrc_t irs = __builtin_amdgcn_make_buffer_rsrc(item, 0, CH_BYTES, 0x00020000);
    const int hw = (it >> 6) & 3;
    FK_LAS float* TAB = (FK_LAS float*)(lds + PL_TAB);
    if (wave == 0) {
        float g = R.g; const float be = R.be;
#pragma unroll
        for (int o = 1; o < 64; o <<= 1) { const float t = __shfl_up(g, o); if (lane >= o) g += t; }
        const float gl = __shfl(g, 63);
        TAB[lane] = g; TAB[64 + lane] = __expf(g); TAB[128 + lane] = be; TAB[192 + lane] = __expf(gl - g);
        if (lane == 0) __hip_atomic_store((unsigned*)(p->ws + WS_GL) + it, __float_as_uint(__expf(gl)), __ATOMIC_RELAXED, __HIP_MEMORY_SCOPE_AGENT);
    }
    {
        const int cg = tid & 15, rg = tid >> 4;
#pragma unroll
        for (int pt = 0; pt < 3; ++pt) {
            float y0[8], y1[8];
#pragma unroll
            for (int e = 0; e < 8; ++e) { y0[e] = 0.f; y1[e] = 0.f; }
            float xf[8];
#pragma unroll
            for (int j = 0; j < 5; ++j) { const u32x4 x = R.x[pt][j];
#pragma unroll
                for (int q = 0; q < 4; ++q) { xf[2 * q] = bf_lo(x[q]); xf[2 * q + 1] = bf_hi(x[q]); }
                if (j < 4) { const FK_LAS f32x4* wp = (const FK_LAS f32x4*)(lds + PL_CW + hw * 6144 + ((pt * 4 + j) * 128 + cg * 8) * 4); const f32x4 wa = wp[0], wb = wp[1];
#pragma unroll
                    for (int e = 0; e < 4; ++e) { y0[e] += wa[e] * xf[e]; y0[4 + e] += wb[e] * xf[4 + e]; } }
                if (j >= 1) { const FK_LAS f32x4* wp = (const FK_LAS f32x4*)(lds + PL_CW + hw * 6144 + ((pt * 4 + j - 1) * 128 + cg * 8) * 4); const f32x4 wa = wp[0], wb = wp[1];
#pragma unroll
                    for (int e = 0; e < 4; ++e) { y1[e] += wa[e] * xf[e]; y1[4 + e] += wb[e] * xf[4 + e]; } }
            }
            float s0 = 0.f, s1 = 0.f;
#pragma unroll
            for (int e = 0; e < 8; ++e) { y0[e] = silu(y0[e]); y1[e] = silu(y1[e]); s0 += y0[e] * y0[e]; s1 += y1[e] * y1[e]; }
            if (pt < 2) { s0 = sum16(s0); s1 = sum16(s1);
                const float sc = (pt == 0 ? 0.08838834764831845f : 1.f), r0 = rsqrtf(s0 + EPS) * sc, r1 = rsqrtf(s1 + EPS) * sc;
#pragma unroll
                for (int e = 0; e < 8; ++e) { y0[e] *= r0; y1[e] *= r1; } }
            u32x4 o0, o1; o0.x = pk2(y0[0], y0[1]); o0.y = pk2(y0[2], y0[3]); o0.z = pk2(y0[4], y0[5]); o0.w = pk2(y0[6], y0[7]);
            o1.x = pk2(y1[0], y1[1]); o1.y = pk2(y1[2], y1[3]); o1.z = pk2(y1[4], y1[5]); o1.w = pk2(y1[6], y1[7]);
            if (pt <= 1) { FK_LAS unsigned char* dst = lds + (pt == 0 ? PL_QS : PL_KS) + ((2 * rg) * QS_LD + cg * 8) * 2; *(FK_LAS u32x4*)dst = o0; *(FK_LAS u32x4*)(dst + QS_LD * 2) = o1; }
            if (pt >= 1) { FK_LAS unsigned char* T = lds + (pt == 1 ? PL_KT : PL_VT) + ((cg * 8) * KT_LD + 2 * rg) * 2;
#pragma unroll
                for (int e = 0; e < 8; ++e) { const unsigned a0 = (e & 1) ? (o0[e >> 1] >> 16) : (o0[e >> 1] & 0xffffu), a1 = (e & 1) ? (o1[e >> 1] & 0xffff0000u) : (o1[e >> 1] << 16);
                    *(FK_LAS unsigned*)(T + e * KT_LD * 2) = a0 | a1; } }
        }
    }
    P2_BAR();
    if (it_next >= 0) p2_load(p, it_next, tid, lane, R);
    {
        const int r = lane & 31, hh = lane >> 5;
        if (wave < 4) {
            const int tj = wave >> 1, ti = wave & 1;
            f32x16 c = zero16();
            if (tj <= ti) {
#pragma unroll
                for (int s = 0; s < 8; ++s) { const bf16x8 a = *(const FK_LAS bf16x8*)(lds + PL_KS + ((32 * tj + r) * QS_LD + 16 * s + 8 * hh) * 2);
                    const bf16x8 bq = *(const FK_LAS bf16x8*)(lds + PL_QS + ((32 * ti + r) * QS_LD + 16 * s + 8 * hh) * 2); c = FK_MFMA32(a, bq, c); }
                const int i = 32 * ti + r; const float gci = TAB[i];
#pragma unroll
                for (int reg = 0; reg < 16; ++reg) { const int j = 32 * tj + crow(reg, hh); c[reg] = (i >= j) ? c[reg] * __expf(gci - TAB[j]) : 0.f; }
            }
#pragma unroll
            for (int s = 0; s < 2; ++s) st16_wt(irs, CH_ATF + (((ti * 4) + 2 * tj + s) * 64 + lane) * 16, __builtin_bit_cast(u32x4, pack8(c, s)));
        } else {
            const int ta = (wave - 4) >> 1, tb = (wave - 4) & 1;
            if (ta >= tb) {
                f32x16 c = zero16();
#pragma unroll
                for (int s = 0; s < 8; ++s) { const bf16x8 a = *(const FK_LAS bf16x8*)(lds + PL_KS + ((32 * ta + r) * QS_LD + 16 * s + 8 * hh) * 2);
                    const bf16x8 bk = *(const FK_LAS bf16x8*)(lds + PL_KS + ((32 * tb + r) * QS_LD + 16 * s + 8 * hh) * 2); c = FK_MFMA32(a, bk, c); }
                const int j = 32 * tb + r; const float gcj = TAB[j]; FK_LAS float* AF = (FK_LAS float*)(lds + PL_AF);
#pragma unroll
                for (int reg = 0; reg < 16; ++reg) { const int i = 32 * ta + crow(reg, hh); AF[i * 64 + j] = (i > j) ? TAB[128 + i] * c[reg] * __expf(TAB[i] - gcj) : 0.f; }
            }
        }
#pragma unroll
        for (int rep = 0; rep < 2; ++rep) { const int f = wave * 2 + rep;
            { const int mt = f >> 3, kk = f & 7; const int tok = 32 * mt + r; const float sc = TAB[64 + tok];
              const u32x2 lo = *(const FK_LAS u32x2*)(lds + PL_QS + (tok * QS_LD + 16 * kk + 4 * hh) * 2), hi = *(const FK_LAS u32x2*)(lds + PL_QS + (tok * QS_LD + 16 * kk + 8 + 4 * hh) * 2);
              u32x4 o; o.x = pk2(bf_lo(lo.x) * sc, bf_hi(lo.x) * sc); o.y = pk2(bf_lo(lo.y) * sc, bf_hi(lo.y) * sc); o.z = pk2(bf_lo(hi.x) * sc, bf_hi(hi.x) * sc); o.w = pk2(bf_lo(hi.y) * sc, bf_hi(hi.y) * sc);
              st16_wt(irs, CH_QDF + (f * 64 + lane) * 16, o); }
            { const int mt = f >> 2, ks = f & 3; const int dk = 32 * mt + r; const int tk = 16 * ks + 4 * hh;
              const u32x2 lo = *(const FK_LAS u32x2*)(lds + PL_KT + (dk * KT_LD + tk) * 2), hi = *(const FK_LAS u32x2*)(lds + PL_KT + (dk * KT_LD + tk + 8) * 2);
              const f32x4 f0 = *(const FK_LAS f32x4*)(TAB + 192 + tk), f1 = *(const FK_LAS f32x4*)(TAB + 192 + tk + 8);
              u32x4 o; o.x = pk2(bf_lo(lo.x) * f0[0], bf_hi(lo.x) * f0[1]); o.y = pk2(bf_lo(lo.y) * f0[2], bf_hi(lo.y) * f0[3]); o.z = pk2(bf_lo(hi.x) * f1[0], bf_hi(hi.x) * f1[1]); o.w = pk2(bf_lo(hi.y) * f1[2], bf_hi(hi.y) * f1[3]);
              st16_wt(irs, CH_KDF + (f * 64 + lane) * 16, o); }
        }
    }
    P2_BAR();
#ifndef NO_STEPD
    if (wave == 0) {
        const int c = lane & 31, hb = lane >> 5;
        const FK_LAS float* AF = (const FK_LAS float*)(lds + PL_AF) + (32 * hb) * 64 + 32 * hb;
        FK_LAS bf16_t* TP = (FK_LAS bf16_t*)(lds + PL_TP); FK_LAS bf16_t* TPP = (FK_LAS bf16_t*)(lds + PL_TPP);
        FK_LAS unsigned char* X1 = lds + PL_QS;
        asm volatile("" : "+v"(AF), "+v"(TP), "+v"(TPP), "+v"(X1));
        const int col = 32 * hb + c;
        const float bcol = TAB[128 + col], becol = bcol * TAB[64 + col];
        float t[32];
#pragma unroll
        for (int i = 0; i < 32; ++i) {
            float acc = (c == i) ? 1.f : 0.f;
#pragma unroll
            for (int j4 = 0; j4 < (i + 3) / 4; ++j4) { const f32x4 a = *(const FK_LAS f32x4*)(AF + i * 64 + 4 * j4);
#pragma unroll
                for (int e = 0; e < 4; ++e) if (4 * j4 + e < i) acc -= a[e] * t[4 * j4 + e]; }
            t[i] = acc;
            const unsigned pv = pk2(acc * becol, acc * bcol);
            TP[(32 * hb + i) * TP_LD + col] = (bf16_t)(pv & 0xffffu); TPP[(32 * hb + i) * TP_LD + col] = (bf16_t)(pv >> 16);
            if (hb == 0) { TP[i * TP_LD + 32 + c] = 0; TPP[i * TP_LD + 32 + c] = 0; }
            const unsigned tb = pk2(acc, acc);
            if (hb == 1) *(FK_LAS bf16_t*)(X1 + 2560 + i * 80 + c * 2) = (bf16_t)(tb & 0xffffu);
            if ((i & 1) == 1) asm volatile("" ::: "memory");
        }
        if (hb == 0) {
#pragma unroll
            for (int q = 0; q < 4; ++q) { u32x4 w; w.x = pk2(t[8 * q], t[8 * q + 1]); w.y = pk2(t[8 * q + 2], t[8 * q + 3]); w.z = pk2(t[8 * q + 4], t[8 * q + 5]); w.w = pk2(t[8 * q + 6], t[8 * q + 7]);
                *(FK_LAS u32x4*)(X1 + c * 80 + q * 16) = w; }
        }
        asm volatile("s_waitcnt lgkmcnt(0)" ::: "memory");
        f32x16 xacc = zero16();
        const FK_LAS float* A21 = (const FK_LAS float*)(lds + PL_AF) + (32 + c) * 64;
#pragma unroll
        for (int s2 = 0; s2 < 2; ++s2) { const f32x4 a0 = *(const FK_LAS f32x4*)(A21 + 16 * s2 + 8 * hb), a1 = *(const FK_LAS f32x4*)(A21 + 16 * s2 + 8 * hb + 4);
            u32x4 af; af.x = pk2(a0[0], a0[1]); af.y = pk2(a0[2], a0[3]); af.z = pk2(a1[0], a1[1]); af.w = pk2(a1[2], a1[3]);
            const bf16x8 bfrag = *(const FK_LAS bf16x8*)(X1 + c * 80 + (16 * s2 + 8 * hb) * 2);
            xacc = FK_MFMA32(__builtin_bit_cast(bf16x8, af), bfrag, xacc); }
        f32x16 yacc = zero16();
#pragma unroll
        for (int s2 = 0; s2 < 2; ++s2) { const u32x2 lo = *(const FK_LAS u32x2*)(X1 + 2560 + c * 80 + (16 * s2 + 4 * hb) * 2), hi = *(const FK_LAS u32x2*)(X1 + 2560 + c * 80 + (16 * s2 + 8 + 4 * hb) * 2);
            u32x4 af; af.x = lo.x; af.y = lo.y; af.z = hi.x; af.w = hi.y;
            yacc = FK_MFMA32(__builtin_bit_cast(bf16x8, af), pack8(xacc, s2), yacc); }
        const float bc0 = TAB[128 + c], bec0 = bc0 * TAB[64 + c];
#pragma unroll
        for (int reg = 0; reg < 16; ++reg) { const int i = 32 + crow(reg, hb); const unsigned pv = pk2(-yacc[reg] * bec0, -yacc[reg] * bc0);
            TP[i * TP_LD + c] = (bf16_t)(pv & 0xffffu); TPP[i * TP_LD + c] = (bf16_t)(pv >> 16); }
    }
#endif
    P2_BAR();
    {
        const int r = lane & 31, hh = lane >> 5;
        { const int mt = wave & 1, s4 = wave >> 1; f32x16 c = zero16();
#pragma unroll
          for (int s = 0; s < 4; ++s) { const bf16x8 a = *(const FK_LAS bf16x8*)(lds + PL_TPP + ((32 * mt + r) * TP_LD + 16 * s + 8 * hh) * 2);
              const bf16x8 bv = *(const FK_LAS bf16x8*)(lds + PL_VT + ((32 * s4 + r) * KT_LD + 16 * s + 8 * hh) * 2); c = FK_MFMA32(a, bv, c); }
          const unsigned dst = CH_UC + ((s4 * 64 + lane) * 2 + mt) * 32;
          st16_wt(irs, dst, __builtin_bit_cast(u32x4, pack8(c, 0))); st16_wt(irs, dst + 16, __builtin_bit_cast(u32x4, pack8(c, 1))); }
        { const int t = wave >> 1, mt = wave & 1; f32x16 c = zero16();
#pragma unroll
          for (int s = 0; s < 4; ++s) { const bf16x8 a = *(const FK_LAS bf16x8*)(lds + PL_KT + ((32 * t + r) * KT_LD + 16 * s + 8 * hh) * 2);
              const bf16x8 bt = *(const FK_LAS bf16x8*)(lds + PL_TP + ((32 * mt + r) * TP_LD + 16 * s + 8 * hh) * 2); c = FK_MFMA32(a, bt, c); }
#pragma unroll
          for (int s = 0; s < 2; ++s) st16_wt(irs, CH_WF + ((mt * 8 + 2 * t + s) * 64 + lane) * 16, __builtin_bit_cast(u32x4, pack8(c, s))); }
    }
    asm volatile("s_waitcnt vmcnt(0)" ::: "memory");
    P2_BAR();
    if (tid == 0) __hip_atomic_store((unsigned*)(p->ws + WS_FLAGS) + it, 1u, __ATOMIC_RELAXED, __HIP_MEMORY_SCOPE_AGENT);
}

#define SC_BAR() do { asm volatile("s_waitcnt lgkmcnt(0)" ::: "memory"); __builtin_amdgcn_s_barrier(); asm volatile("" ::: "memory"); } while (0)
constexpr int SC_STAGE = 57344, SC_OBUF = 2 * SC_STAGE, SC_OB_BYTES = 16384;

FK_DI void p3_scan(PP p, FK_LAS unsigned char* lds, int bh, int tid_in, int wave, int lane_in) {
    int lane = lane_in; asm volatile("" : "+v"(lane));
    const int b = bh >> 2, h = bh & 3;
    const unsigned char* items = p->ws + WS_CHUNK + (size_t)(bh * 64) * CH_BYTES;
    const float* GL = (const float*)(p->ws + WS_GL) + bh * 64;
    const int r = lane & 31, hh = lane >> 5;
    const __amdgpu_buffer_rsrc_t prs = __builtin_amdgcn_make_buffer_rsrc((void*)items, 0, 64 * CH_BYTES, 0x00020000);
    const unsigned* flags = (const unsigned*)(p->ws + WS_FLAGS) + bh * 64;
    if (wave < 4) {
        f32x16 S[4]; bf16x8 Sf[8];
#pragma unroll
        for (int t = 0; t < 4; ++t) S[t] = zero16();
#pragma unroll
        for (int k = 0; k < 8; ++k) Sf[k] = (bf16x8){0, 0, 0, 0, 0, 0, 0, 0};
        const unsigned ubase = CH_UC + wave * 4096 + lane * 64;
        u32x4 u0[4], u1[4];
        SC_BAR();
#define SC_ULD(ub, k) do { _Pragma("unroll") for (int i_ = 0; i_ < 4; ++i_) ub[i_] = __builtin_bit_cast(u32x4, __builtin_amdgcn_raw_buffer_load_b128(prs, ubase + (unsigned)(k) * CH_BYTES + i_ * 16, 0, 18)); } while (0)
        SC_ULD(u0, 0); SC_ULD(u1, 1);
        unsigned g0 = __hip_atomic_load((const unsigned*)GL, __ATOMIC_RELAXED, __HIP_MEMORY_SCOPE_AGENT), g1 = __hip_atomic_load((const unsigned*)GL + 1, __ATOMIC_RELAXED, __HIP_MEMORY_SCOPE_AGENT);
#define SC_STEP(n, ub, gv, RELOAD) do { \
            const FK_LAS unsigned char* st = lds + ((n) & 1) * SC_STAGE + lane * 16; \
            const float egl = __uint_as_float(gv); \
            f32x16 av[2]; \
            _Pragma("unroll") for (int mt = 0; mt < 2; ++mt) { av[mt] = zero16(); \
                _Pragma("unroll") for (int kk = 0; kk < 8; ++kk) { const bf16x8 wa = *(const FK_LAS bf16x8*)(st + CH_WF + (mt * 8 + kk) * 1024); av[mt] = FK_MFMA32(wa, Sf[kk], av[mt]); } } \
            bf16x8 Vf[4]; \
            _Pragma("unroll") for (int mt = 0; mt < 2; ++mt) { \
                _Pragma("unroll") for (int q = 0; q < 8; ++q) { const unsigned uw = ub[2 * mt + (q >> 2)][q & 3]; av[mt][2 * q] = bf_lo(uw) - av[mt][2 * q]; av[mt][2 * q + 1] = bf_hi(uw) - av[mt][2 * q + 1]; } \
                Vf[2 * mt] = pack8(av[mt], 0); Vf[2 * mt + 1] = pack8(av[mt], 1); } \
            if (RELOAD) { SC_ULD(ub, (n) + 2); gv = __hip_atomic_load((const unsigned*)GL + (n) + 2, __ATOMIC_RELAXED, __HIP_MEMORY_SCOPE_AGENT); } \
            f32x16 ao[2]; \
            _Pragma("unroll") for (int mt = 0; mt < 2; ++mt) { ao[mt] = zero16(); \
                _Pragma("unroll") for (int kk = 0; kk < 8; ++kk) { const bf16x8 qa = *(const FK_LAS bf16x8*)(st + CH_QDF + (mt * 8 + kk) * 1024); ao[mt] = FK_MFMA32(qa, Sf[kk], ao[mt]); } \
                _Pragma("unroll") for (int ks = 0; ks < 4; ++ks) { const bf16x8 aa = *(const FK_LAS bf16x8*)(st + CH_ATF + (mt * 4 + ks) * 1024); ao[mt] = FK_MFMA32(aa, Vf[ks], ao[mt]); } } \
            _Pragma("unroll") for (int t = 0; t < 4; ++t) { S[t] = S[t] * egl; \
                _Pragma("unroll") for (int ks = 0; ks < 4; ++ks) { const bf16x8 ka = *(const FK_LAS bf16x8*)(st + CH_KDF + (t * 4 + ks) * 1024); S[t] = FK_MFMA32(ka, Vf[ks], S[t]); } \
                Sf[2 * t] = pack8(S[t], 0); Sf[2 * t + 1] = pack8(S[t], 1); } \
            FK_LAS bf16_t* ob = (FK_LAS bf16_t*)(lds + SC_OBUF + ((n) & 1) * SC_OB_BYTES) + 32 * wave + r; \
            _Pragma("unroll") for (int mt = 0; mt < 2; ++mt) \
                _Pragma("unroll") for (int q = 0; q < 8; ++q) { const unsigned pv = pk2(ao[mt][2 * q], ao[mt][2 * q + 1]); \
                    ob[(32 * mt + crow(2 * q, hh)) * 128] = (bf16_t)(pv & 0xffffu); ob[(32 * mt + crow(2 * q + 1, hh)) * 128] = (bf16_t)(pv >> 16); } \
            SC_BAR(); } while (0)
        for (int n = 0; n < NCH - 8; n += 8) { SC_STEP(n, u0, g0, true); SC_STEP(n + 1, u1, g1, true); SC_STEP(n + 2, u0, g0, true); SC_STEP(n + 3, u1, g1, true); SC_STEP(n + 4, u0, g0, true); SC_STEP(n + 5, u1, g1, true); SC_STEP(n + 6, u0, g0, true); SC_STEP(n + 7, u1, g1, true); }
        SC_STEP(NCH - 8, u0, g0, true); SC_STEP(NCH - 7, u1, g1, true); SC_STEP(NCH - 6, u0, g0, true); SC_STEP(NCH - 5, u1, g1, true); SC_STEP(NCH - 4, u0, g0, true); SC_STEP(NCH - 3, u1, g1, true);
        SC_STEP(NCH - 2, u0, g0, false); SC_STEP(NCH - 1, u1, g1, false);
#undef SC_STEP
#undef SC_ULD
        SC_BAR();
    } else {
        const int e = wave - 4, l16 = lane & 15, rq = lane >> 4;
        const unsigned char* Zu = (const unsigned char*)p->out + DO_Z + ((size_t)b * SEQ * 512 + h * 128 + (size_t)(16 * e) * 512) * 2;
        unsigned char* Mu = p->ws + WS_MIX + ((size_t)b * SEQ * D + h * 128 + (size_t)(16 * e) * D) * 2;
        const __amdgpu_buffer_rsrc_t mxrs = __builtin_amdgcn_make_buffer_rsrc((void*)Mu, 0, SEQ * 2048, 0x00020000);
        unsigned* prog = (unsigned*)(p->ws + WS_PROG) + b * 4;
        const unsigned zoff = (unsigned)(rq * 512 + 8 * l16) * 2u, moff = (unsigned)(rq * D + 8 * l16) * 2u, soff = (unsigned)lane * 16u;
        const unsigned src = (unsigned)(e * 14336) + (unsigned)lane * 16u;
        FK_LAS unsigned char* dstw = lds + e * 14336 + lane * 16;
        u32x4 sa[14], sb[14], sc[14]; u32x4 za[4], zb[4];
#define SC_POLL(k) do { unsigned sp_ = 0; while ((unsigned)__builtin_amdgcn_readfirstlane(__hip_atomic_load(flags + (k), __ATOMIC_RELAXED, __HIP_MEMORY_SCOPE_AGENT)) == 0u) { __builtin_amdgcn_s_sleep(2); if (++sp_ > (1u << 22)) break; } } while (0)
#define SC_LD(set, k) do { SC_POLL(k); _Pragma("unroll") for (int i = 0; i < 14; ++i) set[i] = __builtin_bit_cast(u32x4, __builtin_amdgcn_raw_buffer_load_b128(prs, src + (unsigned)(k) * CH_BYTES + i * 1024, 0, 18)); } while (0)
#define SC_WR(set, k) do { FK_LAS unsigned char* d_ = dstw + ((k) & 1) * SC_STAGE; _Pragma("unroll") for (int i = 0; i < 14; ++i) *(FK_LAS u32x4*)(d_ + i * 1024) = set[i]; } while (0)
#define SC_ZLD(zs, k) do { _Pragma("unroll") for (int q = 0; q < 4; ++q) zs[q] = __builtin_nontemporal_load((const u32x4*)(Zu + (size_t)((k) * 64 + 4 * q) * 1024 + zoff)); } while (0)
#define SC_GATE(zs, k) do { const FK_LAS unsigned char* ob = lds + SC_OBUF + ((k) & 1) * SC_OB_BYTES; \
            _Pragma("unroll") for (int q = 0; q < 4; ++q) { const int row = 16 * e + 4 * q + rq; const u32x4 ov = *(const FK_LAS u32x4*)(ob + row * 256 + l16 * 16); \
                float o[8] = {bf_lo(ov.x), bf_hi(ov.x), bf_lo(ov.y), bf_hi(ov.y), bf_lo(ov.z), bf_hi(ov.z), bf_lo(ov.w), bf_hi(ov.w)}; \
                float ss = 0.f; _Pragma("unroll") for (int j = 0; j < 8; ++j) ss += o[j] * o[j]; \
                ss = sum16(ss); \
                const float rs = rsqrtf(ss * (1.f / 128.f) + EPS); const u32x4 zv = zs[q]; \
                const float z[8] = {bf_lo(zv.x), bf_hi(zv.x), bf_lo(zv.y), bf_hi(zv.y), bf_lo(zv.z), bf_hi(zv.z), bf_lo(zv.w), bf_hi(zv.w)}; \
                u32x4 w; w.x = pk2(o[0] * rs * z[0], o[1] * rs * z[1]); w.y = pk2(o[2] * rs * z[2], o[3] * rs * z[3]); \
                w.z = pk2(o[4] * rs * z[4], o[5] * rs * z[5]); w.w = pk2(o[6] * rs * z[6], o[7] * rs * z[7]); \
                __builtin_amdgcn_raw_buffer_store_b128(w, mxrs, moff, (unsigned)((k) * 64 + 4 * q) * 2048u, 16); asm volatile("" ::: "memory"); } } while (0)
        SC_LD(sc, 0); SC_WR(sc, 0); SC_LD(sa, 1); SC_LD(sb, 2); SC_LD(sc, 3); SC_ZLD(za, 0);
        SC_BAR();
#define SC_PUB(lv) do { asm volatile("s_waitcnt vmcnt(0)" ::: "memory"); if (lane == 0) __hip_atomic_fetch_add(prog + (lv), 1u, __ATOMIC_RELAXED, __HIP_MEMORY_SCOPE_AGENT); } while (0)
#define SC_LSTEP(n, set, zs, WR, LD, GT, ZL) do { \
            if ((n) == 37 || (n) == 57 || (n) == 61) SC_PUB((n) == 37 ? 0 : ((n) == 57 ? 1 : 2));        \
            if (WR) SC_WR(set, (n) + 1); \
            if (LD) SC_LD(set, (n) + 4); \
            if (GT) SC_GATE(zs, (n) - 1); \
            if (ZL) SC_ZLD(zs, (n) + 1); \
            SC_BAR(); } while (0)
        SC_LSTEP(0, sa, zb, true, true, false, true); SC_LSTEP(1, sb, za, true, true, true, true); SC_LSTEP(2, sc, zb, true, true, true, true);
        for (int n = 3; n < NCH - 7; n += 6) {
            SC_LSTEP(n, sa, za, true, true, true, true); SC_LSTEP(n + 1, sb, zb, true, true, true, true); SC_LSTEP(n + 2, sc, za, true, true, true, true);
            SC_LSTEP(n + 3, sa, zb, true, true, true, true); SC_LSTEP(n + 4, sb, za, true, true, true, true); SC_LSTEP(n + 5, sc, zb, true, true, true, true); }
        SC_LSTEP(57, sa, za, true, true, true, true); SC_LSTEP(58, sb, zb, true, true, true, true); SC_LSTEP(59, sc, za, true, true, true, true);
        SC_LSTEP(60, sa, zb, true, false, true, true); SC_LSTEP(61, sb, za, true, false, true, true); SC_LSTEP(62, sc, zb, true, false, true, true);
        SC_LSTEP(63, sa, za, false, false, true, false);
        SC_LSTEP(64, sb, zb, false, false, true, false);
        SC_PUB(3);
#undef SC_PUB
#undef SC_LD
#undef SC_WR
#undef SC_ZLD
#undef SC_GATE
#undef SC_LSTEP
    }
}
}
namespace fk {
namespace cg = cooperative_groups;
#ifndef WGM_P1
#define WGM_P1 4
#endif
#ifndef WGM_P7
#define WGM_P7 4
#endif

struct ProbXW {
    static constexpr int AUXA = 0;
    const char* KB; const char* VB; const char* WXQ; const char* WXO; int lda, ldb, K; int G, c, lim;
    FK_DI bool next(int i, Unit& u) const { const int L = i * G + c; if (L >= lim) return false; u.pm = L; u.pn = 0; return true; }
    FK_DI const char* aptr(const Unit& u) const { const int L = u.pm & 127, b = L >> 4, h = (L >> 2) & 3, q4 = L & 3;
        return (u.pm < 128) ? KB + ((size_t)(b * 256) * 1024 + h * 256) * 2 : WXO + ((size_t)(q4 * 256) * 1024 + h * 256) * 2; }
    FK_DI const char* bptr(const Unit& u) const { const int L = u.pm & 127, b = L >> 4, h = (L >> 2) & 3, q4 = L & 3;
        return (u.pm < 128) ? WXQ + ((size_t)(q4 * 256) * 1024 + h * 256) * 2 : VB + ((size_t)(b * 256) * 1024 + h * 256) * 2; }
};
struct EpiXW {
    static constexpr bool PERM = true;
    bf16_t* WQP; bf16_t* VWP;
    FK_DI void operator()(Acc& acc, const Unit& u, int wr, int wc, int fr, int fq, FK_LAS unsigned char*) const {
        const int L = u.pm & 127, b = L >> 4, h = (L >> 2) & 3, q4 = L & 3;
        bf16_t* base = (u.pm < 128) ? WQP + (size_t)b * 1048576 + (size_t)(h * 256) * 1024 + q4 * 256 : VWP + (size_t)b * 1048576 + (size_t)(q4 * 256) * 1024 + h * 256;
        const int row0 = wr * 64 + fr, col0 = wc * 32 + 8 * fq;
#pragma unroll
        for (int ai = 0; ai < 2; ++ai)
#pragma unroll
            for (int m = 0; m < 4; ++m) { bf16_t* rowp = base + (size_t)(row0 + ai * HALF + m * 16) * 1024 + col0;
#pragma unroll
                for (int bj = 0; bj < 2; ++bj) { const f32x4 v0 = acc[ai][bj][m][0], v1 = acc[ai][bj][m][1];
                    u32x4 w; w.x = pk2(v0[0], v0[1]); w.y = pk2(v0[2], v0[3]); w.z = pk2(v1[0], v1[1]); w.w = pk2(v1[2], v1[3]);
                    *(u32x4*)(rowp + bj * HALF) = w; } }
    }
};

struct ProbOne {
    static constexpr int AUXA = 16;
    const char* A; const char* Bt; int lda, ldb, K; int pm, pn;
    FK_DI bool next(int i, Unit& u) const { if (i) return false; u.pm = pm; u.pn = pn; return true; }
    FK_DI const char* aptr(const Unit& u) const { return A + (size_t)u.pm * 256 * lda * 2; }
    FK_DI const char* bptr(const Unit& u) const { return Bt + (size_t)u.pn * 256 * ldb * 2; }
};

__global__ void __launch_bounds__(512, 2) mega(Params p_arg) {
    PP p = (PP)__builtin_amdgcn_kernarg_segment_ptr();
    extern __shared__ __attribute__((aligned(16))) unsigned char lds_raw[];
    FK_LAS unsigned char* lds = (FK_LAS unsigned char*)lds_raw;
    cg::grid_group grid = cg::this_grid();
    int tid = threadIdx.x, lane = tid & 63; const int wave = __builtin_amdgcn_readfirstlane(tid >> 6);
    const int G = gridDim.x, bid = blockIdx.x, gw = bid * 8 + wave, NGW = G * 8;
#ifndef PHMASK
#define PHMASK 0x3ff
#endif
#define PH(k) (((PHMASK >> (k)) & 1) && p->dbg_lo <= (k) && (k) <= p->dbg_hi)
#ifndef REPMASK
#define REPMASK 0
#endif
#ifdef EXPK
#define TS0(k) if ((k) == EXPK && bid == 0 && tid == 0) *(volatile FK_LAS unsigned long long*)(lds + LDS_TOTAL) = __builtin_amdgcn_s_memrealtime();
#define TS1(k) if ((k) == EXPK && bid == 0 && tid == 0) *(volatile FK_LAS unsigned long long*)(lds + LDS_TOTAL + 8) = __builtin_amdgcn_s_memrealtime();
#else
#define TS0(k)
#define TS1(k)
#endif
#define REPS(k) asm volatile("" : "+s"(p)); unsigned char* ws = p->ws; for (int rep_ = 0; rep_ <= ((REPMASK >> (k)) & 1); ++rep_, ({ asm volatile("" : "+v"(tid), "+v"(lane)); }))
    constexpr bool AL = true, SP = true;
    volatile FK_LAS unsigned* xb_st = (volatile FK_LAS unsigned*)(lds + LDS_TOTAL + 16);
    if (tid < 2) xb_st[tid] = 0u;
    __syncthreads();
    XcdBarrier xb = xcd_barrier_post((unsigned*)(p->ws + WS_BAR), xb_st);
    if (p->dbg_lo == 0x7fffffff) grid.sync();
    { TS0(0) REPS(0) if (PH(0)) { p0_prologue(p, lds, gw, NGW, wave, lane); }
    }
    xcd_barrier(xb);
    TS1(0)
    { TS0(1) REPS(1) if (PH(1)) {
        { ProbStd S{(const char*)p->out + DO_XN, (const char*)(ws + WS_WIN_T), D, D, D, 0}; S.T.init(M / 256, N1 / 256, G, bid, WGM_P1);
          EpiBf16Split E{(bf16_t*)(ws + WS_QKV), (bf16_t*)((unsigned char*)p->out + DO_Z), (bf16_t*)(ws + WS_SC), 6, 8, 1536, 512, 1024, 10, p->in[7]};
          gemm_phase<EpiBf16Split, ProbStd, AL, SP>(lds, S, E); }
        if (bid < 64) { ProbStd S{(const char*)(ws + WS_MEMN), (const char*)(ws + WS_WXK_T), D, D, D, 0}; S.T.init(8, 8, G, bid);
          EpiBf16Split E{(bf16_t*)(ws + WS_KV), (bf16_t*)(ws + WS_KV) + (size_t)2048 * 1024, nullptr, 4, 8, 1024, 1024, 1024, 1 << 30, nullptr};
          gemm_phase<EpiBf16Split, ProbStd, AL, SP>(lds, S, E); }
        else late_weights(p, lds, (bid - 64) * 8 + wave, (G - 64) * 8, wave, lane);
    }
    }
    xcd_barrier(xb);
    TS1(1)
    { TS0(2) TS0(3) REPS(2) if (PH(2)) {
        const int x = bid & 7, w0 = bid - 32, jj = w0 >> 3;
        if (bid < 32) p3_scan(p, lds, bid, tid, wave, lane);
        else if (G == 256 && jj < 24) {
            { const float* cw = p->in[4];
              for (int i = tid; i < 4 * 3 * 4 * 128; i += 512) { const int hh_ = i / 1536, r_ = i % 1536, pt = r_ >> 9, k = (r_ >> 7) & 3, c = r_ & 127; ((FK_LAS float*)(lds + PL_CW))[i] = cw[k * 1536 + pt * 512 + hh_ * 128 + c]; } }
            auto item_of = [](int idx) { return (idx & 31) * 64 + (idx >> 5); };
            P2Raw R; p2_load(p, item_of(w0), tid, lane, R);
            __syncthreads();
            for (int idx = w0; idx < NITEM; idx += 192) { int it = item_of(idx); asm volatile("" : "+s"(it)); const int nx = idx + 192; p2_item(p, lds, it, nx < NITEM ? item_of(nx) : -1, tid, wave, lane, R); }
        } else if (G == 256) {
            for (int vw = (w0 - 192) * 8 + wave; vw < 2048; vw += 32 * 8) p2_short_conv(p, vw, lane);
            asm volatile("s_waitcnt vmcnt(0)" ::: "memory");
            __syncthreads();
            if (tid == 0) __hip_atomic_fetch_add((unsigned*)(ws + WS_PROG) + 32, 1u, __ATOMIC_RELAXED, __HIP_MEMORY_SCOPE_AGENT);
        }
        if (G == 256) {
            for (int r = 0; r < 3; ++r) {
                int t, level;
                if (bid < 32) { if (r > 0) break; t = 60 + (bid >> 3); level = 4; }
                else if (jj >= 24) { t = (jj - 24) + 4 * r; level = 1; }
                else { if (r > 1) break; t = 12 + jj + 24 * r; level = (t >> 2) <= 8 ? 1 : ((t >> 2) <= 13 ? 2 : 3); }
                if (tid == 0) { unsigned* pg = (unsigned*)(ws + WS_PROG); unsigned sp_ = 0;
                    while (__hip_atomic_load(pg + x * 4 + (level - 1), __ATOMIC_RELAXED, __HIP_MEMORY_SCOPE_AGENT) < 16u || __hip_atomic_load(pg + 32, __ATOMIC_RELAXED, __HIP_MEMORY_SCOPE_AGENT) < 32u) { __builtin_amdgcn_s_sleep(8); if (++sp_ > (1u << 21)) break; }
                    __builtin_amdgcn_fence(__ATOMIC_ACQUIRE, "agent"); asm volatile("s_waitcnt vmcnt(0)" ::: "memory"); }
                __syncthreads();
                ProbOne S{(const char*)(ws + WS_MIX), (const char*)(ws + WS_WOUT_T), D, D, D, x * 16 + (t >> 2), t & 3};
                EpiResidB E{p->in[0], nullptr, (bf16_t*)((unsigned char*)p->out + DO_XN), (float*)(ws + WS_SS1)};
                gemm_phase<EpiResidB, ProbOne, AL, SP>(lds, S, E);
            }
            if (bid >= 32 && jj < 24) {
              const bool light = w0 >= 128;
              ProbXW S{(const char*)(ws + WS_KV), (const char*)(ws + WS_KV) + (size_t)2048 * 1024 * 2, (const char*)(ws + WS_WXQ_G), (const char*)(ws + WS_WXO_T), D, D, 256, light ? 64 : 256, light ? w0 - 128 : 128 + w0, light ? 128 : 256};
              EpiXW E{(bf16_t*)(ws + WS_WQP), (bf16_t*)(ws + WS_VWP)};
              gemm_phase<EpiXW, ProbXW, AL, SP>(lds, S, E); }
        }
    }
    }
    xcd_barrier(xb);
    TS1(2) TS1(3)
    { TS0(5) REPS(5) if (PH(5)) { ProbStd S{(const char*)p->out + DO_XN, (const char*)(ws + WS_WQP), D, D, D, (size_t)2 * 1048576}; S.T.init(M / 256, 4, G, bid);
        EpiSoftmax E{(const float*)(ws + WS_SS1), (bf16_t*)(ws + WS_P)};
        gemm_phase<EpiSoftmax, ProbStd, AL, SP>(lds, S, E); }
    }
    xcd_barrier(xb);
    TS1(5)
    { TS0(6) REPS(6) if (PH(6)) { ProbStd S{(const char*)(ws + WS_P), (const char*)(ws + WS_VWP), D, D, D, (size_t)2 * 1048576}; S.T.init(M / 256, 4, G, bid);
        EpiResidB E{nullptr, (const bf16_t*)((const unsigned char*)p->out + DO_XN), (bf16_t*)(ws + WS_HB), (float*)(ws + WS_SS2)};
        gemm_phase<EpiResidB, ProbStd, AL, SP>(lds, S, E); }
    }
    xcd_barrier(xb);
    TS1(6)
    { TS0(7) REPS(7) if (PH(7)) { ProbStd S{(const char*)(ws + WS_HB), (const char*)(ws + WS_WGU_T), D, D, D, 0}; S.T.init(M / 256, 2 * DFF / 256, G, bid, WGM_P7);
        EpiGateUp E{(const float*)(ws + WS_SS2), (bf16_t*)(ws + WS_ACT)};
        gemm_phase<EpiGateUp, ProbStd, AL, SP>(lds, S, E); }
    }
    xcd_barrier(xb);
    TS1(7)
    { TS0(8) REPS(8) if (PH(8)) { ProbStd S{(const char*)(ws + WS_ACT), (const char*)(ws + WS_WDN_T), DFF, DFF, DFF, 0}; S.T.init(M / 256, 4, G, bid);
        EpiFinal E{(const bf16_t*)(ws + WS_HB), p->out, (float*)(ws + WS_SS3), (unsigned*)(ws + WS_PCNT), p->in[21]};
        gemm_phase<EpiFinal, ProbStd, AL, SP>(lds, S, E); }
    }
    TS1(8)
#ifdef EXPK
    if (EXPK == 9) { __syncthreads(); TS1(9) }
    if (bid == 0 && tid == 0) { const unsigned long long ts0_ = *(volatile FK_LAS unsigned long long*)(lds + LDS_TOTAL), ts1_ = *(volatile FK_LAS unsigned long long*)(lds + LDS_TOTAL + 8);
        const unsigned long long te = __builtin_amdgcn_s_memrealtime(), dt = (ts1_ - ts0_) * EXPMULT;
        while (__builtin_amdgcn_s_memrealtime() - te < dt) __builtin_amdgcn_s_sleep(32); }
#endif
#undef PH
}

static int launch_mega(void* const* d_in, void* d_out, void* d_ws, size_t ws_size, hipStream_t stream, int lo, int hi) {
    static int grid_blocks = 0;
    if (!grid_blocks) {
        int dev = 0, cus = 0, per_cu = 0;
        hipGetDevice(&dev); hipDeviceGetAttribute(&cus, hipDeviceAttributeMultiprocessorCount, dev);
        if (hipFuncSetAttribute((const void*)mega, hipFuncAttributeMaxDynamicSharedMemorySize, LDS_TOTAL + 64) != hipSuccess) { fprintf(stderr, "hipFuncSetAttribute failed\n"); grid_blocks = -1; return -1; }
        hipOccupancyMaxActiveBlocksPerMultiprocessor(&per_cu, (const void*)mega, 512, LDS_TOTAL + 64);
        if (per_cu < 1) { fprintf(stderr, "occupancy query says %d blocks/CU\n", per_cu); per_cu = 1; }
        grid_blocks = cus * 1;
        if (ws_size < WS_END) { fprintf(stderr, "ws too small: %zu < %zu\n", ws_size, (size_t)WS_END); grid_blocks = -1; return -1; }
    }
    if (grid_blocks < 0) return -1;
    if (hipMemsetAsync((char*)d_ws + WS_BAR, 0, (WS_FLAGS - WS_BAR) + NITEM * 4 + 512 + 256, stream) != hipSuccess) { fprintf(stderr, "memset of barrier words failed\n"); return -1; }
    Params p{}; for (int i = 0; i < 22; ++i) p.in[i] = (const float*)d_in[i];
    p.out = (float*)d_out; p.ws = (unsigned char*)d_ws; p.dbg_lo = lo; p.dbg_hi = hi;
    void* args[] = {&p};
    hipError_t e = hipLaunchCooperativeKernel((const void*)mega, dim3(grid_blocks), dim3(512), args, LDS_TOTAL + 64, stream);
    if (e != hipSuccess) { fprintf(stderr, "cooperative launch failed: %s (grid %d)\n", hipGetErrorString(e), grid_blocks); return -1; }
    return 0;
}
}
extern "C" void kernel_launch(void* const* d_in, const int* in_sizes, int n_in, void* d_out, int out_size, void* d_ws, size_t ws_size, hipStream_t stream) {
    fk::launch_mega(d_in, d_out, d_ws, ws_size, stream, 0, 99);
}
```

```cpp
#include <hip/hip_runtime.h>
#include <hip/hip_cooperative_groups.h>
#include <cstdio>
namespace fk {
#define FK_LAS __attribute__((address_space(3)))
#define FK_DI __device__ __forceinline__
typedef unsigned short bf16_t;
typedef short bf16x8 __attribute__((ext_vector_type(8)));
typedef float f32x2 __attribute__((ext_vector_type(2)));
typedef float f32x4 __attribute__((ext_vector_type(4)));
typedef float f32x16 __attribute__((ext_vector_type(16)));
typedef unsigned u32x2 __attribute__((ext_vector_type(2)));
typedef unsigned u32x4 __attribute__((ext_vector_type(4)));
typedef __bf16 bf16v2 __attribute__((ext_vector_type(2)));

constexpr int M = 32768, D = 1024, SEQ = 4096, NB = 8, DFF = 2816, N1 = 3584, INC = 3592, NCH = 64  , NITEM = NB * 4 * NCH;
constexpr float EPS = 1e-6f;

FK_DI unsigned pk2(float lo, float hi) { f32x2 v = {lo, hi}; bf16v2 r = __builtin_convertvector(v, bf16v2); return __builtin_bit_cast(unsigned, r); }
FK_DI float bf_lo(unsigned u) { return __uint_as_float(u << 16); }
FK_DI float bf_hi(unsigned u) { return __uint_as_float(u & 0xffff0000u); }
FK_DI float silu(float x) { return x * __builtin_amdgcn_rcpf(1.f + __expf(-x)); }
template <int CTRL> FK_DI float dpp_mov(float v) { return __builtin_bit_cast(float, __builtin_amdgcn_update_dpp(0, __builtin_bit_cast(int, v), CTRL, 0xF, 0xF, true)); }
FK_DI float sum8(float v) { v += dpp_mov<0xB1>(v); v += dpp_mov<0x4E>(v); v += dpp_mov<0x141>(v); return v; }
FK_DI float sum16(float v) { v = sum8(v); v += dpp_mov<0x140>(v); return v; }
FK_DI float wave_sum(float v) {
    v = sum16(v);
    const float r0 = __builtin_bit_cast(float, __builtin_amdgcn_readlane(__builtin_bit_cast(int, v), 0)), r1 = __builtin_bit_cast(float, __builtin_amdgcn_readlane(__builtin_bit_cast(int, v), 16));
    const float r2 = __builtin_bit_cast(float, __builtin_amdgcn_readlane(__builtin_bit_cast(int, v), 32)), r3 = __builtin_bit_cast(float, __builtin_amdgcn_readlane(__builtin_bit_cast(int, v), 48));
    return (r0 + r1) + (r2 + r3);
}

constexpr size_t MiB = 1u << 20;
constexpr size_t WS_WIN_T = 0;
constexpr size_t WS_WOUT_T = 7 * MiB;
constexpr size_t WS_WXQ_G = 9 * MiB;
constexpr size_t WS_WXK_T = 11 * MiB;
constexpr size_t WS_WXV_T = 13 * MiB;
constexpr size_t WS_WXO_T = 15 * MiB;
constexpr size_t WS_WGU_T = 17 * MiB;
constexpr size_t WS_WDN_T = 28 * MiB;
constexpr size_t WS_WQP = 34 * MiB;
constexpr size_t WS_VWP = 50 * MiB;
constexpr size_t WS_MEMN = 66 * MiB;
constexpr size_t WS_KV = 70 * MiB;
constexpr size_t WS_GB = 78 * MiB;
constexpr size_t WS_SS1 = 79 * MiB, WS_SS2 = 81 * MiB, WS_SS3 = 83 * MiB;
constexpr size_t WS_GL = 85 * MiB;
constexpr size_t WS_BAR = 85 * MiB + 65536;
constexpr size_t WS_FLAGS = 85 * MiB + 131072;
constexpr size_t WS_PCNT = WS_FLAGS + 8192;
constexpr size_t WS_PROG = WS_PCNT + 512;
constexpr size_t WS_QKV = 86 * MiB;
constexpr size_t WS_SC = 182 * MiB;
constexpr size_t WS_CHUNK = 278 * MiB;
constexpr size_t WS_MIX = 422 * MiB;
constexpr size_t WS_END = 486 * MiB;
constexpr size_t WS_ORAW = WS_QKV;
constexpr size_t WS_HB = WS_QKV;
constexpr size_t WS_P = WS_SC;
constexpr size_t WS_ACT = 246 * MiB;
constexpr size_t DO_XN = 0, DO_Z = 64 * MiB;
constexpr int CH_WF = 0, CH_KDF = 16384, CH_QDF = 32768, CH_ATF = 49152, CH_UC = 57344, CH_BYTES = 73728;

struct Params {
    const float* in[22];
    float* out; unsigned char* ws;
    int dbg_lo, dbg_hi;
};
typedef const __attribute__((address_space(4))) Params* PP;
}
namespace fk {
#define XB_TMO      128
#define XB_XCNT(j)  (256  + 64 * (j))
#define XB_XSUB(j)  (1280 + 64 * (j))
#define XB_XGEN(j)  (2304 + 64 * (j))
#define XB_TOP      3328
#define XB_TOPGEN   3392
#define XCD_BAR_WORDS 3456
#define XB_SPIN_CAP (1u << 18)

__device__ __forceinline__ unsigned xb_ld(unsigned* p)              { return __hip_atomic_load(p, __ATOMIC_RELAXED, __HIP_MEMORY_SCOPE_AGENT); }
__device__ __forceinline__ unsigned xb_add(unsigned* p, unsigned v) { return __hip_atomic_fetch_add(p, v, __ATOMIC_RELAXED, __HIP_MEMORY_SCOPE_AGENT); }
__device__ __forceinline__ unsigned xb_xcc_id() { return (unsigned)__builtin_amdgcn_s_getreg((3 << 11) | 20) & 0xFu; }
#define XB_SPIN(cond, bar) do { unsigned _sp = 0; while (cond) { __builtin_amdgcn_s_sleep(1); \
    if ((++_sp & 255u) == 0u) { if (xb_ld(&(bar)[XB_TMO])) break; if (_sp > XB_SPIN_CAP) { atomicAdd(&(bar)[XB_TMO], 1u); break; } } } } while (0)

struct XcdBarrier {
    unsigned* bar; unsigned x;
    volatile FK_LAS unsigned* st;
};

__device__ __forceinline__ XcdBarrier xcd_barrier_post(unsigned* bar, volatile FK_LAS unsigned* st) {
    XcdBarrier b; b.bar = bar; b.x = xb_xcc_id(); b.st = st;
    if (threadIdx.x == 0) (void)xb_add(&bar[XB_XCNT(b.x)], 1u);
    return b;
}
__device__ __forceinline__ void xcd_barrier_complete(unsigned* bar, unsigned x, unsigned& nloc, unsigned& nx) {
    const unsigned G = gridDim.x * gridDim.y * gridDim.z;
    unsigned sum, cnt, mine, sp = 0u;
    for (;;) {
        sum = 0u; cnt = 0u; mine = 0u;
#pragma unroll
        for (unsigned j = 0; j < 16; ++j) { const unsigned c = xb_ld(&bar[XB_XCNT(j)]); sum += c; cnt += (c > 0u) ? 1u : 0u; mine = (j == x) ? c : mine; }
        if (sum == G) break;
        __builtin_amdgcn_s_sleep(1);
        if ((++sp & 255u) == 0u) { if (xb_ld(&bar[XB_TMO])) break; if (sp > XB_SPIN_CAP) { atomicAdd(&bar[XB_TMO], 1u); break; } }
    }
    nloc = mine > 0u ? mine : 1u; nx = cnt > 0u ? cnt : 1u;
}

__device__ __forceinline__ void xcd_barrier(const XcdBarrier& b) {
    asm volatile("s_waitcnt vmcnt(0)" ::: "memory");
    __syncthreads();
    if (threadIdx.x == 0) {
        unsigned* bar = b.bar;
        __builtin_amdgcn_s_waitcnt(0);
        unsigned nloc = b.st[0], nx = b.st[1];
        if (nloc == 0u) { xcd_barrier_complete(bar, b.x, nloc, nx); b.st[0] = nloc; b.st[1] = nx; }
        const unsigned old = xb_add(&bar[XB_XSUB(b.x)], 1u);
        const unsigned gen = old / nloc;
        if (old + 1u == (gen + 1u) * nloc) {
            __builtin_amdgcn_fence(__ATOMIC_RELEASE, "agent");
            asm volatile("s_waitcnt vmcnt(0)" ::: "memory");
            const unsigned og = xb_add(&bar[XB_TOP], 1u);
            const unsigned tg = og / nx;
            if (og + 1u == (tg + 1u) * nx) xb_add(&bar[XB_TOPGEN], 1u);
            else XB_SPIN(xb_ld(&bar[XB_TOPGEN]) == tg, bar);
            __builtin_amdgcn_fence(__ATOMIC_ACQUIRE, "agent");
            xb_add(&bar[XB_XGEN(b.x)], 1u);
            asm volatile("s_waitcnt vmcnt(0)" ::: "memory");
        } else {
            XB_SPIN(xb_ld(&bar[XB_XGEN(b.x)]) == gen, bar);
            __builtin_amdgcn_fence(__ATOMIC_ACQUIRE, "agent");
            asm volatile("s_waitcnt vmcnt(0)" ::: "memory");
        }
    }
    __syncthreads();
}

}
namespace fk {
#ifndef GEMM_WGM
#define GEMM_WGM 4
#endif
constexpr int BM = 256, BK = 64, HALF = 128, HTB = HALF * BK * 2, STAGE_BYTES = 8 * HTB, NXCD = 8, WGM = GEMM_WGM;
constexpr int LDS_EXCH = STAGE_BYTES;
constexpr int LDS_TOTAL = STAGE_BYTES + 16384;

FK_DI int lds_byte(int r, int c) { const int st = (r >> 4) * 2 + (c >> 5), rr = r & 15, cc = c & 31, ob = rr * 64 + cc * 2; return st * 1024 + (ob ^ (((ob >> 9) & 1) << 5)); }
FK_DI void stage_rc(int b, int& R, int& C) { const int st = b / 1024, sb = b % 1024, swz = sb ^ (((sb >> 9) & 1) << 5); R = (st >> 1) * 16 + swz / 64; C = (st & 1) * 32 + (swz % 64) / 2; }
FK_DI int perm32(int rho) { const int n = rho >> 4, i = rho & 15; return 8 * (i >> 2) + 4 * n + (i & 3); }

struct Unit { int pm, pn; };

struct TileOrder {
    int nM, nN, nwg, G, c, wgm;
    FK_DI void init(int nM_, int nN_, int G_, int c_, int wgm_ = WGM) { nM = nM_; nN = nN_; nwg = nM * nN; G = G_; c = c_; wgm = wgm_; }
    FK_DI bool next(int i, Unit& u) const {
        const long L = (long)i * G + c; if (L >= nwg) return false;
        int wgid = (int)L; { const int q = nwg / NXCD, r = nwg % NXCD, xcd = wgid % NXCD, off = wgid / NXCD; wgid = (xcd < r ? xcd * (q + 1) : r * (q + 1) + (xcd - r) * q) + off; }
        const int nig = wgm * nN, gid = wgid / nig, fm = gid * wgm, gsz = (nM - fm) < wgm ? (nM - fm) : wgm;
        u.pm = fm + ((wgid % nig) % gsz); u.pn = (wgid % nig) / gsz; return true;
    }
};
struct ProbStd {
    static constexpr int AUXA = 0;
    const char* A; const char* Bt; int lda, ldb, K; size_t b_bstride; TileOrder T;
    FK_DI bool next(int i, Unit& u) const { return T.next(i, u); }
    FK_DI const char* aptr(const Unit& u) const { return A + (size_t)u.pm * 256 * lda * 2; }
    FK_DI const char* bptr(const Unit& u) const { return Bt + (size_t)u.pn * 256 * ldb * 2 + (size_t)(u.pm >> 4) * b_bstride; }
};

typedef f32x4 Acc[2][2][4][2];

template <class Epi, class Prob, bool ALIGN_EPI, bool SP2>
FK_DI void gemm_phase(FK_LAS unsigned char* lds, const Prob& S, const Epi& E) {
    int tid = threadIdx.x; asm volatile("" : "+v"(tid));
    const int wid = __builtin_amdgcn_readfirstlane(tid >> 6), lane = tid & 63, wr = wid >> 2, wc = wid & 3, fr = lane & 15, fq = lane >> 4;
    const int K = S.K, nt = K / BK, lda = S.lda, ldb = S.ldb;
    unsigned voffA[2], voffB[2];
#pragma unroll
    for (int i = 0; i < 2; ++i) { int R, C; stage_rc(tid * 16 + i * 8192, R, C); const int Rb = Epi::PERM ? ((R & ~31) + perm32(R & 31)) : R;
        voffA[i] = (unsigned)(R * lda + C) * 2u; voffB[i] = (unsigned)(Rb * ldb + C) * 2u; }
    const size_t kstep = (size_t)(BK * 2);
    const size_t hstepA = (size_t)HALF * lda * 2, hstepB = (size_t)HALF * ldb * 2;
    const unsigned ldsw = (unsigned)wid * 1024u;
    const int aoff = lds_byte(wr * 64 + fr, fq * 8), boff = lds_byte(wc * 32 + fr, fq * 8);
#define PG8_SA(b, h) (((b) * 2 + (h)) * HTB)
#define PG8_SB(b, h) ((4 + (b) * 2 + (h)) * HTB)
#define PG8_STAGE(bufoff, gbase, voff) do { _Pragma("unroll") for (int _i = 0; _i < 2; ++_i) \
        __builtin_amdgcn_global_load_lds((const unsigned*)((const char*)(gbase) + (voff)[_i]), (FK_LAS unsigned*)(lds + (bufoff) + ldsw + _i * 8192), 16, 0, 0); } while (0)
#define PG8_STAGEA(bufoff, gbase, voff) do { _Pragma("unroll") for (int _i = 0; _i < 2; ++_i) \
        __builtin_amdgcn_global_load_lds((const unsigned*)((const char*)(gbase) + (voff)[_i]), (FK_LAS unsigned*)(lds + (bufoff) + ldsw + _i * 8192), 16, 0, Prob::AUXA); } while (0)
#define PG8_LDA(dst, b, h) do { _Pragma("unroll") for (int m = 0; m < 4; ++m) _Pragma("unroll") for (int k = 0; k < 2; ++k) dst[m][k] = *(const FK_LAS bf16x8*)(lds + PG8_SA(b, h) + aoff + m * 2048 + k * 1024); } while (0)
#define PG8_LDB(dst, b, h) do { _Pragma("unroll") for (int n = 0; n < 2; ++n) _Pragma("unroll") for (int k = 0; k < 2; ++k) dst[n][k] = *(const FK_LAS bf16x8*)(lds + PG8_SB(b, h) + boff + n * 2048 + k * 1024); } while (0)
#define PG8_MMA(ai, bj, At, Bt) do { __builtin_amdgcn_s_setprio(1); _Pragma("unroll") for (int m = 0; m < 4; ++m) _Pragma("unroll") for (int n = 0; n < 2; ++n) _Pragma("unroll") for (int k = 0; k < 2; ++k) \
        acc[ai][bj][m][n] = __builtin_amdgcn_mfma_f32_16x16x32_bf16(Bt[n][k], At[m][k], acc[ai][bj][m][n], 0, 0, 0); __builtin_amdgcn_s_setprio(0); } while (0)
#define PG8_WAIT_V(n) asm volatile("s_waitcnt vmcnt(" #n ")" ::: "memory")
#define PG8_WAIT_L(n) asm volatile("s_waitcnt lgkmcnt(" #n ")" ::: "memory")
#define PG8_BAR __builtin_amdgcn_s_barrier()
#define PG8_SCHED __builtin_amdgcn_sched_barrier(0)
    Unit cur, nxt; int ui = 0;
    if (!S.next(0, cur)) return;
    Acc acc;
#pragma unroll
    for (int a = 0; a < 2; ++a)
#pragma unroll
        for (int b = 0; b < 2; ++b)
#pragma unroll
            for (int m = 0; m < 4; ++m)
#pragma unroll
                for (int n = 0; n < 2; ++n) acc[a][b][m][n] = (f32x4){0.f, 0.f, 0.f, 0.f};
    bf16x8 At[4][2], B0[2][2], B1[2][2];
    const char* cA = S.aptr(cur); const char* cB = S.bptr(cur);
    if constexpr (SP2) {
        PG8_STAGE(PG8_SB(0, 0), cB, voffB); PG8_STAGE(PG8_SB(0, 1), cB + hstepB, voffB); PG8_STAGEA(PG8_SA(0, 0), cA, voffA); PG8_STAGEA(PG8_SA(0, 1), cA + hstepA, voffA);
        if (wr == 1) PG8_BAR;
        PG8_WAIT_V(2); PG8_BAR;
        PG8_STAGE(PG8_SB(1, 0), cB + kstep, voffB); PG8_STAGEA(PG8_SA(1, 0), cA + kstep, voffA); PG8_STAGE(PG8_SB(1, 1), cB + hstepB + kstep, voffB);
        PG8_WAIT_V(6); PG8_BAR;
    } else {
        PG8_STAGE(PG8_SB(0, 0), cB, voffB); PG8_STAGEA(PG8_SA(0, 0), cA, voffA); PG8_STAGE(PG8_SB(0, 1), cB + hstepB, voffB); PG8_STAGEA(PG8_SA(0, 1), cA + hstepA, voffA);
        if (wr == 1) PG8_BAR;
        PG8_WAIT_V(4); PG8_BAR;
        PG8_STAGE(PG8_SB(1, 0), cB + kstep, voffB); PG8_STAGEA(PG8_SA(1, 0), cA + kstep, voffA); PG8_STAGE(PG8_SB(1, 1), cB + hstepB + kstep, voffB);
        PG8_WAIT_V(6); PG8_BAR;
    }
    for (;;) {
        const bool has_next = S.next(ui + 1, nxt);
        const char* nA = has_next ? S.aptr(nxt) : cA; const char* nB = has_next ? S.bptr(nxt) : cB;
        for (int t = 0; t < nt; t += 2) {
            const bool last = (t == nt - 2);
            const char* a1 = cA + (size_t)(t + 1) * kstep;
            const char* a2 = last ? nA : cA + (size_t)(t + 2) * kstep; const char* b2 = last ? nB : cB + (size_t)(t + 2) * kstep;
            const char* a3 = a2 + kstep; const char* b3 = b2 + kstep;
            if constexpr (SP2) {
            PG8_LDB(B0, 0, 0); PG8_LDB(B1, 0, 1); PG8_SCHED; PG8_LDA(At, 0, 0); PG8_STAGEA(PG8_SA(1, 1), a1 + hstepA, voffA);
            PG8_WAIT_V(8); PG8_WAIT_L(0); PG8_BAR; PG8_MMA(0, 0, At, B0); PG8_MMA(0, 1, At, B1); PG8_BAR; PG8_SCHED;
            PG8_LDA(At, 0, 1); PG8_STAGE(PG8_SB(0, 0), b2, voffB); PG8_STAGE(PG8_SB(0, 1), b2 + hstepB, voffB); PG8_STAGEA(PG8_SA(0, 0), a2, voffA);
            PG8_WAIT_V(8); PG8_WAIT_L(0); PG8_BAR; PG8_MMA(1, 0, At, B0); PG8_MMA(1, 1, At, B1); PG8_BAR; PG8_SCHED;
            PG8_LDB(B0, 1, 0); PG8_LDB(B1, 1, 1); PG8_SCHED; PG8_LDA(At, 1, 0); PG8_STAGEA(PG8_SA(0, 1), a2 + hstepA, voffA);
            PG8_WAIT_V(8); PG8_WAIT_L(0); PG8_BAR; PG8_MMA(0, 0, At, B0); PG8_MMA(0, 1, At, B1); PG8_BAR; PG8_SCHED;
            PG8_LDA(At, 1, 1); PG8_STAGE(PG8_SB(1, 0), b3, voffB); PG8_STAGE(PG8_SB(1, 1), b3 + hstepB, voffB); PG8_STAGEA(PG8_SA(1, 0), a3, voffA);
            PG8_WAIT_V(8); PG8_WAIT_L(0); PG8_BAR; PG8_MMA(1, 0, At, B0); PG8_MMA(1, 1, At, B1); PG8_BAR; PG8_SCHED;
            } else {
            PG8_LDB(B0, 0, 0); PG8_SCHED; PG8_LDA(At, 0, 0); PG8_STAGEA(PG8_SA(1, 1), a1 + hstepA, voffA);
            PG8_WAIT_L(8); PG8_BAR; PG8_WAIT_L(0); PG8_MMA(0, 0, At, B0); PG8_BAR; PG8_SCHED;
            PG8_LDB(B1, 0, 1); PG8_STAGE(PG8_SB(0, 0), b2, voffB);
            PG8_BAR; PG8_WAIT_L(0); PG8_MMA(0, 1, At, B1); PG8_BAR;
            PG8_LDA(At, 0, 1); PG8_STAGEA(PG8_SA(0, 0), a2, voffA);
            PG8_BAR; PG8_WAIT_L(0); PG8_MMA(1, 0, At, B0); PG8_BAR; PG8_SCHED;
            PG8_STAGE(PG8_SB(0, 1), b2 + hstepB, voffB);
            PG8_WAIT_V(6); PG8_BAR; PG8_MMA(1, 1, At, B1); PG8_BAR;
            PG8_LDB(B0, 1, 0); PG8_SCHED; PG8_LDA(At, 1, 0); PG8_STAGEA(PG8_SA(0, 1), a2 + hstepA, voffA);
            PG8_WAIT_L(8); PG8_BAR; PG8_WAIT_L(0); PG8_MMA(0, 0, At, B0); PG8_BAR; PG8_SCHED;
            PG8_LDB(B1, 1, 1); PG8_STAGE(PG8_SB(1, 0), b3, voffB);
            PG8_BAR; PG8_WAIT_L(0); PG8_MMA(0, 1, At, B1); PG8_BAR;
            PG8_LDA(At, 1, 1); PG8_STAGEA(PG8_SA(1, 0), a3, voffA);
            PG8_BAR; PG8_WAIT_L(0); PG8_MMA(1, 0, At, B0); PG8_BAR; PG8_SCHED;
            PG8_STAGE(PG8_SB(1, 1), b3 + hstepB, voffB);
            PG8_WAIT_V(6); PG8_BAR; PG8_MMA(1, 1, At, B1); PG8_BAR;
            }
        }
        if constexpr (ALIGN_EPI) { if (wr == 0) PG8_BAR; }
        E(acc, cur, wr, wc, fr, fq, lds);
        if (!has_next) break;
#pragma unroll
        for (int a = 0; a < 2; ++a)
#pragma unroll
            for (int b = 0; b < 2; ++b)
#pragma unroll
                for (int m = 0; m < 4; ++m)
#pragma unroll
                    for (int n = 0; n < 2; ++n) acc[a][b][m][n] = (f32x4){0.f, 0.f, 0.f, 0.f};
        cur = nxt; cA = nA; cB = nB; ++ui;
        if constexpr (ALIGN_EPI) { if (wr == 1) PG8_BAR; }
    }
    PG8_WAIT_V(0);
    if constexpr (!ALIGN_EPI) { if (wr == 0) PG8_BAR; }
    PG8_BAR;
#undef PG8_SA
#undef PG8_SB
#undef PG8_STAGE
#undef PG8_STAGEA
#undef PG8_LDA
#undef PG8_LDB
#undef PG8_MMA
#undef PG8_WAIT_V
#undef PG8_WAIT_L
#undef PG8_BAR
#undef PG8_SCHED
}

struct EpiBf16Split {
    static constexpr bool PERM = true;
    bf16_t* o0; bf16_t* o1; bf16_t* o2; int t1, t2;
    int ld0, ld1, ld2;
    int t3;
    const float* gz;
    FK_DI void operator()(Acc& acc, const Unit& u, int wr, int wc, int fr, int fq, FK_LAS unsigned char*) const {
        bf16_t* base; int ld, ct; bool gate = false;
        if (u.pn < t1) { base = o0; ld = ld0; ct = u.pn; } else if (u.pn < t2) { base = o1; ld = ld1; ct = u.pn - t1; gate = (gz != nullptr); } else { base = o2; ld = ld2; ct = u.pn - t2; }
        const int row0 = u.pm * BM + wr * 64 + fr, col0 = ct * BM + wc * 32 + 8 * fq;
        if (u.pn >= t3) {
#pragma unroll
            for (int ai = 0; ai < 2; ++ai)
#pragma unroll
                for (int m = 0; m < 4; ++m) { const f32x4 v0 = acc[ai][0][m][0] * acc[ai][1][m][0], v1 = acc[ai][0][m][1] * acc[ai][1][m][1];
                    u32x4 w; w.x = pk2(v0[0], v0[1]); w.y = pk2(v0[2], v0[3]); w.z = pk2(v1[0], v1[1]); w.w = pk2(v1[2], v1[3]);
                    *(u32x4*)(o2 + (size_t)(row0 + ai * HALF + m * 16) * ld2 + 512 + (u.pn - t3) * HALF + wc * 32 + 8 * fq) = w; }
            return;
        }
        if (gate) {
            const f32x4 g0 = *(const f32x4*)(gz + (col0 & 127)), g1 = *(const f32x4*)(gz + (col0 & 127) + 4);
#pragma unroll
            for (int ai = 0; ai < 2; ++ai)
#pragma unroll
                for (int m = 0; m < 4; ++m)
#pragma unroll
                    for (int bj = 0; bj < 2; ++bj) { f32x4 v0 = acc[ai][bj][m][0], v1 = acc[ai][bj][m][1];
#pragma unroll
                        for (int j = 0; j < 4; ++j) { v0[j] = silu(v0[j]) * g0[j]; v1[j] = silu(v1[j]) * g1[j]; }
                        acc[ai][bj][m][0] = v0; acc[ai][bj][m][1] = v1; }
        }
#pragma unroll
        for (int ai = 0; ai < 2; ++ai)
#pragma unroll
            for (int m = 0; m < 4; ++m) { bf16_t* rowp = base + (size_t)(row0 + ai * HALF + m * 16) * ld + col0;
#pragma unroll
                for (int bj = 0; bj < 2; ++bj) { const f32x4 v0 = acc[ai][bj][m][0], v1 = acc[ai][bj][m][1];
                    u32x4 w; w.x = pk2(v0[0], v0[1]); w.y = pk2(v0[2], v0[3]); w.z = pk2(v1[0], v1[1]); w.w = pk2(v1[2], v1[3]);
                    *(u32x4*)(rowp + bj * HALF) = w; } }
    }
};
struct EpiBf16At {
    static constexpr bool PERM = true;
    bf16_t* o; int ld; size_t pm_stride, pn_stride;
    FK_DI void operator()(Acc& acc, const Unit& u, int wr, int wc, int fr, int fq, FK_LAS unsigned char*) const {
        bf16_t* base = o + (size_t)u.pm * pm_stride + (size_t)u.pn * pn_stride;
        const int row0 = wr * 64 + fr, col0 = wc * 32 + 8 * fq;
#pragma unroll
        for (int ai = 0; ai < 2; ++ai)
#pragma unroll
            for (int m = 0; m < 4; ++m) { bf16_t* rowp = base + (size_t)(row0 + ai * HALF + m * 16) * ld + col0;
#pragma unroll
                for (int bj = 0; bj < 2; ++bj) { const f32x4 v0 = acc[ai][bj][m][0], v1 = acc[ai][bj][m][1];
                    u32x4 w; w.x = pk2(v0[0], v0[1]); w.y = pk2(v0[2], v0[3]); w.z = pk2(v1[0], v1[1]); w.w = pk2(v1[2], v1[3]);
                    *(u32x4*)(rowp + bj * HALF) = w; } }
    }
};
struct EpiResid {
    static constexpr bool PERM = false;
    const float* base; float* hout; bf16_t* hb; float* ss;
    FK_DI void operator()(Acc& acc, const Unit& u, int wr, int wc, int fr, int fq, FK_LAS unsigned char*) const {
        const int row0 = u.pm * BM + wr * 64 + fr, col0 = u.pn * BM + wc * 32 + 4 * fq;
#pragma unroll
        for (int ai = 0; ai < 2; ++ai)
#pragma unroll
            for (int m = 0; m < 4; ++m) { const int row = row0 + ai * HALF + m * 16; const size_t off = (size_t)row * D + col0; float s = 0.f;
#pragma unroll
                for (int bj = 0; bj < 2; ++bj)
#pragma unroll
                    for (int n = 0; n < 2; ++n) { const f32x4 bs = *(const f32x4*)(base + off + bj * HALF + n * 16); const f32x4 o = bs + acc[ai][bj][m][n];
                        *(f32x4*)(hout + off + bj * HALF + n * 16) = o; s += (o[0] * o[0] + o[1] * o[1]) + (o[2] * o[2] + o[3] * o[3]);
                        if (hb) { u32x2 w; w.x = pk2(o[0], o[1]); w.y = pk2(o[2], o[3]); *(u32x2*)(hb + off + bj * HALF + n * 16) = w; } }
                s += __shfl_xor(s, 16); s += __shfl_xor(s, 32);
                if (fq == 0) __hip_atomic_fetch_add(ss + row, s, __ATOMIC_RELAXED, __HIP_MEMORY_SCOPE_AGENT);
                asm volatile("" ::: "memory"); }
    }
};

struct EpiResidB {
    static constexpr bool PERM = true;
    const float* xf; const bf16_t* hb_in; bf16_t* hb_out; float* ss;
    FK_DI void operator()(Acc& acc, const Unit& u, int wr, int wc, int fr, int fq, FK_LAS unsigned char*) const {
        const int row0 = u.pm * BM + wr * 64 + fr, col0 = u.pn * BM + wc * 32 + 8 * fq;
#pragma unroll
        for (int ai = 0; ai < 2; ++ai)
#pragma unroll
            for (int m = 0; m < 4; ++m) { const int row = row0 + ai * HALF + m * 16; const size_t off = (size_t)row * D + col0; float s = 0.f;
#pragma unroll
                for (int bj = 0; bj < 2; ++bj) { f32x4 b0, b1;
                    if (xf) { b0 = *(const f32x4*)(xf + off + bj * HALF); b1 = *(const f32x4*)(xf + off + bj * HALF + 4); }
                    else { const u32x4 hv = *(const u32x4*)(hb_in + off + bj * HALF); b0 = (f32x4){bf_lo(hv.x), bf_hi(hv.x), bf_lo(hv.y), bf_hi(hv.y)}; b1 = (f32x4){bf_lo(hv.z), bf_hi(hv.z), bf_lo(hv.w), bf_hi(hv.w)}; }
                    const f32x4 o0 = b0 + acc[ai][bj][m][0], o1 = b1 + acc[ai][bj][m][1];
                    s += ((o0[0] * o0[0] + o0[1] * o0[1]) + (o0[2] * o0[2] + o0[3] * o0[3])) + ((o1[0] * o1[0] + o1[1] * o1[1]) + (o1[2] * o1[2] + o1[3] * o1[3]));
                    u32x4 w; w.x = pk2(o0[0], o0[1]); w.y = pk2(o0[2], o0[3]); w.z = pk2(o1[0], o1[1]); w.w = pk2(o1[2], o1[3]);
                    *(u32x4*)(hb_out + off + bj * HALF) = w; }
                s += __shfl_xor(s, 16); s += __shfl_xor(s, 32);
                if (fq == 0) __hip_atomic_fetch_add(ss + row, s, __ATOMIC_RELAXED, __HIP_MEMORY_SCOPE_AGENT);
                asm volatile("" ::: "memory"); }
    }
};

struct EpiFinal {
    static constexpr bool PERM = true;
    const bf16_t* hb_in; float* out; float* ss; unsigned* cnt; const float* gfin;
    FK_DI void operator()(Acc& acc, const Unit& u, int wr, int wc, int fr, int fq, FK_LAS unsigned char*) const {
        const int row0 = u.pm * BM + wr * 64 + fr, col0 = u.pn * BM + wc * 32 + 8 * fq;
#pragma unroll
        for (int ai = 0; ai < 2; ++ai)
#pragma unroll
            for (int m = 0; m < 4; ++m) { const int row = row0 + ai * HALF + m * 16; const size_t off = (size_t)row * D + col0; float s = 0.f;
#pragma unroll
                for (int bj = 0; bj < 2; ++bj) { const u32x4 hv = *(const u32x4*)(hb_in + off + bj * HALF);
                    const f32x4 o0 = (f32x4){bf_lo(hv.x), bf_hi(hv.x), bf_lo(hv.y), bf_hi(hv.y)} + acc[ai][bj][m][0], o1 = (f32x4){bf_lo(hv.z), bf_hi(hv.z), bf_lo(hv.w), bf_hi(hv.w)} + acc[ai][bj][m][1];
                    acc[ai][bj][m][0] = o0; acc[ai][bj][m][1] = o1;
                    s += ((o0[0] * o0[0] + o0[1] * o0[1]) + (o0[2] * o0[2] + o0[3] * o0[3])) + ((o1[0] * o1[0] + o1[1] * o1[1]) + (o1[2] * o1[2] + o1[3] * o1[3])); }
                s += __shfl_xor(s, 16); s += __shfl_xor(s, 32);
                if (fq == 0) __hip_atomic_fetch_add(ss + row, s, __ATOMIC_RELAXED, __HIP_MEMORY_SCOPE_AGENT);
                asm volatile("" ::: "memory"); }
        asm volatile("s_waitcnt vmcnt(0)" ::: "memory"); __builtin_amdgcn_s_barrier(); asm volatile("" ::: "memory");
        if (threadIdx.x == 0) __hip_atomic_fetch_add(cnt + u.pm, 1u, __ATOMIC_RELAXED, __HIP_MEMORY_SCOPE_AGENT);
        { unsigned sp_ = 0; while ((unsigned)__builtin_amdgcn_readfirstlane(__hip_atomic_load(cnt + u.pm, __ATOMIC_RELAXED, __HIP_MEMORY_SCOPE_AGENT)) < 4u) { __builtin_amdgcn_s_sleep(2); if (++sp_ > (1u << 22)) break; } }
        float rsv[8];
#pragma unroll
        for (int q = 0; q < 8; ++q) rsv[q] = __uint_as_float(__hip_atomic_load((const unsigned*)ss + row0 + (q >> 2) * HALF + (q & 3) * 16, __ATOMIC_RELAXED, __HIP_MEMORY_SCOPE_AGENT));
        f32x4 gv[2][2];
#pragma unroll
        for (int bj = 0; bj < 2; ++bj) { gv[bj][0] = *(const f32x4*)(gfin + col0 + bj * HALF); gv[bj][1] = *(const f32x4*)(gfin + col0 + bj * HALF + 4); }
#pragma unroll
        for (int ai = 0; ai < 2; ++ai)
#pragma unroll
            for (int m = 0; m < 4; ++m) { const int row = row0 + ai * HALF + m * 16; const float rs = rsqrtf(rsv[ai * 4 + m] * (1.f / 1024.f) + EPS); float* op = out + (size_t)row * D + col0;
#pragma unroll
                for (int bj = 0; bj < 2; ++bj) { *(f32x4*)(op + bj * HALF) = acc[ai][bj][m][0] * rs * gv[bj][0]; *(f32x4*)(op + bj * HALF + 4) = acc[ai][bj][m][1] * rs * gv[bj][1]; } }
    }
};
FK_DI float row_rstd(const float* ss, int row) { return rsqrtf(ss[row] * (1.f / 1024.f) + EPS); }
struct EpiSoftmax {
    static constexpr bool PERM = true;
    const float* ss; bf16_t* P;
    FK_DI void operator()(Acc& acc, const Unit& u, int wr, int wc, int fr, int fq, FK_LAS unsigned char* lds) const {
        FK_LAS f32x2* X = (FK_LAS f32x2*)(lds + LDS_EXCH);
        const int row0 = u.pm * BM + wr * 64 + fr;
        float rsv[8];
#pragma unroll
        for (int q = 0; q < 8; ++q) rsv[q] = ss[row0 + (q >> 2) * HALF + (q & 3) * 16];
#pragma unroll
        for (int ai = 0; ai < 2; ++ai)
#pragma unroll
            for (int m = 0; m < 4; ++m) { const int rl = ai * HALF + wr * 64 + m * 16 + fr; const float rs = rsqrtf(rsv[ai * 4 + m] * (1.f / 1024.f) + EPS);
                float mx = -3.0e38f;
#pragma unroll
                for (int bj = 0; bj < 2; ++bj)
#pragma unroll
                    for (int n = 0; n < 2; ++n) { f32x4 v = acc[ai][bj][m][n] * rs; acc[ai][bj][m][n] = v; mx = fmaxf(fmaxf(mx, fmaxf(v[0], v[1])), fmaxf(v[2], v[3])); }
                mx = fmaxf(mx, __shfl_xor(mx, 16)); mx = fmaxf(mx, __shfl_xor(mx, 32));
                float sm = 0.f;
#pragma unroll
                for (int bj = 0; bj < 2; ++bj)
#pragma unroll
                    for (int n = 0; n < 2; ++n) { f32x4 v = acc[ai][bj][m][n];
#pragma unroll
                        for (int j = 0; j < 4; ++j) { v[j] = __expf(v[j] - mx); sm += v[j]; }
                        acc[ai][bj][m][n] = v; }
                sm += __shfl_xor(sm, 16); sm += __shfl_xor(sm, 32);
                if (fq == 0) X[rl * 4 + wc] = (f32x2){mx, sm};
            }
        asm volatile("s_waitcnt lgkmcnt(0)" ::: "memory"); __builtin_amdgcn_s_barrier(); asm volatile("" ::: "memory");
#pragma unroll
        for (int ai = 0; ai < 2; ++ai)
#pragma unroll
            for (int m = 0; m < 4; ++m) { const int rl = ai * HALF + wr * 64 + m * 16 + fr;
                const f32x2 x0 = X[rl * 4 + 0], x1 = X[rl * 4 + 1], x2 = X[rl * 4 + 2], x3 = X[rl * 4 + 3];
                const float Mx = fmaxf(fmaxf(x0.x, x1.x), fmaxf(x2.x, x3.x));
                const float tot = x0.y * __expf(x0.x - Mx) + x1.y * __expf(x1.x - Mx) + x2.y * __expf(x2.x - Mx) + x3.y * __expf(x3.x - Mx);
                const float mine = wc == 0 ? x0.x : (wc == 1 ? x1.x : (wc == 2 ? x2.x : x3.x));
                const float sc = __expf(mine - Mx) * __builtin_amdgcn_rcpf(tot);
                bf16_t* rowp = P + (size_t)(row0 + ai * HALF + m * 16) * D + u.pn * BM + wc * 32 + 8 * fq;
#pragma unroll
                for (int bj = 0; bj < 2; ++bj) { const f32x4 v0 = acc[ai][bj][m][0] * sc, v1 = acc[ai][bj][m][1] * sc;
                    u32x4 w; w.x = pk2(v0[0], v0[1]); w.y = pk2(v0[2], v0[3]); w.z = pk2(v1[0], v1[1]); w.w = pk2(v1[2], v1[3]);
                    *(u32x4*)(rowp + bj * HALF) = w; } }
        asm volatile("s_waitcnt lgkmcnt(0)" ::: "memory"); __builtin_amdgcn_s_barrier(); asm volatile("" ::: "memory");
    }
};
struct EpiGateUp {
    static constexpr bool PERM = true;
    const float* ss; bf16_t* act;
    FK_DI void operator()(Acc& acc, const Unit& u, int wr, int wc, int fr, int fq, FK_LAS unsigned char*) const {
        const int row0 = u.pm * BM + wr * 64 + fr, col0 = u.pn * HALF + wc * 32 + 8 * fq;
        float rsv[8];
#pragma unroll
        for (int q = 0; q < 8; ++q) rsv[q] = ss[row0 + (q >> 2) * HALF + (q & 3) * 16];
#pragma unroll
        for (int ai = 0; ai < 2; ++ai)
#pragma unroll
            for (int m = 0; m < 4; ++m) { const int row = row0 + ai * HALF + m * 16; const float rs = rsqrtf(rsv[ai * 4 + m] * (1.f / 1024.f) + EPS);
                u32x4 w;
#pragma unroll
                for (int n = 0; n < 2; ++n) { const f32x4 g = acc[ai][0][m][n] * rs, up = acc[ai][1][m][n] * rs;
                    w[2 * n] = pk2(silu(g[0]) * up[0], silu(g[1]) * up[1]); w[2 * n + 1] = pk2(silu(g[2]) * up[2], silu(g[3]) * up[3]); }
                *(u32x4*)(act + (size_t)row * DFF + col0) = w; }
    }
};
}
namespace fk {
template <class Src>
FK_DI void transpose_item(const Src& src, int ldw, int K, bf16_t* WT, const float* gk, FK_LAS float* scr, int kb, int nb, int lane) {
    const int k0 = 64 * kb, n0 = 32 * nb;
    const float* colp = src(n0 + (lane & 31));
    float vv[32];
#pragma unroll
    for (int i = 0; i < 32; ++i) { const int kk = 2 * i + (lane >> 5); vv[i] = __builtin_nontemporal_load(colp + (size_t)(k0 + kk) * ldw); }
#pragma unroll
    for (int i = 0; i < 32; ++i) { const int kk = 2 * i + (lane >> 5); float v = vv[i]; if (gk) v *= gk[k0 + kk]; scr[kk * 33 + (lane & 31)] = v; }
    asm volatile("s_waitcnt lgkmcnt(0)" ::: "memory");
    const int c = lane & 7;
#pragma unroll
    for (int j = 0; j < 4; ++j) { const int n = (lane >> 3) + 8 * j; const FK_LAS float* s = scr + (8 * c) * 33 + n;
        u32x4 o; o.x = pk2(s[0 * 33], s[1 * 33]); o.y = pk2(s[2 * 33], s[3 * 33]); o.z = pk2(s[4 * 33], s[5 * 33]); o.w = pk2(s[6 * 33], s[7 * 33]);
        *(u32x4*)(WT + (size_t)(n0 + n) * K + k0 + 8 * c) = o; }
    asm volatile("s_waitcnt lgkmcnt(0)" ::: "memory");
}

FK_DI void late_weights(PP p, FK_LAS unsigned char* lds, int gw, int NGW, int wave, int lane) {
    unsigned char* ws = p->ws;
    FK_LAS float* scr = (FK_LAS float*)(lds + wave * 16384);
    const float* w_out = p->in[10]; const float* w_xq = p->in[13]; const float* w_xo = p->in[16]; const float* w_gate = p->in[18]; const float* w_up = p->in[19]; const float* w_down = p->in[20];
    const float* g_x = p->in[11]; const float* g_ffn = p->in[17];
    constexpr int I_SQ = (D / 64) * (D / 32), I_GU = (D / 64) * (2 * DFF / 32), I_DN = (DFF / 64) * (D / 32);
    constexpr int NITEMS = 2 * I_SQ + I_GU + I_DN;
    for (int it = gw; it < NITEMS; it += NGW) {
        int r = it;
        if (r < I_SQ) { auto src = [&](int n) { return w_out + n; }; transpose_item(src, D, D, (bf16_t*)(ws + WS_WOUT_T), (const float*)nullptr, scr, r / 32, r % 32, lane); continue; } r -= I_SQ;
        if (r < I_SQ) { auto src = [&](int n) { return w_xo + n; }; transpose_item(src, D, D, (bf16_t*)(ws + WS_WXO_T), (const float*)nullptr, scr, r / 32, r % 32, lane); continue; } r -= I_SQ;
        if (r < I_GU) { auto src = [&](int n) { const int blk = n >> 8, w = n & 255; return (w < 128 ? w_gate + blk * 128 + w : w_up + blk * 128 + (w - 128)); };
            transpose_item(src, DFF, D, (bf16_t*)(ws + WS_WGU_T), g_ffn, scr, r / (2 * DFF / 32), r % (2 * DFF / 32), lane); continue; } r -= I_GU;
        { auto src = [&](int n) { return w_down + n; }; transpose_item(src, D, DFF, (bf16_t*)(ws + WS_WDN_T), (const float*)nullptr, scr, r / 32, r % 32, lane); }
    }
    for (int k = gw; k < D; k += NGW) { const float sc = g_x[k] * 0.0625f; const f32x4* s = (const f32x4*)(w_xq + (size_t)k * D) + lane; u32x2* o = (u32x2*)((bf16_t*)(ws + WS_WXQ_G) + (size_t)k * D) + lane;
#pragma unroll
        for (int j = 0; j < 4; ++j) { const f32x4 v = s[64 * j] * sc; u32x2 w; w.x = pk2(v[0], v[1]); w.y = pk2(v[2], v[3]); o[64 * j] = w; } }
}

FK_DI void p0_prologue(PP p, FK_LAS unsigned char* lds, int gw, int NGW, int wave, int lane) {
    unsigned char* ws = p->ws;
    FK_LAS float* scr = (FK_LAS float*)(lds + wave * 16384);
    const float* w_in = p->in[3]; const float* w_xk = p->in[14]; const float* w_xv = p->in[15];
    const float* g_mix = p->in[2]; const float* g_mem = p->in[12];
    constexpr int I_IN = (D / 64) * (N1 / 32), I_SQ = (D / 64) * (D / 32);
    constexpr int NITEMS = I_IN + 2 * I_SQ;
    for (int it = gw; it < NITEMS; it += NGW) {
        int r = it;
        if (r < I_IN) { auto src = [&](int n) { if (n < 2048) return w_in + n; if (n < 2560) return w_in + n + 8; const int t = (n - 2560) >> 8, w = (n - 2560) & 255; return w_in + (w < 128 ? 2568 + 128 * t + w : 3080 + 128 * t + (w - 128)); };   transpose_item(src, INC, D, (bf16_t*)(ws + WS_WIN_T), (const float*)nullptr, scr, r / (N1 / 32), r % (N1 / 32), lane); continue; } r -= I_IN;
        if (r < I_SQ) { auto src = [&](int n) { return w_xk + n; }; transpose_item(src, D, D, (bf16_t*)(ws + WS_WXK_T), (const float*)nullptr, scr, r / 32, r % 32, lane); continue; } r -= I_SQ;
        { auto src = [&](int n) { return w_xv + n; }; transpose_item(src, D, D, (bf16_t*)(ws + WS_WXV_T), (const float*)nullptr, scr, r / 32, r % 32, lane); }
    }
    for (int i = gw * 64 + lane; i < M; i += NGW * 64) { ((float*)(ws + WS_SS1))[i] = 0.f; ((float*)(ws + WS_SS2))[i] = 0.f; ((float*)(ws + WS_SS3))[i] = 0.f; }
    for (int m = gw; m < NB * 256; m += NGW) { const f32x4* xr = (const f32x4*)(p->in[1] + (size_t)m * D) + lane; f32x4 v[4]; float s = 0.f;
#pragma unroll
        for (int j = 0; j < 4; ++j) { v[j] = xr[64 * j]; s += (v[j][0] * v[j][0] + v[j][1] * v[j][1]) + (v[j][2] * v[j][2] + v[j][3] * v[j][3]); }
        const float rs = rsqrtf(wave_sum(s) * (1.f / D) + EPS); u32x2* o = (u32x2*)((bf16_t*)(ws + WS_MEMN) + (size_t)m * D) + lane;
#pragma unroll
        for (int j = 0; j < 4; ++j) { const f32x4 g = ((const f32x4*)g_mem)[lane + 64 * j]; const f32x4 y = v[j] * rs * g; u32x2 w; w.x = pk2(y[0], y[1]); w.y = pk2(y[2], y[3]); o[64 * j] = w; } }
    {
        f32x4 gm[4]; f32x4 wab[4][4][2];
#pragma unroll
        for (int j = 0; j < 4; ++j) { gm[j] = ((const f32x4*)g_mix)[lane + 64 * j];
#pragma unroll
            for (int e = 0; e < 4; ++e) { const int k = 4 * lane + 256 * j + e; const f32x4* wp = (const f32x4*)(w_in + (size_t)k * INC + 2048); wab[j][e][0] = wp[0] * gm[j][e]; wab[j][e][1] = wp[1] * gm[j][e]; } }
        const float* a_log = p->in[5]; const float* dt_bias = p->in[6];
        bf16_t* XN = (bf16_t*)((unsigned char*)p->out + DO_XN); float* GB = (float*)(ws + WS_GB);
        f32x4 vn[4];
        { const f32x4* xr = (const f32x4*)(p->in[0] + (size_t)gw * D) + lane;
#pragma unroll
          for (int j = 0; j < 4; ++j) vn[j] = __builtin_nontemporal_load(xr + 64 * j); }
        for (int m = gw; m < M; m += NGW) { f32x4 v[4]; float s = 0.f;
#pragma unroll
            for (int j = 0; j < 4; ++j) { v[j] = vn[j]; s += (v[j][0] * v[j][0] + v[j][1] * v[j][1]) + (v[j][2] * v[j][2] + v[j][3] * v[j][3]); }
            if (m + NGW < M) { const f32x4* xr = (const f32x4*)(p->in[0] + (size_t)(m + NGW) * D) + lane;
#pragma unroll
                for (int j = 0; j < 4; ++j) vn[j] = __builtin_nontemporal_load(xr + 64 * j); }
            const float rs = rsqrtf(wave_sum(s) * (1.f / D) + EPS);
            f32x4 d0 = {0.f, 0.f, 0.f, 0.f}, d1 = {0.f, 0.f, 0.f, 0.f};
            u32x2* o = (u32x2*)(XN + (size_t)m * D) + lane;
#pragma unroll
            for (int j = 0; j < 4; ++j) { const f32x4 xs = v[j] * rs; const f32x4 y = xs * gm[j]; u32x2 w; w.x = pk2(y[0], y[1]); w.y = pk2(y[2], y[3]); o[64 * j] = w;
#pragma unroll
                for (int e = 0; e < 4; ++e) { d0 += wab[j][e][0] * xs[e]; d1 += wab[j][e][1] * xs[e]; } }
            float r8[8] = {d0[0], d0[1], d0[2], d0[3], d1[0], d1[1], d1[2], d1[3]};
#pragma unroll
            for (int q = 0; q < 8; ++q) r8[q] = wave_sum(r8[q]);
            float mine = r8[0];
#pragma unroll
            for (int q = 1; q < 8; ++q) mine = (lane == q) ? r8[q] : mine;
            if (lane < 4) { const float xx = mine + dt_bias[lane]; const float sp = xx > 20.f ? xx : log1pf(__expf(xx)); GB[(size_t)m * 8 + lane] = -__expf(a_log[lane]) * sp; }
            else if (lane < 8) { GB[(size_t)m * 8 + lane] = 1.f / (1.f + __expf(-mine)); }
        }
    }
}

FK_DI void p9_final(PP p, int gw, int NGW, int lane) {
    const float* ss = (const float*)(p->ws + WS_SS3); const f32x4* g = (const f32x4*)p->in[21]; const bf16_t* HB = (const bf16_t*)(p->ws + WS_HB);
    f32x4 gm[4];
#pragma unroll
    for (int j = 0; j < 2; ++j) { gm[2 * j] = g[2 * lane + 128 * j]; gm[2 * j + 1] = g[2 * lane + 128 * j + 1]; }
    for (int m0 = gw * 4; m0 < M; m0 += NGW * 4) {
        u32x4 hv[4][2]; float rs[4];
#pragma unroll
        for (int r = 0; r < 4; ++r) { const u32x4* hr = (const u32x4*)(HB + (size_t)(m0 + r) * D) + lane; hv[r][0] = hr[0]; hv[r][1] = hr[64]; rs[r] = row_rstd(ss, m0 + r); }
#pragma unroll
        for (int r = 0; r < 4; ++r) { f32x4* xr = (f32x4*)(p->out + (size_t)(m0 + r) * D) + 2 * lane;
#pragma unroll
            for (int j = 0; j < 2; ++j) { const u32x4 h = hv[r][j];
                xr[128 * j] = (f32x4){bf_lo(h.x), bf_hi(h.x), bf_lo(h.y), bf_hi(h.y)} * rs[r] * gm[2 * j];
                xr[128 * j + 1] = (f32x4){bf_lo(h.z), bf_hi(h.z), bf_lo(h.w), bf_hi(h.w)} * rs[r] * gm[2 * j + 1]; } }
    }
}
}
namespace fk {
#define FK_MFMA32(a, b, c) __builtin_amdgcn_mfma_f32_32x32x16_bf16((a), (b), (c), 0, 0, 0)
FK_DI int crow(int reg, int h) { return (reg & 3) + 8 * (reg >> 2) + 4 * h; }
FK_DI bf16x8 pack8(const f32x16& x, int s) {
    u32x4 p; p.x = pk2(x[8 * s], x[8 * s + 1]); p.y = pk2(x[8 * s + 2], x[8 * s + 3]); p.z = pk2(x[8 * s + 4], x[8 * s + 5]); p.w = pk2(x[8 * s + 6], x[8 * s + 7]);
    return __builtin_bit_cast(bf16x8, p);
}
FK_DI f32x16 zero16() { f32x16 z; for (int i = 0; i < 16; ++i) z[i] = 0.f; return z; }

constexpr int PL_QS = 0, PL_KS = 17408, PL_KT = 34816, PL_VT = 53248, PL_AF = 71680, PL_TP = 88064, PL_TPP = 97280, PL_TAB = 106496;
constexpr int QS_LD = 136, KT_LD = 72, TP_LD = 72;

FK_DI void st16_wt(__amdgpu_buffer_rsrc_t rs, unsigned off, u32x4 v) { __builtin_amdgcn_raw_buffer_store_b128(v, rs, off, 0, 16); }
FK_DI void p2_short_conv(PP p, int gw, int lane) {
    const bf16_t* SC = (const bf16_t*)(p->ws + WS_SC);
    const __amdgpu_buffer_rsrc_t mrs = __builtin_amdgcn_make_buffer_rsrc((void*)(p->ws + WS_MIX), 0, (int)((size_t)M * D * 2), 0x00020000);
    const float* csw = p->in[8]; const float* scg = p->in[9];
    float w0[8], w1[8], w2[8], g[8];
#pragma unroll
    for (int e = 0; e < 8; ++e) { w0[e] = csw[8 * lane + e]; w1[e] = csw[512 + 8 * lane + e]; w2[e] = csw[1024 + 8 * lane + e]; g[e] = scg[8 * lane + e]; }
    const int r0 = gw * 16;
    float p1[8], p2[8];
    auto prod = [&](int row, float* o) {
        const u32x4 c = *(const u32x4*)(SC + (size_t)row * 1024 + 512 + 8 * lane);
        #pragma unroll
        for (int q = 0; q < 4; ++q) { o[2 * q] = bf_lo(c[q]); o[2 * q + 1] = bf_hi(c[q]); }
    };
    const int t0 = r0 & (SEQ - 1);
    if (t0 >= 1) prod(r0 - 1, p1); else { for (int e = 0; e < 8; ++e) p1[e] = 0.f; }
    if (t0 >= 2) prod(r0 - 2, p2); else { for (int e = 0; e < 8; ++e) p2[e] = 0.f; }
    {
        u32x4 cv[16], bv[16];
#pragma unroll
        for (int r = 0; r < 16; ++r) { const size_t row = (size_t)(r0 + r); cv[r] = __builtin_nontemporal_load((const u32x4*)(SC + row * 1024 + 512 + 8 * lane)); bv[r] = __builtin_nontemporal_load((const u32x4*)(SC + row * 1024 + 8 * lane)); }
#pragma unroll
        for (int r = 0; r < 16; ++r) { const size_t row = (size_t)(r0 + r); float p0[8];
#pragma unroll
            for (int q = 0; q < 4; ++q) { p0[2 * q] = bf_lo(cv[r][q]); p0[2 * q + 1] = bf_hi(cv[r][q]); }
            const u32x4 b = bv[r]; float y[8]; float s = 0.f;
#pragma unroll
            for (int e = 0; e < 8; ++e) { const float bb = (e & 1) ? bf_hi(b[e >> 1]) : bf_lo(b[e >> 1]); y[e] = bb * (w0[e] * p2[e] + w1[e] * p1[e] + w2[e] * p0[e]); s += y[e] * y[e]; }
            s = sum8(s);
            const float rs = rsqrtf(s * (1.f / 64.f) + EPS);
            u32x4 o; o.x = pk2(y[0] * rs * g[0], y[1] * rs * g[1]); o.y = pk2(y[2] * rs * g[2], y[3] * rs * g[3]); o.z = pk2(y[4] * rs * g[4], y[5] * rs * g[5]); o.w = pk2(y[6] * rs * g[6], y[7] * rs * g[7]);
            st16_wt(mrs, (unsigned)((row * D + 512 + 8 * lane) * 2), o);
#pragma unroll
            for (int e = 0; e < 8; ++e) { p2[e] = p1[e]; p1[e] = p0[e]; } }
    }
}

constexpr int PL_CW = 107520;
struct P2Raw { u32x4 x[3][5]; float g, be; };
FK_DI void p2_load(PP p, int it, int tid, int lane, P2Raw& R) {
    const int n = it & 63, h = (it >> 6) & 3, b = it >> 8, cg = tid & 15, rg = tid >> 4;
    const bf16_t* QKV = (const bf16_t*)(p->ws + WS_QKV) + (size_t)(b * SEQ) * 1536 + h * 128 + cg * 8;
#pragma unroll
    for (int pt = 0; pt < 3; ++pt)
#pragma unroll
        for (int j = 0; j < 5; ++j) { const int tt = n * 64 + 2 * rg - 3 + j; R.x[pt][j] = (tt >= 0) ? *(const u32x4*)(QKV + (size_t)tt * 1536 + pt * 512) : (u32x4){0u, 0u, 0u, 0u}; }
    const float* GB = (const float*)(p->ws + WS_GB) + (size_t)(b * SEQ + n * 64 + lane) * 8 + h;
    R.g = GB[0]; R.be = GB[4];
}
#define P2_BAR() do { asm volatile("s_waitcnt lgkmcnt(0)" ::: "memory"); __builtin_amdgcn_s_barrier(); asm volatile("" ::: "memory"); } while (0)
FK_DI void p2_item(PP p, FK_LAS unsigned char* lds, int it, int it_next, int tid_in, int wave, int lane_in, P2Raw& R) {
    int tid = tid_in, lane = lane_in; asm volatile("" : "+v"(tid), "+v"(lane));
    unsigned char* item = p->ws + WS_CHUNK + (size_t)it * CH_BYTES;
    const __amdgpu_buffer_rsrc_t irs = __builtin_amdgcn_make_buffer_rsrc(item, 0, CH_BYTES, 0x00020000);
    const int hw = (it >> 6) & 3;
    FK_LAS float* TAB = (FK_LAS float*)(lds + PL_TAB);
    if (wave == 0) {
        float g = R.g; const float be = R.be;
#pragma unroll
        for (int o = 1; o < 64; o <<= 1) { const float t = __shfl_up(g, o); if (lane >= o) g += t; }
        const float gl = __shfl(g, 63);
        TAB[lane] = g; TAB[64 + lane] = __expf(g); TAB[128 + lane] = be; TAB[192 + lane] = __expf(gl - g);
        if (lane == 0) __hip_atomic_store((unsigned*)(p->ws + WS_GL) + it, __float_as_uint(__expf(gl)), __ATOMIC_RELAXED, __HIP_MEMORY_SCOPE_AGENT);
    }
    {
        const int cg = tid & 15, rg = tid >> 4;
#pragma unroll
        for (int pt = 0; pt < 3; ++pt) {
            float y0[8], y1[8];
#pragma unroll
            for (int e = 0; e < 8; ++e) { y0[e] = 0.f; y1[e] = 0.f; }
            float xf[8];
#pragma unroll
            for (int j = 0; j < 5; ++j) { const u32x4 x = R.x[pt][j];
#pragma unroll
                for (int q = 0; q < 4; ++q) { xf[2 * q] = bf_lo(x[q]); xf[2 * q + 1] = bf_hi(x[q]); }
                if (j < 4) { const FK_LAS f32x4* wp = (const FK_LAS f32x4*)(lds + PL_CW + hw * 6144 + ((pt * 4 + j) * 128 + cg * 8) * 4); const f32x4 wa = wp[0], wb = wp[1];
#pragma unroll
                    for (int e = 0; e < 4; ++e) { y0[e] += wa[e] * xf[e]; y0[4 + e] += wb[e] * xf[4 + e]; } }
                if (j >= 1) { const FK_LAS f32x4* wp = (const FK_LAS f32x4*)(lds + PL_CW + hw * 6144 + ((pt * 4 + j - 1) * 128 + cg * 8) * 4); const f32x4 wa = wp[0], wb = wp[1];
#pragma unroll
                    for (int e = 0; e < 4; ++e) { y1[e] += wa[e] * xf[e]; y1[4 + e] += wb[e] * xf[4 + e]; } }
            }
            float s0 = 0.f, s1 = 0.f;
#pragma unroll
            for (int e = 0; e < 8; ++e) { y0[e] = silu(y0[e]); y1[e] = silu(y1[e]); s0 += y0[e] * y0[e]; s1 += y1[e] * y1[e]; }
            if (pt < 2) { s0 = sum16(s0); s1 = sum16(s1);
                const float sc = (pt == 0 ? 0.08838834764831845f : 1.f), r0 = rsqrtf(s0 + EPS) * sc, r1 = rsqrtf(s1 + EPS) * sc;
#pragma unroll
                for (int e = 0; e < 8; ++e) { y0[e] *= r0; y1[e] *= r1; } }
            u32x4 o0, o1; o0.x = pk2(y0[0], y0[1]); o0.y = pk2(y0[2], y0[3]); o0.z = pk2(y0[4], y0[5]); o0.w = pk2(y0[6], y0[7]);
            o1.x = pk2(y1[0], y1[1]); o1.y = pk2(y1[2], y1[3]); o1.z = pk2(y1[4], y1[5]); o1.w = pk2(y1[6], y1[7]);
            if (pt <= 1) { FK_LAS unsigned char* dst = lds + (pt == 0 ? PL_QS : PL_KS) + ((2 * rg) * QS_LD + cg * 8) * 2; *(FK_LAS u32x4*)dst = o0; *(FK_LAS u32x4*)(dst + QS_LD * 2) = o1; }
            if (pt >= 1) { FK_LAS unsigned char* T = lds + (pt == 1 ? PL_KT : PL_VT) + ((cg * 8) * KT_LD + 2 * rg) * 2;
#pragma unroll
                for (int e = 0; e < 8; ++e) { const unsigned a0 = (e & 1) ? (o0[e >> 1] >> 16) : (o0[e >> 1] & 0xffffu), a1 = (e & 1) ? (o1[e >> 1] & 0xffff0000u) : (o1[e >> 1] << 16);
                    *(FK_LAS unsigned*)(T + e * KT_LD * 2) = a0 | a1; } }
        }
    }
    P2_BAR();
    if (it_next >= 0) p2_load(p, it_next, tid, lane, R);
    {
        const int r = lane & 31, hh = lane >> 5;
        if (wave < 4) {
            const int tj = wave >> 1, ti = wave & 1;
            f32x16 c = zero16();
            if (tj <= ti) {
#pragma unroll
                for (int s = 0; s < 8; ++s) { const bf16x8 a = *(const FK_LAS bf16x8*)(lds + PL_KS + ((32 * tj + r) * QS_LD + 16 * s + 8 * hh) * 2);
                    const bf16x8 bq = *(const FK_LAS bf16x8*)(lds + PL_QS + ((32 * ti + r) * QS_LD + 16 * s + 8 * hh) * 2); c = FK_MFMA32(a, bq, c); }
                const int i = 32 * ti + r; const float gci = TAB[i];
#pragma unroll
                for (int reg = 0; reg < 16; ++reg) { const int j = 32 * tj + crow(reg, hh); c[reg] = (i >= j) ? c[reg] * __expf(gci - TAB[j]) : 0.f; }
            }
#pragma unroll
            for (int s = 0; s < 2; ++s) st16_wt(irs, CH_ATF + (((ti * 4) + 2 * tj + s) * 64 + lane) * 16, __builtin_bit_cast(u32x4, pack8(c, s)));
        } else {
            const int ta = (wave - 4) >> 1, tb = (wave - 4) & 1;
            if (ta >= tb) {
                f32x16 c = zero16();
#pragma unroll
                for (int s = 0; s < 8; ++s) { const bf16x8 a = *(const FK_LAS bf16x8*)(lds + PL_KS + ((32 * ta + r) * QS_LD + 16 * s + 8 * hh) * 2);
                    const bf16x8 bk = *(const FK_LAS bf16x8*)(lds + PL_KS + ((32 * tb + r) * QS_LD + 16 * s + 8 * hh) * 2); c = FK_MFMA32(a, bk, c); }
                const int j = 32 * tb + r; const float gcj = TAB[j]; FK_LAS float* AF = (FK_LAS float*)(lds + PL_AF);
#pragma unroll
                for (int reg = 0; reg < 16; ++reg) { const int i = 32 * ta + crow(reg, hh); AF[i * 64 + j] = (i > j) ? TAB[128 + i] * c[reg] * __expf(TAB[i] - gcj) : 0.f; }
            }
        }
#pragma unroll
        for (int rep = 0; rep < 2; ++rep) { const int f = wave * 2 + rep;
            { const int mt = f >> 3, kk = f & 7; const int tok = 32 * mt + r; const float sc = TAB[64 + tok];
              const u32x2 lo = *(const FK_LAS u32x2*)(lds + PL_QS + (tok * QS_LD + 16 * kk + 4 * hh) * 2), hi = *(const FK_LAS u32x2*)(lds + PL_QS + (tok * QS_LD + 16 * kk + 8 + 4 * hh) * 2);
              u32x4 o; o.x = pk2(bf_lo(lo.x) * sc, bf_hi(lo.x) * sc); o.y = pk2(bf_lo(lo.y) * sc, bf_hi(lo.y) * sc); o.z = pk2(bf_lo(hi.x) * sc, bf_hi(hi.x) * sc); o.w = pk2(bf_lo(hi.y) * sc, bf_hi(hi.y) * sc);
              st16_wt(irs, CH_QDF + (f * 64 + lane) * 16, o); }
            { const int mt = f >> 2, ks = f & 3; const int dk = 32 * mt + r; const int tk = 16 * ks + 4 * hh;
              const u32x2 lo = *(const FK_LAS u32x2*)(lds + PL_KT + (dk * KT_LD + tk) * 2), hi = *(const FK_LAS u32x2*)(lds + PL_KT + (dk * KT_LD + tk + 8) * 2);
              const f32x4 f0 = *(const FK_LAS f32x4*)(TAB + 192 + tk), f1 = *(const FK_LAS f32x4*)(TAB + 192 + tk + 8);
              u32x4 o; o.x = pk2(bf_lo(lo.x) * f0[0], bf_hi(lo.x) * f0[1]); o.y = pk2(bf_lo(lo.y) * f0[2], bf_hi(lo.y) * f0[3]); o.z = pk2(bf_lo(hi.x) * f1[0], bf_hi(hi.x) * f1[1]); o.w = pk2(bf_lo(hi.y) * f1[2], bf_hi(hi.y) * f1[3]);
              st16_wt(irs, CH_KDF + (f * 64 + lane) * 16, o); }
        }
    }
    P2_BAR();
#ifndef NO_STEPD
    if (wave == 0) {
        const int c = lane & 31, hb = lane >> 5;
        const FK_LAS float* AF = (const FK_LAS float*)(lds + PL_AF) + (32 * hb) * 64 + 32 * hb;
        FK_LAS bf16_t* TP = (FK_LAS bf16_t*)(lds + PL_TP); FK_LAS bf16_t* TPP = (FK_LAS bf16_t*)(lds + PL_TPP);
        FK_LAS unsigned char* X1 = lds + PL_QS;
        asm volatile("" : "+v"(AF), "+v"(TP), "+v"(TPP), "+v"(X1));
        const int col = 32 * hb + c;
        const float bcol = TAB[128 + col], becol = bcol * TAB[64 + col];
        float t[32];
        f32x4 an[8];
        an[0] = *(const FK_LAS f32x4*)(AF + 1 * 64);
#pragma unroll
        for (int i = 0; i < 32; ++i) {
            f32x4 ar[8];
#pragma unroll
            for (int j4 = 0; j4 < (i + 3) / 4; ++j4) ar[j4] = an[j4];
            if (i + 1 < 32) {
#pragma unroll
                for (int j4 = 0; j4 < (i + 4) / 4; ++j4) { if (i > 0 || j4 > 0) an[j4] = *(const FK_LAS f32x4*)(AF + (i + 1) * 64 + 4 * j4); } }
            float ps[4] = {(c == i) ? 1.f : 0.f, 0.f, 0.f, 0.f};
#pragma unroll
            for (int j4 = 0; j4 < (i + 3) / 4; ++j4) {
#pragma unroll
                for (int e = 0; e < 4; ++e) if (4 * j4 + e < i) ps[e] -= ar[j4][e] * t[4 * j4 + e]; }
            const float acc = (ps[0] + ps[1]) + (ps[2] + ps[3]);
            t[i] = acc;
            const unsigned pv = pk2(acc * becol, acc * bcol);
            TP[(32 * hb + i) * TP_LD + col] = (bf16_t)(pv & 0xffffu); TPP[(32 * hb + i) * TP_LD + col] = (bf16_t)(pv >> 16);
            if (hb == 0) { TP[i * TP_LD + 32 + c] = 0; TPP[i * TP_LD + 32 + c] = 0; }
            const unsigned tb = pk2(acc, acc);
            if (hb == 1) *(FK_LAS bf16_t*)(X1 + 2560 + i * 80 + c * 2) = (bf16_t)(tb & 0xffffu);
            asm volatile("" ::: "memory");
        }
        if (hb == 0) {
#pragma unroll
            for (int q = 0; q < 4; ++q) { u32x4 w; w.x = pk2(t[8 * q], t[8 * q + 1]); w.y = pk2(t[8 * q + 2], t[8 * q + 3]); w.z = pk2(t[8 * q + 4], t[8 * q + 5]); w.w = pk2(t[8 * q + 6], t[8 * q + 7]);
                *(FK_LAS u32x4*)(X1 + c * 80 + q * 16) = w; }
        }
        asm volatile("s_waitcnt lgkmcnt(0)" ::: "memory");
        f32x16 xacc = zero16();
        const FK_LAS float* A21 = (const FK_LAS float*)(lds + PL_AF) + (32 + c) * 64;
#pragma unroll
        for (int s2 = 0; s2 < 2; ++s2) { const f32x4 a0 = *(const FK_LAS f32x4*)(A21 + 16 * s2 + 8 * hb), a1 = *(const FK_LAS f32x4*)(A21 + 16 * s2 + 8 * hb + 4);
            u32x4 af; af.x = pk2(a0[0], a0[1]); af.y = pk2(a0[2], a0[3]); af.z = pk2(a1[0], a1[1]); af.w = pk2(a1[2], a1[3]);
            const bf16x8 bfrag = *(const FK_LAS bf16x8*)(X1 + c * 80 + (16 * s2 + 8 * hb) * 2);
            xacc = FK_MFMA32(__builtin_bit_cast(bf16x8, af), bfrag, xacc); }
        f32x16 yacc = zero16();
#pragma unroll
        for (int s2 = 0; s2 < 2; ++s2) { const u32x2 lo = *(const FK_LAS u32x2*)(X1 + 2560 + c * 80 + (16 * s2 + 4 * hb) * 2), hi = *(const FK_LAS u32x2*)(X1 + 2560 + c * 80 + (16 * s2 + 8 + 4 * hb) * 2);
            u32x4 af; af.x = lo.x; af.y = lo.y; af.z = hi.x; af.w = hi.y;
            yacc = FK_MFMA32(__builtin_bit_cast(bf16x8, af), pack8(xacc, s2), yacc); }
        const float bc0 = TAB[128 + c], bec0 = bc0 * TAB[64 + c];
#pragma unroll
        for (int reg = 0; reg < 16; ++reg) { const int i = 32 + crow(reg, hb); const unsigned pv = pk2(-yacc[reg] * bec0, -yacc[reg] * bc0);
            TP[i * TP_LD + c] = (bf16_t)(pv & 0xffffu); TPP[i * TP_LD + c] = (bf16_t)(pv >> 16); }
    }
#endif
    P2_BAR();
    {
        const int r = lane & 31, hh = lane >> 5;
        { const int mt = wave & 1, s4 = wave >> 1; f32x16 c = zero16();
#pragma unroll
          for (int s = 0; s < 4; ++s) { const bf16x8 a = *(const FK_LAS bf16x8*)(lds + PL_TPP + ((32 * mt + r) * TP_LD + 16 * s + 8 * hh) * 2);
              const bf16x8 bv = *(const FK_LAS bf16x8*)(lds + PL_VT + ((32 * s4 + r) * KT_LD + 16 * s + 8 * hh) * 2); c = FK_MFMA32(a, bv, c); }
          const unsigned dst = CH_UC + ((s4 * 64 + lane) * 2 + mt) * 32;
          st16_wt(irs, dst, __builtin_bit_cast(u32x4, pack8(c, 0))); st16_wt(irs, dst + 16, __builtin_bit_cast(u32x4, pack8(c, 1))); }
        { const int t = wave >> 1, mt = wave & 1; f32x16 c = zero16();
#pragma unroll
          for (int s = 0; s < 4; ++s) { const bf16x8 a = *(const FK_LAS bf16x8*)(lds + PL_KT + ((32 * t + r) * KT_LD + 16 * s + 8 * hh) * 2);
              const bf16x8 bt = *(const FK_LAS bf16x8*)(lds + PL_TP + ((32 * mt + r) * TP_LD + 16 * s + 8 * hh) * 2); c = FK_MFMA32(a, bt, c); }
#pragma unroll
          for (int s = 0; s < 2; ++s) st16_wt(irs, CH_WF + ((mt * 8 + 2 * t + s) * 64 + lane) * 16, __builtin_bit_cast(u32x4, pack8(c, s))); }
    }
    asm volatile("s_waitcnt vmcnt(0)" ::: "memory");
    P2_BAR();
    if (tid == 0) __hip_atomic_store((unsigned*)(p->ws + WS_FLAGS) + it, 1u, __ATOMIC_RELAXED, __HIP_MEMORY_SCOPE_AGENT);
}

#define SC_BAR() do { asm volatile("s_waitcnt lgkmcnt(0)" ::: "memory"); __builtin_amdgcn_s_barrier(); asm volatile("" ::: "memory"); } while (0)
constexpr int SC_STAGE = 57344, SC_OBUF = 2 * SC_STAGE, SC_OB_BYTES = 16384;

FK_DI void p3_scan(PP p, FK_LAS unsigned char* lds, int bh, int tid_in, int wave, int lane_in) {
    int lane = lane_in; asm volatile("" : "+v"(lane));
    const int b = bh >> 2, h = bh & 3;
    const unsigned char* items = p->ws + WS_CHUNK + (size_t)(bh * 64) * CH_BYTES;
    const float* GL = (const float*)(p->ws + WS_GL) + bh * 64;
    const int r = lane & 31, hh = lane >> 5;
    const __amdgpu_buffer_rsrc_t prs = __builtin_amdgcn_make_buffer_rsrc((void*)items, 0, 64 * CH_BYTES, 0x00020000);
    const unsigned* flags = (const unsigned*)(p->ws + WS_FLAGS) + bh * 64;
    if (wave < 4) {
        f32x16 S[4]; bf16x8 Sf[8];
#pragma unroll
        for (int t = 0; t < 4; ++t) S[t] = zero16();
#pragma unroll
        for (int k = 0; k < 8; ++k) Sf[k] = (bf16x8){0, 0, 0, 0, 0, 0, 0, 0};
        const unsigned ubase = CH_UC + wave * 4096 + lane * 64;
        u32x4 u0[4], u1[4];
        SC_BAR();
#define SC_ULD(ub, k) do { _Pragma("unroll") for (int i_ = 0; i_ < 4; ++i_) ub[i_] = __builtin_bit_cast(u32x4, __builtin_amdgcn_raw_buffer_load_b128(prs, ubase + (unsigned)(k) * CH_BYTES + i_ * 16, 0, 18)); } while (0)
        SC_ULD(u0, 0); SC_ULD(u1, 1);
        unsigned g0 = __hip_atomic_load((const unsigned*)GL, __ATOMIC_RELAXED, __HIP_MEMORY_SCOPE_AGENT), g1 = __hip_atomic_load((const unsigned*)GL + 1, __ATOMIC_RELAXED, __HIP_MEMORY_SCOPE_AGENT);
#define SC_STEP(n, ub, gv, RELOAD) do { \
            const FK_LAS unsigned char* st = lds + ((n) & 1) * SC_STAGE + lane * 16; \
            const float egl = __uint_as_float(gv); \
            f32x16 av[2]; \
            _Pragma("unroll") for (int mt = 0; mt < 2; ++mt) { av[mt] = zero16(); \
                _Pragma("unroll") for (int kk = 0; kk < 8; ++kk) { const bf16x8 wa = *(const FK_LAS bf16x8*)(st + CH_WF + (mt * 8 + kk) * 1024); av[mt] = FK_MFMA32(wa, Sf[kk], av[mt]); } } \
            bf16x8 Vf[4]; \
            _Pragma("unroll") for (int mt = 0; mt < 2; ++mt) { \
                _Pragma("unroll") for (int q = 0; q < 8; ++q) { const unsigned uw = ub[2 * mt + (q >> 2)][q & 3]; av[mt][2 * q] = bf_lo(uw) - av[mt][2 * q]; av[mt][2 * q + 1] = bf_hi(uw) - av[mt][2 * q + 1]; } \
                Vf[2 * mt] = pack8(av[mt], 0); Vf[2 * mt + 1] = pack8(av[mt], 1); } \
            if (RELOAD) { SC_ULD(ub, (n) + 2); gv = __hip_atomic_load((const unsigned*)GL + (n) + 2, __ATOMIC_RELAXED, __HIP_MEMORY_SCOPE_AGENT); } \
            f32x16 ao[2]; \
            _Pragma("unroll") for (int mt = 0; mt < 2; ++mt) { ao[mt] = zero16(); \
                _Pragma("unroll") for (int kk = 0; kk < 8; ++kk) { const bf16x8 qa = *(const FK_LAS bf16x8*)(st + CH_QDF + (mt * 8 + kk) * 1024); ao[mt] = FK_MFMA32(qa, Sf[kk], ao[mt]); } \
                _Pragma("unroll") for (int ks = 0; ks < 4; ++ks) { const bf16x8 aa = *(const FK_LAS bf16x8*)(st + CH_ATF + (mt * 4 + ks) * 1024); ao[mt] = FK_MFMA32(aa, Vf[ks], ao[mt]); } } \
            _Pragma("unroll") for (int t = 0; t < 4; ++t) { S[t] = S[t] * egl; \
                _Pragma("unroll") for (int ks = 0; ks < 4; ++ks) { const bf16x8 ka = *(const FK_LAS bf16x8*)(st + CH_KDF + (t * 4 + ks) * 1024); S[t] = FK_MFMA32(ka, Vf[ks], S[t]); } \
                Sf[2 * t] = pack8(S[t], 0); Sf[2 * t + 1] = pack8(S[t], 1); } \
            FK_LAS bf16_t* ob = (FK_LAS bf16_t*)(lds + SC_OBUF + ((n) & 1) * SC_OB_BYTES) + 32 * wave + r; \
            _Pragma("unroll") for (int mt = 0; mt < 2; ++mt) \
                _Pragma("unroll") for (int q = 0; q < 8; ++q) { const unsigned pv = pk2(ao[mt][2 * q], ao[mt][2 * q + 1]); \
                    ob[(32 * mt + crow(2 * q, hh)) * 128] = (bf16_t)(pv & 0xffffu); ob[(32 * mt + crow(2 * q + 1, hh)) * 128] = (bf16_t)(pv >> 16); } \
            SC_BAR(); } while (0)
        for (int n = 0; n < NCH - 8; n += 8) { SC_STEP(n, u0, g0, true); SC_STEP(n + 1, u1, g1, true); SC_STEP(n + 2, u0, g0, true); SC_STEP(n + 3, u1, g1, true); SC_STEP(n + 4, u0, g0, true); SC_STEP(n + 5, u1, g1, true); SC_STEP(n + 6, u0, g0, true); SC_STEP(n + 7, u1, g1, true); }
        SC_STEP(NCH - 8, u0, g0, true); SC_STEP(NCH - 7, u1, g1, true); SC_STEP(NCH - 6, u0, g0, true); SC_STEP(NCH - 5, u1, g1, true); SC_STEP(NCH - 4, u0, g0, true); SC_STEP(NCH - 3, u1, g1, true);
        SC_STEP(NCH - 2, u0, g0, false); SC_STEP(NCH - 1, u1, g1, false);
#undef SC_STEP
#undef SC_ULD
        SC_BAR();
    } else {
        const int e = wave - 4, l16 = lane & 15, rq = lane >> 4;
        const unsigned char* Zu = (const unsigned char*)p->out + DO_Z + ((size_t)b * SEQ * 512 + h * 128 + (size_t)(16 * e) * 512) * 2;
        unsigned char* Mu = p->ws + WS_MIX + ((size_t)b * SEQ * D + h * 128 + (size_t)(16 * e) * D) * 2;
        const __amdgpu_buffer_rsrc_t mxrs = __builtin_amdgcn_make_buffer_rsrc((void*)Mu, 0, SEQ * 2048, 0x00020000);
        unsigned* prog = (unsigned*)(p->ws + WS_PROG) + b * 8;
        const unsigned zoff = (unsigned)(rq * 512 + 8 * l16) * 2u, moff = (unsigned)(rq * D + 8 * l16) * 2u, soff = (unsigned)lane * 16u;
        const unsigned src = (unsigned)(e * 14336) + (unsigned)lane * 16u;
        FK_LAS unsigned char* dstw = lds + e * 14336 + lane * 16;
        u32x4 sa[14], sb[14], sc[14]; u32x4 za[4], zb[4];
#define SC_POLL(k) do { unsigned sp_ = 0; while ((unsigned)__builtin_amdgcn_readfirstlane(__hip_atomic_load(flags + (k), __ATOMIC_RELAXED, __HIP_MEMORY_SCOPE_AGENT)) == 0u) { __builtin_amdgcn_s_sleep(2); if (++sp_ > (1u << 22)) break; } } while (0)
#define SC_LD(set, k) do { SC_POLL(k); _Pragma("unroll") for (int i = 0; i < 14; ++i) set[i] = __builtin_bit_cast(u32x4, __builtin_amdgcn_raw_buffer_load_b128(prs, src + (unsigned)(k) * CH_BYTES + i * 1024, 0, 18)); } while (0)
#define SC_WR(set, k) do { FK_LAS unsigned char* d_ = dstw + ((k) & 1) * SC_STAGE; _Pragma("unroll") for (int i = 0; i < 14; ++i) *(FK_LAS u32x4*)(d_ + i * 1024) = set[i]; } while (0)
#define SC_ZLD(zs, k) do { _Pragma("unroll") for (int q = 0; q < 4; ++q) zs[q] = __builtin_nontemporal_load((const u32x4*)(Zu + (size_t)((k) * 64 + 4 * q) * 1024 + zoff)); } while (0)
#define SC_GATE(zs, k) do { const FK_LAS unsigned char* ob = lds + SC_OBUF + ((k) & 1) * SC_OB_BYTES; \
            _Pragma("unroll") for (int q = 0; q < 4; ++q) { const int row = 16 * e + 4 * q + rq; const u32x4 ov = *(const FK_LAS u32x4*)(ob + row * 256 + l16 * 16); \
                float o[8] = {bf_lo(ov.x), bf_hi(ov.x), bf_lo(ov.y), bf_hi(ov.y), bf_lo(ov.z), bf_hi(ov.z), bf_lo(ov.w), bf_hi(ov.w)}; \
                float ss = 0.f; _Pragma("unroll") for (int j = 0; j < 8; ++j) ss += o[j] * o[j]; \
                ss = sum16(ss); \
                const float rs = rsqrtf(ss * (1.f / 128.f) + EPS); const u32x4 zv = zs[q]; \
                const float z[8] = {bf_lo(zv.x), bf_hi(zv.x), bf_lo(zv.y), bf_hi(zv.y), bf_lo(zv.z), bf_hi(zv.z), bf_lo(zv.w), bf_hi(zv.w)}; \
                u32x4 w; w.x = pk2(o[0] * rs * z[0], o[1] * rs * z[1]); w.y = pk2(o[2] * rs * z[2], o[3] * rs * z[3]); \
                w.z = pk2(o[4] * rs * z[4], o[5] * rs * z[5]); w.w = pk2(o[6] * rs * z[6], o[7] * rs * z[7]); \
                __builtin_amdgcn_raw_buffer_store_b128(w, mxrs, moff, (unsigned)((k) * 64 + 4 * q) * 2048u, 16); asm volatile("" ::: "memory"); } } while (0)
        SC_LD(sc, 0); SC_WR(sc, 0); SC_LD(sa, 1); SC_LD(sb, 2); SC_LD(sc, 3); SC_ZLD(za, 0);
        SC_BAR();
#define SC_PUB(lv) do { asm volatile("s_waitcnt vmcnt(0)" ::: "memory"); if (lane == 0) __hip_atomic_fetch_add(prog + (lv), 1u, __ATOMIC_RELAXED, __HIP_MEMORY_SCOPE_AGENT); } while (0)
#define SC_LSTEP(n, set, zs, WR, LD, GT, ZL) do { \
            if ((n) == 13 || (n) == 37 || (n) == 57 || (n) == 61) SC_PUB((n) == 13 ? 0 : ((n) == 37 ? 1 : ((n) == 57 ? 2 : 3)));        \
            if (WR) SC_WR(set, (n) + 1); \
            if (LD) SC_LD(set, (n) + 4); \
            if (GT) SC_GATE(zs, (n) - 1); \
            if (ZL) SC_ZLD(zs, (n) + 1); \
            SC_BAR(); } while (0)
        SC_LSTEP(0, sa, zb, true, true, false, true); SC_LSTEP(1, sb, za, true, true, true, true); SC_LSTEP(2, sc, zb, true, true, true, true);
        for (int n = 3; n < NCH - 7; n += 6) {
            SC_LSTEP(n, sa, za, true, true, true, true); SC_LSTEP(n + 1, sb, zb, true, true, true, true); SC_LSTEP(n + 2, sc, za, true, true, true, true);
            SC_LSTEP(n + 3, sa, zb, true, true, true, true); SC_LSTEP(n + 4, sb, za, true, true, true, true); SC_LSTEP(n + 5, sc, zb, true, true, true, true); }
        SC_LSTEP(57, sa, za, true, true, true, true); SC_LSTEP(58, sb, zb, true, true, true, true); SC_LSTEP(59, sc, za, true, true, true, true);
        SC_LSTEP(60, sa, zb, true, false, true, true); SC_LSTEP(61, sb, za, true, false, true, true); SC_LSTEP(62, sc, zb, true, false, true, true);
        SC_LSTEP(63, sa, za, false, false, true, false);
        SC_LSTEP(64, sb, zb, false, false, true, false);
        SC_PUB(4);
#undef SC_PUB
#undef SC_LD
#undef SC_WR
#undef SC_ZLD
#undef SC_GATE
#undef SC_LSTEP
    }
}
}
namespace fk {
namespace cg = cooperative_groups;
#ifndef WGM_P1
#define WGM_P1 4
#endif
#ifndef WGM_P7
#define WGM_P7 4
#endif

struct ProbXW {
    static constexpr int AUXA = 0;
    const char* KB; const char* VB; const char* WXQ; const char* WXO; int lda, ldb, K; int G, c, lim;
    FK_DI bool next(int i, Unit& u) const { const int L = i * G + c; if (L >= lim) return false; u.pm = L; u.pn = 0; return true; }
    FK_DI const char* aptr(const Unit& u) const { const int L = u.pm & 127, b = L >> 4, h = (L >> 2) & 3, q4 = L & 3;
        return (u.pm < 128) ? KB + ((size_t)(b * 256) * 1024 + h * 256) * 2 : WXO + ((size_t)(q4 * 256) * 1024 + h * 256) * 2; }
    FK_DI const char* bptr(const Unit& u) const { const int L = u.pm & 127, b = L >> 4, h = (L >> 2) & 3, q4 = L & 3;
        return (u.pm < 128) ? WXQ + ((size_t)(q4 * 256) * 1024 + h * 256) * 2 : VB + ((size_t)(b * 256) * 1024 + h * 256) * 2; }
};
struct EpiXW {
    static constexpr bool PERM = true;
    bf16_t* WQP; bf16_t* VWP;
    FK_DI void operator()(Acc& acc, const Unit& u, int wr, int wc, int fr, int fq, FK_LAS unsigned char*) const {
        const int L = u.pm & 127, b = L >> 4, h = (L >> 2) & 3, q4 = L & 3;
        bf16_t* base = (u.pm < 128) ? WQP + (size_t)b * 1048576 + (size_t)(h * 256) * 1024 + q4 * 256 : VWP + (size_t)b * 1048576 + (size_t)(q4 * 256) * 1024 + h * 256;
        const int row0 = wr * 64 + fr, col0 = wc * 32 + 8 * fq;
#pragma unroll
        for (int ai = 0; ai < 2; ++ai)
#pragma unroll
            for (int m = 0; m < 4; ++m) { bf16_t* rowp = base + (size_t)(row0 + ai * HALF + m * 16) * 1024 + col0;
#pragma unroll
                for (int bj = 0; bj < 2; ++bj) { const f32x4 v0 = acc[ai][bj][m][0], v1 = acc[ai][bj][m][1];
                    u32x4 w; w.x = pk2(v0[0], v0[1]); w.y = pk2(v0[2], v0[3]); w.z = pk2(v1[0], v1[1]); w.w = pk2(v1[2], v1[3]);
                    *(u32x4*)(rowp + bj * HALF) = w; } }
    }
};

struct ProbOne {
    static constexpr int AUXA = 0;
    const char* A; const char* Bt; int lda, ldb, K; int pm, pn;
    FK_DI bool next(int i, Unit& u) const { if (i) return false; u.pm = pm; u.pn = pn; return true; }
    FK_DI const char* aptr(const Unit& u) const { return A + (size_t)u.pm * 256 * lda * 2; }
    FK_DI const char* bptr(const Unit& u) const { return Bt + (size_t)u.pn * 256 * ldb * 2; }
};

__global__ void __launch_bounds__(512, 2) mega(Params p_arg) {
    PP p = (PP)__builtin_amdgcn_kernarg_segment_ptr();
    extern __shared__ __attribute__((aligned(16))) unsigned char lds_raw[];
    FK_LAS unsigned char* lds = (FK_LAS unsigned char*)lds_raw;
    cg::grid_group grid = cg::this_grid();
    int tid = threadIdx.x, lane = tid & 63; const int wave = __builtin_amdgcn_readfirstlane(tid >> 6);
    const int G = gridDim.x, bid = blockIdx.x, gw = bid * 8 + wave, NGW = G * 8;
#ifndef PHMASK
#define PHMASK 0x3ff
#endif
#define PH(k) (((PHMASK >> (k)) & 1) && p->dbg_lo <= (k) && (k) <= p->dbg_hi)
#ifndef REPMASK
#define REPMASK 0
#endif
#ifdef EXPK
#define TS0(k) if ((k) == EXPK && bid == 0 && tid == 0) *(volatile FK_LAS unsigned long long*)(lds + LDS_TOTAL) = __builtin_amdgcn_s_memrealtime();
#define TS1(k) if ((k) == EXPK && bid == 0 && tid == 0) *(volatile FK_LAS unsigned long long*)(lds + LDS_TOTAL + 8) = __builtin_amdgcn_s_memrealtime();
#else
#define TS0(k)
#define TS1(k)
#endif
#define REPS(k) asm volatile("" : "+s"(p)); unsigned char* ws = p->ws; for (int rep_ = 0; rep_ <= ((REPMASK >> (k)) & 1); ++rep_, ({ asm volatile("" : "+v"(tid), "+v"(lane)); }))
    constexpr bool AL = true, SP = true;
    volatile FK_LAS unsigned* xb_st = (volatile FK_LAS unsigned*)(lds + LDS_TOTAL + 16);
    if (tid < 2) xb_st[tid] = 0u;
    __syncthreads();
    XcdBarrier xb = xcd_barrier_post((unsigned*)(p->ws + WS_BAR), xb_st);
    if (p->dbg_lo == 0x7fffffff) grid.sync();
    { TS0(0) REPS(0) if (PH(0)) { p0_prologue(p, lds, gw, NGW, wave, lane); }
    }
    xcd_barrier(xb);
    TS1(0)
    { TS0(1) REPS(1) if (PH(1)) {
        { ProbStd S{(const char*)p->out + DO_XN, (const char*)(ws + WS_WIN_T), D, D, D, 0}; S.T.init(M / 256, N1 / 256, G, bid, WGM_P1);
          EpiBf16Split E{(bf16_t*)(ws + WS_QKV), (bf16_t*)((unsigned char*)p->out + DO_Z), (bf16_t*)(ws + WS_SC), 6, 8, 1536, 512, 1024, 10, p->in[7]};
          gemm_phase<EpiBf16Split, ProbStd, AL, SP>(lds, S, E); }
        if (bid < 64) { ProbStd S{(const char*)(ws + WS_MEMN), (const char*)(ws + WS_WXK_T), D, D, D, 0}; S.T.init(8, 8, G, bid);
          EpiBf16Split E{(bf16_t*)(ws + WS_KV), (bf16_t*)(ws + WS_KV) + (size_t)2048 * 1024, nullptr, 4, 8, 1024, 1024, 1024, 1 << 30, nullptr};
          gemm_phase<EpiBf16Split, ProbStd, AL, SP>(lds, S, E); }
        else late_weights(p, lds, (bid - 64) * 8 + wave, (G - 64) * 8, wave, lane);
    }
    }
    xcd_barrier(xb);
    TS1(1)
    { TS0(2) TS0(3) REPS(2) if (PH(2)) {
        const int x = bid & 7, w0 = bid - 32, jj = w0 >> 3;
        if (bid < 32) p3_scan(p, lds, bid, tid, wave, lane);
        else if (G == 256 && jj < 24) {
            { const float* cw = p->in[4];
              for (int i = tid; i < 4 * 3 * 4 * 128; i += 512) { const int hh_ = i / 1536, r_ = i % 1536, pt = r_ >> 9, k = (r_ >> 7) & 3, c = r_ & 127; ((FK_LAS float*)(lds + PL_CW))[i] = cw[k * 1536 + pt * 512 + hh_ * 128 + c]; } }
            auto item_of = [](int idx) { return (idx & 31) * 64 + (idx >> 5); };
            P2Raw R; p2_load(p, item_of(w0), tid, lane, R);
            __syncthreads();
            for (int idx = w0; idx < NITEM; idx += 192) { int it = item_of(idx); asm volatile("" : "+s"(it)); const int nx = idx + 192; p2_item(p, lds, it, nx < NITEM ? item_of(nx) : -1, tid, wave, lane, R); }
        } else if (G == 256) {
            for (int vw = (w0 - 192) * 8 + wave; vw < 2048; vw += 32 * 8) p2_short_conv(p, vw, lane);
            asm volatile("s_waitcnt vmcnt(0)" ::: "memory");
            __syncthreads();
            if (tid == 0) __hip_atomic_fetch_add((unsigned*)(ws + WS_PROG) + 64, 1u, __ATOMIC_RELAXED, __HIP_MEMORY_SCOPE_AGENT);
        }
        if (G == 256) {
            for (int r = 0; r < 3; ++r) {
                int t, level;
                if (bid < 32) { if (r > 0) break; t = 60 + (bid >> 3); level = 4; }
                else if (jj >= 24) { t = (jj - 24) + 4 * r; level = 0; }
                else { if (r > 1) break; t = 12 + jj + 24 * r; level = (t >> 2) <= 8 ? 1 : ((t >> 2) <= 13 ? 2 : 3); }
                if (tid == 0) { unsigned* pg = (unsigned*)(ws + WS_PROG); unsigned sp_ = 0;
                    while (__hip_atomic_load(pg + x * 8 + level, __ATOMIC_RELAXED, __HIP_MEMORY_SCOPE_AGENT) < 16u || __hip_atomic_load(pg + 64, __ATOMIC_RELAXED, __HIP_MEMORY_SCOPE_AGENT) < 32u) { __builtin_amdgcn_s_sleep(8); if (++sp_ > (1u << 21)) break; }
                    __builtin_amdgcn_fence(__ATOMIC_ACQUIRE, "agent"); asm volatile("s_waitcnt vmcnt(0)" ::: "memory"); }
                __syncthreads();
                ProbOne S{(const char*)(ws + WS_MIX), (const char*)(ws + WS_WOUT_T), D, D, D, x * 16 + (t >> 2), t & 3};
                EpiResidB E{p->in[0], nullptr, (bf16_t*)((unsigned char*)p->out + DO_XN), (float*)(ws + WS_SS1)};
                gemm_phase<EpiResidB, ProbOne, AL, SP>(lds, S, E);
            }
            if (bid >= 32 && jj < 24) {
              const bool light = w0 >= 128;
              ProbXW S{(const char*)(ws + WS_KV), (const char*)(ws + WS_KV) + (size_t)2048 * 1024 * 2, (const char*)(ws + WS_WXQ_G), (const char*)(ws + WS_WXO_T), D, D, 256, light ? 64 : 256, light ? w0 - 128 : 128 + w0, light ? 128 : 256};
              EpiXW E{(bf16_t*)(ws + WS_WQP), (bf16_t*)(ws + WS_VWP)};
              gemm_phase<EpiXW, ProbXW, AL, SP>(lds, S, E); }
        }
    }
    }
    xcd_barrier(xb);
    TS1(2) TS1(3)
    { TS0(5) REPS(5) if (PH(5)) { ProbStd S{(const char*)p->out + DO_XN, (const char*)(ws + WS_WQP), D, D, D, (size_t)2 * 1048576}; S.T.init(M / 256, 4, G, bid);
        EpiSoftmax E{(const float*)(ws + WS_SS1), (bf16_t*)(ws + WS_P)};
        gemm_phase<EpiSoftmax, ProbStd, AL, SP>(lds, S, E); }
    }
    xcd_barrier(xb);
    TS1(5)
    { TS0(6) REPS(6) if (PH(6)) { ProbStd S{(const char*)(ws + WS_P), (const char*)(ws + WS_VWP), D, D, D, (size_t)2 * 1048576}; S.T.init(M / 256, 4, G, bid);
        EpiResidB E{nullptr, (const bf16_t*)((const unsigned char*)p->out + DO_XN), (bf16_t*)(ws + WS_HB), (float*)(ws + WS_SS2)};
        gemm_phase<EpiResidB, ProbStd, AL, SP>(lds, S, E); }
    }
    xcd_barrier(xb);
    TS1(6)
    { TS0(7) REPS(7) if (PH(7)) { ProbStd S{(const char*)(ws + WS_HB), (const char*)(ws + WS_WGU_T), D, D, D, 0}; S.T.init(M / 256, 2 * DFF / 256, G, bid, WGM_P7);
        EpiGateUp E{(const float*)(ws + WS_SS2), (bf16_t*)(ws + WS_ACT)};
        gemm_phase<EpiGateUp, ProbStd, AL, SP>(lds, S, E); }
    }
    xcd_barrier(xb);
    TS1(7)
    { TS0(8) REPS(8) if (PH(8)) { ProbStd S{(const char*)(ws + WS_ACT), (const char*)(ws + WS_WDN_T), DFF, DFF, DFF, 0}; S.T.init(M / 256, 4, G, bid);
        EpiFinal E{(const bf16_t*)(ws + WS_HB), p->out, (float*)(ws + WS_SS3), (unsigned*)(ws + WS_PCNT), p->in[21]};
        gemm_phase<EpiFinal, ProbStd, AL, SP>(lds, S, E); }
    }
    TS1(8)
#ifdef EXPK
    if (EXPK == 9) { __syncthreads(); TS1(9) }
    if (bid == 0 && tid == 0) { const unsigned long long ts0_ = *(volatile FK_LAS unsigned long long*)(lds + LDS_TOTAL), ts1_ = *(volatile FK_LAS unsigned long long*)(lds + LDS_TOTAL + 8);
        const unsigned long long te = __builtin_amdgcn_s_memrealtime(), dt = (ts1_ - ts0_) * EXPMULT;
        while (__builtin_amdgcn_s_memrealtime() - te < dt) __builtin_amdgcn_s_sleep(32); }
#endif
#undef PH
}

static int launch_mega(void* const* d_in, void* d_out, void* d_ws, size_t ws_size, hipStream_t stream, int lo, int hi) {
    static int grid_blocks = 0;
    if (!grid_blocks) {
        int dev = 0, cus = 0, per_cu = 0;
        hipGetDevice(&dev); hipDeviceGetAttribute(&cus, hipDeviceAttributeMultiprocessorCount, dev);
        if (hipFuncSetAttribute((const void*)mega, hipFuncAttributeMaxDynamicSharedMemorySize, LDS_TOTAL + 64) != hipSuccess) { fprintf(stderr, "hipFuncSetAttribute failed\n"); grid_blocks = -1; return -1; }
        hipOccupancyMaxActiveBlocksPerMultiprocessor(&per_cu, (const void*)mega, 512, LDS_TOTAL + 64);
        if (per_cu < 1) { fprintf(stderr, "occupancy query says %d blocks/CU\n", per_cu); per_cu = 1; }
        grid_blocks = cus * 1;
        if (ws_size < WS_END) { fprintf(stderr, "ws too small: %zu < %zu\n", ws_size, (size_t)WS_END); grid_blocks = -1; return -1; }
    }
    if (grid_blocks < 0) return -1;
    if (hipMemsetAsync((char*)d_ws + WS_BAR, 0, (WS_FLAGS - WS_BAR) + NITEM * 4 + 512 + 512, stream) != hipSuccess) { fprintf(stderr, "memset of barrier words failed\n"); return -1; }
    Params p{}; for (int i = 0; i < 22; ++i) p.in[i] = (const float*)d_in[i];
    p.out = (float*)d_out; p.ws = (unsigned char*)d_ws; p.dbg_lo = lo; p.dbg_hi = hi;
    void* args[] = {&p};
    hipError_t e = hipLaunchCooperativeKernel((const void*)mega, dim3(grid_blocks), dim3(512), args, LDS_TOTAL + 64, stream);
    if (e != hipSuccess) { fprintf(stderr, "cooperative launch failed: %s (grid %d)\n", hipGetErrorString(e), grid_blocks); return -1; }
    return 0;
}
}
extern "C" void kernel_launch(void* const* d_in, const int* in_sizes, int n_in, void* d_out, int out_size, void* d_ws, size_t ws_size, hipStream_t stream) {
    fk::launch_mega(d_in, d_out, d_ws, ws_size, stream, 0, 99);
}
```
